# Optimizing an MI355X kernel written in HIP

```python
import math
import jax
import jax.numpy as jnp
from jax import lax
import numpy as np

D_MODEL = 1024
BATCH = 8
SEQ = 2048
DEPTH = 1
DEC_BATCH = 32
DEC_SEQ = 32
PAST_LEN = 2048

CHUNK = 64
QBLK = 128
N_A = 8
HD_A = 64
N_B = 4
HD_B = 64
D_A = N_A * HD_A
D_B = N_B * 2 * HD_B
D_MIX = D_A + D_B
D_IN = 3 * D_A + N_A + 3 * D_B
D_FF = 2816
NORM_EPS = 1e-6
NEG_INF = -1e30
LAMBDA_STD = 0.1
ALIBI_SLOPES = (0.25, 0.0625, 0.015625, 0.00390625)

kernel_name = 'streaming_fox_diff_hybrid_step'


def rmsnorm(x, g):
    xf = x.astype(jnp.float32)
    y = xf * lax.rsqrt(jnp.mean(xf * xf, axis=-1, keepdims=True) + NORM_EPS)
    return (y * g.astype(jnp.float32)).astype(x.dtype)


def swiglu(x, w_in, w_out):
    g, u = jnp.split(x @ w_in, 2, axis=-1)
    return (jax.nn.silu(g) * u) @ w_out


def sweep_queries(block_fn, n_q):
    if n_q <= QBLK:
        return block_fn(0, n_q)
    n_blk = n_q // QBLK
    out = lax.map(lambda i: block_fn(i * QBLK, QBLK), jnp.arange(n_blk))
    out = jnp.moveaxis(out, 0, 1)
    return out.reshape(out.shape[0], n_q, *out.shape[3:])


def fox_attention(q, k, v, c_q, c_k, q_off):
    k_pos = jnp.arange(k.shape[1])
    c_k_t = jnp.swapaxes(c_k, 1, 2)
    scale = HD_A ** -0.5

    def block(start, size):
        qb = lax.dynamic_slice_in_dim(q, start, size, axis=1)
        cqb = jnp.swapaxes(lax.dynamic_slice_in_dim(c_q, start, size, axis=1), 1, 2)
        q_pos = q_off + start + jnp.arange(size)
        s = jnp.einsum('bqhd,bkhd->bhqk', qb, k).astype(jnp.float32) * scale
        s = s + (cqb[..., :, None] - c_k_t[..., None, :])
        s = jnp.where(q_pos[:, None] >= k_pos[None, :], s, NEG_INF)
        p = jax.nn.softmax(s, axis=-1).astype(v.dtype)
        return jnp.einsum('bhqk,bkhd->bqhd', p, v)

    return sweep_queries(block, q.shape[1])


def diff_attention(q, k, v, lam, q_off):
    k_pos = jnp.arange(k.shape[1])
    slopes = jnp.asarray(ALIBI_SLOPES, jnp.float32)
    scale = HD_B ** -0.5

    def block(start, size):
        qb = lax.dynamic_slice_in_dim(q, start, size, axis=1)
        q_pos = q_off + start + jnp.arange(size)
        dist = jnp.abs(q_pos[:, None] - k_pos[None, :]).astype(jnp.float32)
        bias = -slopes[:, None, None] * dist
        s = jnp.einsum('bqhed,bkhed->behqk', qb, k).astype(jnp.float32) * scale + bias
        mask = (q_pos // CHUNK)[:, None] >= (k_pos // CHUNK)[None, :]
        s = jnp.where(mask, s, NEG_INF)
        p = jax.nn.softmax(s, axis=-1)
        a = (p[:, 0] - lam * p[:, 1]).astype(v.dtype)
        return jnp.einsum('bhqk,bkhv->bqhv', a, v)

    return sweep_queries(block, q.shape[1])


def hybrid_layer(x, past_fk, past_fv, past_flf, past_dk, past_dv, lambda_init,
                 norm_ffn1, w_ffn1_in, w_ffn1_out, norm_mix, w_in, b_forget,
                 lambda_q1, lambda_k1, lambda_q2, lambda_k2, diff_subln, w_out,
                 norm_ffn2, w_ffn2_in, w_ffn2_out):
    B, T, _ = x.shape
    past = past_fk.shape[1]
    x = x + 0.5 * swiglu(rmsnorm(x, norm_ffn1), w_ffn1_in, w_ffn1_out)
    h = rmsnorm(x, norm_mix)
    proj = h @ w_in
    splits = [D_A, 2 * D_A, 3 * D_A, 3 * D_A + N_A, 3 * D_A + N_A + D_B, 3 * D_A + N_A + 2 * D_B]
    qa, ka, va, fa, qb, kb, vb = jnp.split(proj, splits, axis=-1)
    qa = qa.reshape(B, T, N_A, HD_A)
    ka = ka.reshape(B, T, N_A, HD_A)
    va = va.reshape(B, T, N_A, HD_A)
    logf = jax.nn.log_sigmoid((fa + b_forget).astype(jnp.float32))
    qb = qb.reshape(B, T, N_B, 2, HD_B)
    kb = kb.reshape(B, T, N_B, 2, HD_B)
    vb = vb.reshape(B, T, N_B, 2 * HD_B)
    k_all = jnp.concatenate([past_fk, ka], axis=1)
    v_all = jnp.concatenate([past_fv, va], axis=1)
    c_all = jnp.cumsum(jnp.concatenate([past_flf.astype(jnp.float32), logf], axis=1), axis=1)
    o_a = fox_attention(qa, k_all, v_all, c_all[:, past:], c_all, past)
    lam = (jnp.exp(jnp.sum(lambda_q1.astype(jnp.float32) * lambda_k1.astype(jnp.float32)))
           - jnp.exp(jnp.sum(lambda_q2.astype(jnp.float32) * lambda_k2.astype(jnp.float32)))
           + lambda_init)
    kb_all = jnp.concatenate([past_dk, kb], axis=1)
    vb_all = jnp.concatenate([past_dv, vb], axis=1)
    o_b = diff_attention(qb, kb_all, vb_all, lam, past)
    o_b = rmsnorm(o_b, diff_subln) * (1.0 - lambda_init)
    o = jnp.concatenate([o_a.reshape(B, T, D_A), o_b.reshape(B, T, D_B)], axis=-1)
    x = x + o @ w_out
    x = x + 0.5 * swiglu(rmsnorm(x, norm_ffn2), w_ffn2_in, w_ffn2_out)
    return x, ka, va, logf, kb, vb


def setup_inputs(seed: int = 0) -> dict:
    key = jax.random.key(seed)
    ks = jax.random.split(key, 24)
    f32 = jnp.float32

    def nrm(k, shape, scale=1.0):
        return jax.random.normal(k, shape, f32) * scale

    def gain(k, n):
        return 1.0 + 0.02 * jax.random.normal(k, (DEPTH, n), f32)

    return {
        'x_prompt': nrm(ks[0], (BATCH, SEQ, D_MODEL)),
        'x_sample': nrm(ks[1], (DEC_BATCH, DEC_SEQ, D_MODEL)),
        'cache_fox_k': nrm(ks[2], (DEPTH, DEC_BATCH, PAST_LEN, N_A, HD_A)),
        'cache_fox_v': nrm(ks[3], (DEPTH, DEC_BATCH, PAST_LEN, N_A, HD_A)),
        'cache_fox_logf': jax.nn.log_sigmoid(2.5 + nrm(ks[4], (DEPTH, DEC_BATCH, PAST_LEN, N_A))),
        'cache_diff_k': nrm(ks[5], (DEPTH, DEC_BATCH, PAST_LEN, N_B, 2, HD_B)),
        'cache_diff_v': nrm(ks[6], (DEPTH, DEC_BATCH, PAST_LEN, N_B, 2 * HD_B)),
        'norm_ffn1': gain(ks[7], D_MODEL),
        'w_ffn1_in': nrm(ks[8], (DEPTH, D_MODEL, 2 * D_FF), D_MODEL ** -0.5),
        'w_ffn1_out': nrm(ks[9], (DEPTH, D_FF, D_MODEL), D_FF ** -0.5),
        'norm_mix': gain(ks[10], D_MODEL),
        'w_in': nrm(ks[11], (DEPTH, D_MODEL, D_IN), D_MODEL ** -0.5),
        'b_forget': jax.random.uniform(ks[12], (DEPTH, N_A), f32, 1.0, 4.0),
        'lambda_q1': nrm(ks[13], (DEPTH, HD_B), LAMBDA_STD),
        'lambda_k1': nrm(ks[14], (DEPTH, HD_B), LAMBDA_STD),
        'lambda_q2': nrm(ks[15], (DEPTH, HD_B), LAMBDA_STD),
        'lambda_k2': nrm(ks[16], (DEPTH, HD_B), LAMBDA_STD),
        'diff_subln': gain(ks[17], 2 * HD_B),
        'w_out': nrm(ks[18], (DEPTH, D_MIX, D_MODEL), D_MIX ** -0.5),
        'norm_ffn2': gain(ks[19], D_MODEL),
        'w_ffn2_in': nrm(ks[20], (DEPTH, D_MODEL, 2 * D_FF), D_MODEL ** -0.5),
        'w_ffn2_out': nrm(ks[21], (DEPTH, D_FF, D_MODEL), D_FF ** -0.5),
        'norm_final': 1.0 + 0.02 * jax.random.normal(ks[22], (D_MODEL,), f32),
    }


def reference(x_prompt, x_sample, cache_fox_k, cache_fox_v, cache_fox_logf, cache_diff_k, cache_diff_v,
              norm_ffn1, w_ffn1_in, w_ffn1_out, norm_mix, w_in, b_forget,
              lambda_q1, lambda_k1, lambda_q2, lambda_k2, diff_subln, w_out,
              norm_ffn2, w_ffn2_in, w_ffn2_out, norm_final):
    B = x_prompt.shape[0]
    dt = x_prompt.dtype
    xp, xs = x_prompt, x_sample
    pk, pv, plf, pdk, pdv = [], [], [], [], []
    sk, sv, slf, sdk, sdv = [], [], [], [], []
    for l in range(DEPTH):
        lambda_init = 0.8 - 0.6 * math.exp(-0.3 * l)
        w = (norm_ffn1[l], w_ffn1_in[l], w_ffn1_out[l], norm_mix[l], w_in[l], b_forget[l],
             lambda_q1[l], lambda_k1[l], lambda_q2[l], lambda_k2[l], diff_subln[l], w_out[l],
             norm_ffn2[l], w_ffn2_in[l], w_ffn2_out[l])
        xp, ka, va, lfa, kb, vb = hybrid_layer(
            xp,
            jnp.zeros((B, 0, N_A, HD_A), dt), jnp.zeros((B, 0, N_A, HD_A), dt),
            jnp.zeros((B, 0, N_A), jnp.float32),
            jnp.zeros((B, 0, N_B, 2, HD_B), dt), jnp.zeros((B, 0, N_B, 2 * HD_B), dt),
            lambda_init, *w)
        pk.append(ka); pv.append(va); plf.append(lfa); pdk.append(kb); pdv.append(vb)
        xs, ka, va, lfa, kb, vb = hybrid_layer(
            xs, cache_fox_k[l], cache_fox_v[l], cache_fox_logf[l], cache_diff_k[l], cache_diff_v[l],
            lambda_init, *w)
        sk.append(ka); sv.append(va); slf.append(lfa); sdk.append(kb); sdv.append(vb)
    y_prompt = rmsnorm(xp, norm_final)
    y_sample = rmsnorm(xs, norm_final)
    return (y_prompt, y_sample,
            jnp.stack(pk), jnp.stack(pv), jnp.stack(plf), jnp.stack(pdk), jnp.stack(pdv),
            jnp.stack(sk), jnp.stack(sv), jnp.stack(slf), jnp.stack(sdk), jnp.stack(sdv))
```

```cpp
#include <hip/hip_runtime.h>
#include <hip/hip_bf16.h>
#include <cstdio>
#include <cstdint>
#include <cmath>

#ifndef MK_N_LAUNCHES
#define MK_N_LAUNCHES 9
#endif

constexpr int DM = 1024, NBP = 8, SEQ = 2048, NBS = 32, TSM = 32, PAST = 2048;
constexpr int MP = NBP * SEQ, MS = NBS * TSM, MT = MP + MS;
constexpr int DFF = 2816, NFF = 2 * DFF, NINP = 3328, NQKV = 3072;
constexpr float EPS = 1e-6f, LOG2E = 1.4426950408889634f, C2 = 0.125f * 1.4426950408889634f;
constexpr float LAMBDA_INIT = 0.2f;
constexpr size_t O_Y = 0;
constexpr size_t O_FKP = 17825792, O_FVP = 26214400, O_FLP = 34603008, O_DKP = 34734080, O_DVP = 43122688;
constexpr size_t O_FKS = 51511296, O_FVS = 52035584, O_FLS = 52559872, O_DKS = 52568064, O_DVS = 53092352, O_END = 53616640;

constexpr size_t MiB = 1u << 20;
constexpr size_t WS_CTL = 0, CTL_ZERO_BYTES = 1 * MiB;
constexpr size_t WS_W1I = 2 * MiB, WS_W1O = 14 * MiB, WS_WIN = 20 * MiB, WS_WOUT = 27 * MiB, WS_W2I = 30 * MiB, WS_W2O = 42 * MiB;
constexpr size_t WS_BC = 48 * MiB, WS_SS0 = 50 * MiB;
constexpr size_t WS_XA = 64 * MiB, WS_H = 100 * MiB, WS_X1 = 196 * MiB, WS_X2 = 264 * MiB, WS_QKV = 332 * MiB, WS_OB = 434 * MiB, WS_OSCR = 468 * MiB, WS_END = 500 * MiB;
constexpr int CW_BAR = 4096;
constexpr int CW_QUEUE = 8192;
constexpr int CW_SS1 = 65536, CW_SS2 = 65536 + 32768;
static_assert((CW_SS2 + 32768) * 4 <= (int)CTL_ZERO_BYTES, "CTL region");

constexpr int RING_OFF = 0, RING_BYTES = 131072;
constexpr int ATT_WSF = 131072, ATT_ML = 135168, ATT_TMP = 137216;
constexpr int LDSCTL_OFF = 143360, MISC_OFF = LDSCTL_OFF + 320;
constexpr int LDS_BYTES = 147456;
constexpr int NWAVES = 8;

#define GAS __attribute__((address_space(1)))
#define LAS __attribute__((address_space(3)))
typedef unsigned short bf16;
typedef unsigned v4u __attribute__((ext_vector_type(4)));
typedef unsigned v2u __attribute__((ext_vector_type(2)));
typedef float f32x4 __attribute__((ext_vector_type(4)));
typedef GAS unsigned gu32;
#define RLX_AGENT __ATOMIC_RELAXED, __HIP_MEMORY_SCOPE_AGENT
#define LDS_WAIT() asm volatile("s_waitcnt lgkmcnt(0)" ::: "memory")
#define VM_WAIT() asm volatile("s_waitcnt vmcnt(0)" ::: "memory")
typedef float f32x2_t __attribute__((ext_vector_type(2))); typedef __bf16 bf16x2_t __attribute__((ext_vector_type(2)));
__device__ __forceinline__ unsigned pk2(float lo, float hi) { f32x2_t v = {lo, hi}; bf16x2_t b = __builtin_convertvector(v, bf16x2_t); return __builtin_bit_cast(unsigned, b); }

namespace pg8 {
#define PG8_LAS __attribute__((address_space(3)))
typedef unsigned short bf16_t;
typedef short bf16x8 __attribute__((ext_vector_type(8)));
typedef float f32x4 __attribute__((ext_vector_type(4)));
typedef unsigned u32x4 __attribute__((ext_vector_type(4)));
constexpr int BM = 256, BK = 64, HALF = 128, HTB = HALF * BK * 2  , STAGE_BYTES = 8 * HTB, NXCD = 8, WGM = 8;

__host__ __device__ __forceinline__ int lds_byte(int r, int c) { const int st = (r >> 4) * 2 + (c >> 5), rr = r & 15, cc = c & 31, ob = rr * 64 + cc * 2; return st * 1024 + (ob ^ (((ob >> 9) & 1) << 5)); }
__host__ __device__ __forceinline__ void stage_rc(int b, int& R, int& C) { const int st = b / 1024, sb = b % 1024, swz = sb ^ (((sb >> 9) & 1) << 5); R = (st >> 1) * 16 + swz / 64; C = (st & 1) * 32 + (swz % 64) / 2; }
__host__ __device__ __forceinline__ int perm32(int rho) { const int n = rho >> 4, i = rho & 15; return 8 * (i >> 2) + 4 * n + (i & 3); }

struct Unit { int pm, pn; };
struct Gemm { const bf16_t* A; const bf16_t* Bt; int M, N, K; };

struct StaticOrder {
    int nM, nN, nwg, G, c;
    __host__ __device__ void init(int M, int N, int G_, int c_) { nM = M / BM; nN = N / BM; nwg = nM * nN; G = G_; c = c_; }
    __host__ __device__ bool next(int i, Unit& u) const {
        const long L = (long)i * G + c; if (L >= nwg) return false;
        int wgid = (int)L; { const int q = nwg / NXCD, r = nwg % NXCD, xcd = wgid % NXCD, off = wgid / NXCD; wgid = (xcd < r ? xcd * (q + 1) : r * (q + 1) + (xcd - r) * q) + off; }
        const int nig = WGM * nN, gid = wgid / nig, fm = gid * WGM, gsz = (nM - fm) < WGM ? (nM - fm) : WGM;
        u.pm = fm + ((wgid % nig) % gsz); u.pn = (wgid % nig) / gsz; return true;
    }
    __device__ __forceinline__ void a_ready(const Unit&) const {}
    __device__ __forceinline__ void done(const Unit&) const {}
};

__device__ __forceinline__ unsigned cvt_pk_bf16(float lo, float hi) { unsigned r; asm volatile("v_cvt_pk_bf16_f32 %0, %1, %2" : "=v"(r) : "v"(lo), "v"(hi)); return r; }
typedef float f32x2 __attribute__((ext_vector_type(2)));
struct EpiSwiglu {
    static constexpr bool PERM = true, AFTER_DRAIN = false;
    bf16_t* H; const float* ss;
    __device__ __forceinline__ void operator()(const f32x4 (&acc)[2][2][4][2], const Unit& u, int wr, int wc, int fr, int fq) const {
        const int row0 = u.pm * BM + wr * 64 + fr, hcol = u.pn * 128 + wc * 32 + 8 * fq;
#pragma unroll
        for (int ai = 0; ai < 2; ++ai)
#pragma unroll
            for (int m = 0; m < 4; ++m) {
                const int row = row0 + ai * HALF + m * 16;
                const float rs = __builtin_amdgcn_rsqf(ss[row] * (1.0f / 1024.0f) + 1e-6f);
                float h[8];
#pragma unroll
                for (int n = 0; n < 2; ++n)
#pragma unroll
                    for (int j = 0; j < 4; ++j) {
                        const float g = acc[ai][0][m][n][j] * rs, uu = acc[ai][1][m][n][j] * rs;
                        const float e = __builtin_amdgcn_exp2f(g * -1.4426950408889634f);
                        h[n * 4 + j] = g * uu * __builtin_amdgcn_rcpf(1.0f + e);
                    }
                u32x4 w; w.x = cvt_pk_bf16(h[0], h[1]); w.y = cvt_pk_bf16(h[2], h[3]); w.z = cvt_pk_bf16(h[4], h[5]); w.w = cvt_pk_bf16(h[6], h[7]);
                *(u32x4*)(H + (size_t)row * 2816 + hcol) = w;
            }
    }
};
struct EpiResid {
    static constexpr bool PERM = true, AFTER_DRAIN = false;
    const float* base0; const float* base1;
    float* out; bf16_t* xa; float* ssout; float alpha;
    __device__ __forceinline__ void operator()(const f32x4 (&acc)[2][2][4][2], const Unit& u, int wr, int wc, int fr, int fq) const {
        const float* bb = (u.pm < 64) ? base0 + (size_t)(u.pm * BM) * 1024 : base1 + (size_t)(u.pm * BM - 16384) * 1024;
        const int col0 = u.pn * BM + wc * 32 + 8 * fq;
#pragma unroll
        for (int ai = 0; ai < 2; ++ai)
#pragma unroll
            for (int m = 0; m < 4; ++m) {
                const int rl = wr * 64 + fr + ai * HALF + m * 16; const size_t row = (size_t)u.pm * BM + rl;
                float sq = 0.f;
#pragma unroll
                for (int bj = 0; bj < 2; ++bj) {
                    const float* bp = bb + (size_t)rl * 1024 + col0 + bj * HALF;
                    const f32x4 b0 = *(const f32x4*)bp, b1 = *(const f32x4*)(bp + 4);
                    const f32x4 v0 = b0 + acc[ai][bj][m][0] * alpha, v1 = b1 + acc[ai][bj][m][1] * alpha;
                    float* op = out + row * 1024 + col0 + bj * HALF;
                    *(f32x4*)op = v0; *(f32x4*)(op + 4) = v1;
                    if (xa) { u32x4 w; w.x = cvt_pk_bf16(v0[0], v0[1]); w.y = cvt_pk_bf16(v0[2], v0[3]); w.z = cvt_pk_bf16(v1[0], v1[1]); w.w = cvt_pk_bf16(v1[2], v1[3]);
                        *(u32x4*)(xa + row * 1024 + col0 + bj * HALF) = w; }
                    sq += (v0[0] * v0[0] + v0[1] * v0[1]) + (v0[2] * v0[2] + v0[3] * v0[3]) + (v1[0] * v1[0] + v1[1] * v1[1]) + (v1[2] * v1[2] + v1[3] * v1[3]);
                }
                if (ssout) { sq += __shfl_xor(sq, 16); sq += __shfl_xor(sq, 32);
                    if (fq == 0) __hip_atomic_fetch_add(ssout + row, sq, __ATOMIC_RELAXED, __HIP_MEMORY_SCOPE_AGENT); }
                if (m & 1) asm volatile("" ::: "memory");
            }
    }
};
struct EpiInProj {
    static constexpr bool PERM = true, AFTER_DRAIN = false;
    bf16_t* qkv; float* out; const float* ss; const float* bfg;
    __device__ __forceinline__ void operator()(const f32x4 (&acc)[2][2][4][2], const Unit& u, int wr, int wc, int fr, int fq) const {
        const int pn = u.pn, row0 = u.pm * BM + wr * 64 + fr;
        if (pn < 12) {
            const int kind = pn >> 1; const bool isq = (kind == 0 || kind == 3); const float sc = isq ? 0.125f * 1.4426950408889634f : 1.0f;
            size_t offp = 0, offs = 0;
            if (kind == 1) { offp = 17825792; offs = 51511296; } else if (kind == 2) { offp = 26214400; offs = 52035584; }
            else if (kind == 4) { offp = 34734080; offs = 52568064; } else if (kind == 5) { offp = 43122688; offs = 53092352; }
            const int cc = (pn & 1) * 256 + wc * 32 + 8 * fq, bc = pn * 256 + wc * 32 + 8 * fq;
#pragma unroll
            for (int ai = 0; ai < 2; ++ai)
#pragma unroll
                for (int m = 0; m < 4; ++m) {
                    const int row = row0 + ai * HALF + m * 16;
                    const float rs = __builtin_amdgcn_rsqf(ss[row] * (1.0f / 1024.0f) + 1e-6f);
                    float* fo = (row < 16384) ? out + offp + (size_t)row * 512 : out + offs + (size_t)(row - 16384) * 512;
#pragma unroll
                    for (int bj = 0; bj < 2; ++bj) {
                        const f32x4 v0 = acc[ai][bj][m][0] * rs, v1 = acc[ai][bj][m][1] * rs;
                        u32x4 w; w.x = cvt_pk_bf16(v0[0] * sc, v0[1] * sc); w.y = cvt_pk_bf16(v0[2] * sc, v0[3] * sc); w.z = cvt_pk_bf16(v1[0] * sc, v1[1] * sc); w.w = cvt_pk_bf16(v1[2] * sc, v1[3] * sc);
                        *(u32x4*)(qkv + (size_t)row * 3072 + bc + bj * HALF) = w;
                        if (!isq) { *(f32x4*)(fo + cc + bj * HALF) = v0; *(f32x4*)(fo + cc + bj * HALF + 4) = v1; }
                    }
                }
        } else if (wc == 0 && fq == 0) {
            const f32x4 b0 = *(const f32x4*)bfg, b1 = *(const f32x4*)(bfg + 4);
#pragma unroll
            for (int ai = 0; ai < 2; ++ai)
#pragma unroll
                for (int m = 0; m < 4; ++m) {
                    const int row = row0 + ai * HALF + m * 16;
                    const float rs = __builtin_amdgcn_rsqf(ss[row] * (1.0f / 1024.0f) + 1e-6f);
                    float* fo = (row < 16384) ? out + 34603008 + (size_t)row * 8 : out + 52559872 + (size_t)(row - 16384) * 8;
                    f32x4 z0 = acc[ai][0][m][0] * rs + b0, z1 = acc[ai][0][m][1] * rs + b1, l0, l1;
#pragma unroll
                    for (int j = 0; j < 4; ++j) { l0[j] = fminf(z0[j], 0.f) - log1pf(expf(-fabsf(z0[j]))); l1[j] = fminf(z1[j], 0.f) - log1pf(expf(-fabsf(z1[j]))); }
                    *(f32x4*)fo = l0; *(f32x4*)(fo + 4) = l1;
                }
        }
    }
};

template <class Epi, class Sched, bool ALIGN_EPI = false, bool SP2 = false>
__device__ __forceinline__ void gemm_phase(PG8_LAS unsigned char* lds, const Gemm g, const Sched& S, const Epi& E, const int tid) {
    const int wid = __builtin_amdgcn_readfirstlane(tid >> 6), lane = tid & 63, wr = wid >> 2, wc = wid & 3, fr = lane & 15, fq = lane >> 4;
    const int K = g.K, nt = K / BK;
    unsigned voffA[2], voffB[2];
#pragma unroll
    for (int i = 0; i < 2; ++i) { int R, C; stage_rc(tid * 16 + i * 8192, R, C); const int Rb = Epi::PERM ? ((R & ~31) + perm32(R & 31)) : R;
        voffA[i] = (unsigned)(R * K + C) * 2u; voffB[i] = (unsigned)(Rb * K + C) * 2u; }
    const size_t kstep = (size_t)(BK * 2);
    const size_t hstep = (size_t)HALF * K * 2;
    const size_t tstep = 2 * hstep;
    const unsigned ldsw = (unsigned)wid * 1024u;
    const int aoff = lds_byte(wr * 64 + fr, fq * 8), boff = lds_byte(wc * 32 + fr, fq * 8);
#define PG8_SA(b, h) (((b) * 2 + (h)) * HTB)
#define PG8_SB(b, h) ((4 + (b) * 2 + (h)) * HTB)
#define PG8_STAGE(bufoff, gbase, voff) do { _Pragma("unroll") for (int _i = 0; _i < 2; ++_i) \
        __builtin_amdgcn_global_load_lds((const unsigned*)((const char*)(gbase) + (voff)[_i]), (PG8_LAS unsigned*)(lds + (bufoff) + ldsw + _i * 8192), 16, 0, 0); } while (0)
#define PG8_LDA(dst, b, h) do { _Pragma("unroll") for (int m = 0; m < 4; ++m) _Pragma("unroll") for (int k = 0; k < 2; ++k) dst[m][k] = *(const PG8_LAS bf16x8*)(lds + PG8_SA(b, h) + aoff + m * 2048 + k * 1024); } while (0)
#define PG8_LDB(dst, b, h) do { _Pragma("unroll") for (int n = 0; n < 2; ++n) _Pragma("unroll") for (int k = 0; k < 2; ++k) dst[n][k] = *(const PG8_LAS bf16x8*)(lds + PG8_SB(b, h) + boff + n * 2048 + k * 1024); } while (0)
#define PG8_MMA(ai, bj, At, Bt) do { __builtin_amdgcn_s_setprio(1); _Pragma("unroll") for (int m = 0; m < 4; ++m) _Pragma("unroll") for (int n = 0; n < 2; ++n) _Pragma("unroll") for (int k = 0; k < 2; ++k) \
        acc[ai][bj][m][n] = __builtin_amdgcn_mfma_f32_16x16x32_bf16(Bt[n][k], At[m][k], acc[ai][bj][m][n], 0, 0, 0); __builtin_amdgcn_s_setprio(0); } while (0)
#define PG8_WAIT_V(n) asm volatile("s_waitcnt vmcnt(" #n ")" ::: "memory")
#define PG8_WAIT_L(n) asm volatile("s_waitcnt lgkmcnt(" #n ")" ::: "memory")
#define PG8_BAR __builtin_amdgcn_s_barrier()
#define PG8_SCHED __builtin_amdgcn_sched_barrier(0)
    Unit cur, nxt; int ui = 0;
    if (!S.next(0, cur)) return;
    f32x4 acc[2][2][4][2];
#pragma unroll
    for (int a = 0; a < 2; ++a)
#pragma unroll
        for (int b = 0; b < 2; ++b)
#pragma unroll
            for (int m = 0; m < 4; ++m)
#pragma unroll
                for (int n = 0; n < 2; ++n) acc[a][b][m][n] = (f32x4){0.f, 0.f, 0.f, 0.f};
    bf16x8 At[4][2], B0[2][2], B1[2][2];
    const char* cA = (const char*)g.A + (size_t)cur.pm * tstep; const char* cB = (const char*)g.Bt + (size_t)cur.pn * tstep;
    S.a_ready(cur);
    if constexpr (SP2) {
        PG8_STAGE(PG8_SB(0, 0), cB, voffB); PG8_STAGE(PG8_SB(0, 1), cB + hstep, voffB); PG8_STAGE(PG8_SA(0, 0), cA, voffA); PG8_STAGE(PG8_SA(0, 1), cA + hstep, voffA);
        if (wr == 1) PG8_BAR;
        PG8_WAIT_V(2); PG8_BAR;
        PG8_STAGE(PG8_SB(1, 0), cB + kstep, voffB); PG8_STAGE(PG8_SA(1, 0), cA + kstep, voffA); PG8_STAGE(PG8_SB(1, 1), cB + hstep + kstep, voffB);
        PG8_WAIT_V(6); PG8_BAR;
    } else {
        PG8_STAGE(PG8_SB(0, 0), cB, voffB); PG8_STAGE(PG8_SA(0, 0), cA, voffA); PG8_STAGE(PG8_SB(0, 1), cB + hstep, voffB); PG8_STAGE(PG8_SA(0, 1), cA + hstep, voffA);
        if (wr == 1) PG8_BAR;
        PG8_WAIT_V(4); PG8_BAR;
        PG8_STAGE(PG8_SB(1, 0), cB + kstep, voffB); PG8_STAGE(PG8_SA(1, 0), cA + kstep, voffA); PG8_STAGE(PG8_SB(1, 1), cB + hstep + kstep, voffB);
        PG8_WAIT_V(6); PG8_BAR;
    }
    for (;;) {
        const bool has_next = S.next(ui + 1, nxt);
        const char* nA = has_next ? (const char*)g.A + (size_t)nxt.pm * tstep : cA; const char* nB = has_next ? (const char*)g.Bt + (size_t)nxt.pn * tstep : cB;
        for (int t = 0; t < nt; t += 2) {
            const bool last = (t == nt - 2);
            const char* a1 = cA + (size_t)(t + 1) * kstep;
            const char* a2 = last ? nA : cA + (size_t)(t + 2) * kstep; const char* b2 = last ? nB : cB + (size_t)(t + 2) * kstep;
            const char* a3 = a2 + kstep; const char* b3 = b2 + kstep;
            if (last && has_next) S.a_ready(nxt);
            if constexpr (SP2) {
            PG8_LDB(B0, 0, 0); PG8_LDB(B1, 0, 1); PG8_SCHED; PG8_LDA(At, 0, 0); PG8_STAGE(PG8_SA(1, 1), a1 + hstep, voffA);
            PG8_WAIT_V(8); PG8_WAIT_L(0); PG8_BAR; PG8_MMA(0, 0, At, B0); PG8_MMA(0, 1, At, B1); PG8_BAR; PG8_SCHED;
            PG8_LDA(At, 0, 1); PG8_STAGE(PG8_SB(0, 0), b2, voffB); PG8_STAGE(PG8_SB(0, 1), b2 + hstep, voffB); PG8_STAGE(PG8_SA(0, 0), a2, voffA);
            PG8_WAIT_V(8); PG8_WAIT_L(0); PG8_BAR; PG8_MMA(1, 0, At, B0); PG8_MMA(1, 1, At, B1); PG8_BAR; PG8_SCHED;
            PG8_LDB(B0, 1, 0); PG8_LDB(B1, 1, 1); PG8_SCHED; PG8_LDA(At, 1, 0); PG8_STAGE(PG8_SA(0, 1), a2 + hstep, voffA);
            PG8_WAIT_V(8); PG8_WAIT_L(0); PG8_BAR; PG8_MMA(0, 0, At, B0); PG8_MMA(0, 1, At, B1); PG8_BAR; PG8_SCHED;
            PG8_LDA(At, 1, 1); PG8_STAGE(PG8_SB(1, 0), b3, voffB); PG8_STAGE(PG8_SB(1, 1), b3 + hstep, voffB); PG8_STAGE(PG8_SA(1, 0), a3, voffA);
            PG8_WAIT_V(8); PG8_WAIT_L(0); PG8_BAR; PG8_MMA(1, 0, At, B0); PG8_MMA(1, 1, At, B1); PG8_BAR; PG8_SCHED;
            } else {
            PG8_LDB(B0, 0, 0); PG8_SCHED; PG8_LDA(At, 0, 0); PG8_STAGE(PG8_SA(1, 1), a1 + hstep, voffA);
            PG8_WAIT_L(8); PG8_BAR; PG8_WAIT_L(0); PG8_MMA(0, 0, At, B0); PG8_BAR; PG8_SCHED;
            PG8_LDB(B1, 0, 1); PG8_STAGE(PG8_SB(0, 0), b2, voffB);
            PG8_BAR; PG8_WAIT_L(0); PG8_MMA(0, 1, At, B1); PG8_BAR;
            PG8_LDA(At, 0, 1); PG8_STAGE(PG8_SA(0, 0), a2, voffA);
            PG8_BAR; PG8_WAIT_L(0); PG8_MMA(1, 0, At, B0); PG8_BAR; PG8_SCHED;
            PG8_STAGE(PG8_SB(0, 1), b2 + hstep, voffB);
            PG8_WAIT_V(6); PG8_BAR; PG8_MMA(1, 1, At, B1); PG8_BAR;
            PG8_LDB(B0, 1, 0); PG8_SCHED; PG8_LDA(At, 1, 0); PG8_STAGE(PG8_SA(0, 1), a2 + hstep, voffA);
            PG8_WAIT_L(8); PG8_BAR; PG8_WAIT_L(0); PG8_MMA(0, 0, At, B0); PG8_BAR; PG8_SCHED;
            PG8_LDB(B1, 1, 1); PG8_STAGE(PG8_SB(1, 0), b3, voffB);
            PG8_BAR; PG8_WAIT_L(0); PG8_MMA(0, 1, At, B1); PG8_BAR;
            PG8_LDA(At, 1, 1); PG8_STAGE(PG8_SA(1, 0), a3, voffA);
            PG8_BAR; PG8_WAIT_L(0); PG8_MMA(1, 0, At, B0); PG8_BAR; PG8_SCHED;
            PG8_STAGE(PG8_SB(1, 1), b3 + hstep, voffB);
            PG8_WAIT_V(6); PG8_BAR; PG8_MMA(1, 1, At, B1); PG8_BAR;
            }
        }
        if constexpr (ALIGN_EPI) { if (wr == 0) PG8_BAR; }
        if constexpr (!Epi::AFTER_DRAIN) { E(acc, cur, wr, wc, fr, fq); S.done(cur); }
        if (!has_next) break;
#pragma unroll
        for (int a = 0; a < 2; ++a)
#pragma unroll
            for (int b = 0; b < 2; ++b)
#pragma unroll
                for (int m = 0; m < 4; ++m)
#pragma unroll
                    for (int n = 0; n < 2; ++n) acc[a][b][m][n] = (f32x4){0.f, 0.f, 0.f, 0.f};
        cur = nxt; cA = nA; cB = nB; ++ui;
        if constexpr (ALIGN_EPI) { if (wr == 1) PG8_BAR; }
    }
    PG8_WAIT_V(0);
    if constexpr (!ALIGN_EPI) { if (wr == 0) PG8_BAR; }
    PG8_BAR;
    if constexpr (Epi::AFTER_DRAIN) { E.fused(acc, cur, wr, wc, fr, fq, lds, wid, lane); S.done(cur); }
#undef PG8_SA
#undef PG8_SB
#undef PG8_STAGE
#undef PG8_LDA
#undef PG8_LDB
#undef PG8_MMA
#undef PG8_WAIT_V
#undef PG8_WAIT_L
#undef PG8_BAR
#undef PG8_SCHED
}
}
namespace att {
typedef short bf16x8 __attribute__((ext_vector_type(8)));
typedef short s16x4 __attribute__((ext_vector_type(4)));
typedef float f32x16 __attribute__((ext_vector_type(16)));
typedef unsigned u32x4 __attribute__((ext_vector_type(4)));
typedef LAS const char* lds_cptr;
typedef short v4i16_t __attribute__((ext_vector_type(4)));
constexpr float THR = 8.0f;
constexpr int PITCH = 3072;

__device__ __forceinline__ int crow(int r, int hi) { return (r & 3) + 8 * (r >> 2) + 4 * hi; }
__device__ __forceinline__ void glds16(const void* gsrc, unsigned lds_dst) { unsigned keep;
    asm volatile("s_mov_b32 %0, m0\n\ts_mov_b32 m0, %2\n\ts_nop 0\n\tglobal_load_lds_dwordx4 %1, off\n\ts_mov_b32 m0, %0" : "=&s"(keep) : "v"(gsrc), "s"(lds_dst) : "memory"); }
__device__ __forceinline__ s16x4 vtr(lds_cptr p) { return __builtin_bit_cast(s16x4, __builtin_amdgcn_ds_read_tr16_b64_v4i16((LAS v4i16_t*)p)); }
#define ABAR_L() asm volatile("s_waitcnt lgkmcnt(0)\n\ts_barrier" ::: "memory")
#define ABAR_VL() asm volatile("s_waitcnt vmcnt(0) lgkmcnt(0)\n\ts_barrier" ::: "memory")

template <int NDV>
__device__ __forceinline__ void sm_part(f32x16 s, float& m, float& l, f32x16 (&o)[NDV], LAS float* wsf, int r32, int hi, bf16x8& pa0, bf16x8& pa1) {
    float pm = s[0];
#pragma unroll
    for (int r = 1; r < 16; ++r) pm = fmaxf(pm, s[r]);
    { auto rr = __builtin_amdgcn_permlane32_swap(__float_as_uint(pm), __float_as_uint(pm), false, false); pm = fmaxf(__uint_as_float(rr[0]), __uint_as_float(rr[1])); }
    if (!__all(pm <= m + THR)) {
        const float mn = fmaxf(m, pm), alpha = __builtin_amdgcn_exp2f(m - mn); m = mn; l *= alpha;
        if (hi == 0) wsf[r32] = alpha;
        LDS_WAIT();
#pragma unroll
        for (int r = 0; r < 16; ++r) { const float a = wsf[crow(r, hi)];
#pragma unroll
            for (int d0 = 0; d0 < NDV; ++d0) o[d0][r] *= a; }
        LDS_WAIT();
    }
    float ps = 0.f;
#pragma unroll
    for (int r = 0; r < 16; ++r) { s[r] = __builtin_amdgcn_exp2f(s[r] - m); ps += s[r]; }
    l += ps;
    u32x4 w0, w1;
    w0.x = pk2(s[0], s[1]); w0.y = pk2(s[2], s[3]); w0.z = pk2(s[4], s[5]); w0.w = pk2(s[6], s[7]);
    w1.x = pk2(s[8], s[9]); w1.y = pk2(s[10], s[11]); w1.z = pk2(s[12], s[13]); w1.w = pk2(s[14], s[15]);
    pa0 = __builtin_bit_cast(bf16x8, w0); pa1 = __builtin_bit_cast(bf16x8, w1);
}
template <int NDV, int KG>
__device__ __forceinline__ void pv_part(bf16x8 pa0, bf16x8 pa1, f32x16 (&o)[NDV], lds_cptr vb) {
#pragma unroll
    for (int d0 = 0; d0 < NDV; ++d0) {
        const s16x4 a0 = vtr(vb + (d0 * KG + 0) * 1024), a1 = vtr(vb + (d0 * KG + 0) * 1024 + 512);
        const s16x4 b0 = vtr(vb + (d0 * KG + 1) * 1024), b1 = vtr(vb + (d0 * KG + 1) * 1024 + 512);
        const bf16x8 v0 = {a0[0], a0[1], a0[2], a0[3], a1[0], a1[1], a1[2], a1[3]}, v1 = {b0[0], b0[1], b0[2], b0[3], b1[0], b1[1], b1[2], b1[3]};
        o[d0] = __builtin_amdgcn_mfma_f32_32x32x16_bf16(pa0, v0, o[d0], 0, 0, 0);
        o[d0] = __builtin_amdgcn_mfma_f32_32x32x16_bf16(pa1, v1, o[d0], 0, 0, 0);
    }
}
template <int NDV, int KG>
__device__ __forceinline__ void sm_pv(f32x16 s, float& m, float& l, f32x16 (&o)[NDV], lds_cptr vb, LAS float* wsf, int r32, int hi) {
    bf16x8 pa0, pa1; sm_part<NDV>(s, m, l, o, wsf, r32, hi, pa0, pa1); pv_part<NDV, KG>(pa0, pa1, o, vb);
}
template <int NDV>
__device__ __forceinline__ void normalize_o(f32x16 (&o)[NDV], float l, LAS float* wsf, int r32, int hi) {
    { auto rr = __builtin_amdgcn_permlane32_swap(__float_as_uint(l), __float_as_uint(l), false, false); l = __uint_as_float(rr[0]) + __uint_as_float(rr[1]); }
    if (hi == 0) wsf[64 + r32] = l;
    LDS_WAIT();
#pragma unroll
    for (int r = 0; r < 16; ++r) { const float a = __builtin_amdgcn_rcpf(wsf[64 + crow(r, hi)]);
#pragma unroll
        for (int d0 = 0; d0 < NDV; ++d0) o[d0][r] *= a; }
    LDS_WAIT();
}

template <int NDV, bool FOX>
__device__ __forceinline__ void prompt_pass(const bf16* Qw, const bf16* Kg, const bf16* Vg, int qb, int w, int lane, LAS char* lds, float slope2, f32x16 (&o)[NDV]) {
    const int r32 = lane & 31, hi = lane >> 5;
    const unsigned lds0 = (unsigned)(uintptr_t)lds;
    LAS float* wsf = (LAS float*)(lds + ATT_WSF) + w * 128;
    LAS const float* cb = (LAS const float*)(lds + 49152);
    bf16x8 qr[4];
#pragma unroll
    for (int d0 = 0; d0 < 4; ++d0) qr[d0] = *(const bf16x8*)(Qw + (size_t)r32 * PITCH + d0 * 16 + hi * 8);
#pragma unroll
    for (int d0 = 0; d0 < NDV; ++d0) o[d0] = f32x16{};
    float m = -1e30f, l = 0.f;
    const int NT = 4 * qb + 4;
    const int my_last = FOX ? 8 * qb + w : 8 * qb + 2 * (w >> 1) + 1;
    const bf16* ksrc = Kg + (size_t)lane * PITCH + w * 8;
    const bf16* vsrc0 = Vg + (size_t)(16 * (w & 3) + (lane >> 2)) * PITCH + (w >> 2) * 32 + (lane & 3) * 8;
    const bf16* vsrc1 = vsrc0 + 64;
#define DMA_TILE(t, bufi) do { const size_t go_ = (size_t)(t) * 64 * PITCH; \
        glds16(ksrc + go_, (unsigned)__builtin_amdgcn_readfirstlane(lds0 + (bufi) * 8192 + w * 1024)); \
        glds16(vsrc0 + go_, (unsigned)__builtin_amdgcn_readfirstlane(lds0 + 16384 + (bufi) * 16384 + w * 1024)); \
        if (NDV == 4) glds16(vsrc1 + go_, (unsigned)__builtin_amdgcn_readfirstlane(lds0 + 16384 + (bufi) * 16384 + (w + 8) * 1024)); } while (0)
    DMA_TILE(NT - 1, 0);
    ABAR_VL();
    for (int i = 0; i < NT; ++i) {
        const int t = NT - 1 - i, buf = i & 1;
        if (i + 1 < NT) DMA_TILE(t - 1, buf ^ 1);
        const lds_cptr kimg = (lds_cptr)lds + buf * 8192, vimg = (lds_cptr)lds + 16384 + buf * 16384;
#pragma unroll
        for (int sub = 1; sub >= 0; --sub) {
            const int gs = 2 * t + sub;
            if (gs <= my_last) {
                f32x16 c;
                if (FOX) {
#pragma unroll
                    for (int g = 0; g < 4; ++g) { const f32x4 x = *(LAS const f32x4*)(cb + 32 * gs + 8 * g + 4 * hi); c[4 * g] = x[0]; c[4 * g + 1] = x[1]; c[4 * g + 2] = x[2]; c[4 * g + 3] = x[3]; }
                } else {
                    const int kb = 32 * gs - 256 * qb;
                    if (t == 4 * qb + (w >> 1)) { const int tq2 = 2 * (32 * w + r32);
#pragma unroll
                        for (int r = 0; r < 16; ++r) { const int s = kb + crow(r, hi); const int v = s < tq2 - s ? s : tq2 - s; c[r] = slope2 * (float)v; }
                    } else {
#pragma unroll
                        for (int r = 0; r < 16; ++r) c[r] = slope2 * (float)(kb + crow(r, hi));
                    }
                }
#pragma unroll
                for (int d0 = 0; d0 < 4; ++d0) { const bf16x8 kf = *(LAS const bf16x8*)(kimg + (2 * d0 + hi) * 1024 + (32 * sub + r32) * 16);
                    c = __builtin_amdgcn_mfma_f32_32x32x16_bf16(kf, qr[d0], c, 0, 0, 0); }
                if (FOX && gs == my_last) {
#pragma unroll
                    for (int r = 0; r < 16; ++r) if (crow(r, hi) > r32) c[r] = -INFINITY;
                }
                const lds_cptr vb = vimg + (2 * sub) * 1024 + (4 * hi + ((lane & 15) >> 2)) * 64 + ((lane >> 4) & 1) * 32 + (lane & 3) * 8;
                sm_pv<NDV, 4>(c, m, l, o, vb, wsf, r32, hi);
            }
        }
        ABAR_VL();
    }
#undef DMA_TILE
    normalize_o<NDV>(o, l, wsf, r32, hi);
}

__device__ __forceinline__ void fox_bias_scan(const float* lf, int n, int qb, LAS char* lds, int tid, int lane, int w) {
    LAS float* cb = (LAS float*)(lds + 49152); LAS float* tmp = (LAS float*)(lds + ATT_TMP);
    float a[4];
#pragma unroll
    for (int k = 0; k < 4; ++k) { const int s = 4 * tid + k; a[k] = s < n ? lf[(size_t)s * 8] : 0.f; }
    a[1] += a[0]; a[2] += a[1]; a[3] += a[2];
    const float tot = a[3]; float v = tot;
#pragma unroll
    for (int o = 1; o < 64; o <<= 1) { const float t = __shfl_up(v, o); if (lane >= o) v += t; }
    if (lane == 63) tmp[w] = v;
    ABAR_L();
    float base = 0.f;
    for (int ww = 0; ww < w; ++ww) base += tmp[ww];
    const float excl = base + v - tot;
#pragma unroll
    for (int k = 0; k < 4; ++k) a[k] += excl;
    if (qb > 0 && tid == 64 * qb - 1) tmp[8] = a[3];
    ABAR_L();
    const float R = qb > 0 ? tmp[8] : 0.f;
    f32x4 cv; cv[0] = (R - a[0]) * LOG2E; cv[1] = (R - a[1]) * LOG2E; cv[2] = (R - a[2]) * LOG2E; cv[3] = (R - a[3]) * LOG2E;
    *(LAS f32x4*)(cb + 4 * tid) = cv;
    ABAR_L();
}

template <bool FOX>
__device__ __forceinline__ void sample_pass(const bf16* Qg, const float* Kc, const float* Kn, const float* Vc, const float* Vn, const float* bcs, const float* lfn, float slope2,
                                            int w, int lane, int tid, LAS char* lds, float (&res)[FOX ? 4 : 8]) {
    constexpr int NSP = FOX ? 8 : 4, DPT = FOX ? 4 : 8, NDV = 2;
    const int wsub = w % NSP, grp = w / NSP;
    const int r32 = lane & 31, hi = lane >> 5;
    LAS float* wsf = (LAS float*)(lds + ATT_WSF) + w * 128;
    LAS char* myreg = lds + w * 16384;
    Vc += grp * 64; Vn += grp * 64;
    bf16x8 qr[4];
#pragma unroll
    for (int d0 = 0; d0 < 4; ++d0) qr[d0] = *(const bf16x8*)(Qg + (size_t)r32 * PITCH + d0 * 16 + hi * 8);
    f32x16 o[NDV];
#pragma unroll
    for (int d0 = 0; d0 < NDV; ++d0) o[d0] = f32x16{};
    float m = -1e30f, l = 0.f;
    float nbias = 0.f;
    if (FOX && w == 0) { float v = lane < 32 ? lfn[(size_t)lane * 8] : 0.f;
#pragma unroll
        for (int o2 = 1; o2 < 32; o2 <<= 1) { const float t = __shfl_up(v, o2); if (lane >= o2) v += t; }
        nbias = -v * LOG2E; }
    constexpr int CNT = 64 / NSP;
    const int nsteps = (wsub == 0) ? CNT + 1 : CNT;
    const lds_cptr vbw = (lds_cptr)myreg + (4 * hi + ((lane & 15) >> 2)) * 64 + ((lane >> 4) & 1) * 32 + (lane & 3) * 8;
    for (int i = 0; i < nsteps; ++i) {
        const int s = (wsub == 0) ? (i == 0 ? 64 : NSP * (CNT - i)) : (wsub + NSP * (CNT - 1 - i));
        const bool isnew = (s == 64);
        const float* Kb = isnew ? Kn : Kc + (size_t)(32 * s) * 512;
        const float* Vb = isnew ? Vn : Vc + (size_t)(32 * s) * 512;
        int lv = lane; asm volatile("" : "+v"(lv));
        const int r32v = lv & 31, hiv = lv >> 5;
        const int vkey = lv >> 4, vdd = 4 * (lv & 15);
        const float* vp = Vb + (size_t)vkey * 512 + vdd;
        LAS char* vdst = myreg + ((vdd >> 5) * 2) * 1024 + vkey * 64 + (vdd & 31) * 2;
        f32x4 kx[8], vx[8];
#pragma unroll
        for (int d0 = 0; d0 < 4; ++d0) { const float* kp = Kb + (size_t)r32v * 512 + 16 * d0 + 8 * hiv; kx[2 * d0] = *(const f32x4*)kp; kx[2 * d0 + 1] = *(const f32x4*)(kp + 4); }
#pragma unroll
        for (int i2 = 0; i2 < 8; ++i2) vx[i2] = *(const f32x4*)(vp + (size_t)(4 * i2) * 512);
        __builtin_amdgcn_sched_barrier(0);
        bf16x8 kf[4];
#pragma unroll
        for (int d0 = 0; d0 < 4; ++d0) { const f32x4 a = kx[2 * d0], b = kx[2 * d0 + 1];
            u32x4 pk; pk.x = pk2(a[0], a[1]); pk.y = pk2(a[2], a[3]); pk.z = pk2(b[0], b[1]); pk.w = pk2(b[2], b[3]); kf[d0] = __builtin_bit_cast(bf16x8, pk); }
        f32x16 c;
        if (FOX) {
            if (!isnew) {
#pragma unroll
                for (int g = 0; g < 4; ++g) { const f32x4 x = *(const f32x4*)(bcs + 32 * s + 8 * g + 4 * hiv); c[4 * g] = x[0]; c[4 * g + 1] = x[1]; c[4 * g + 2] = x[2]; c[4 * g + 3] = x[3]; }
            } else {
#pragma unroll
                for (int r = 0; r < 16; ++r) c[r] = __shfl(nbias, crow(r, hiv));
            }
        } else {
            if (!isnew) {
#pragma unroll
                for (int r = 0; r < 16; ++r) c[r] = slope2 * (float)(32 * s + crow(r, hiv) - 2048);
            } else {
#pragma unroll
                for (int r = 0; r < 16; ++r) { const int j = crow(r, hiv), v2 = 2 * r32v - j; c[r] = slope2 * (float)(j < v2 ? j : v2); }
            }
        }
#pragma unroll
        for (int d0 = 0; d0 < 4; ++d0) c = __builtin_amdgcn_mfma_f32_32x32x16_bf16(kf[d0], qr[d0], c, 0, 0, 0);
        if (FOX && isnew) {
#pragma unroll
            for (int r = 0; r < 16; ++r) if (crow(r, hiv) > r32v) c[r] = -INFINITY;
        }
        __builtin_amdgcn_sched_barrier(0);
#pragma unroll
        for (int i2 = 0; i2 < 8; ++i2) { const int kk = 4 * i2; v2u pk; pk.x = pk2(vx[i2][0], vx[i2][1]); pk.y = pk2(vx[i2][2], vx[i2][3]); *(LAS v2u*)(vdst + (kk >> 4) * 1024 + (kk & 15) * 64) = pk; }
        __builtin_amdgcn_sched_barrier(0);
        sm_pv<NDV, 2>(c, m, l, o, vbw, wsf, r32v, hiv);
    }
    { auto rr = __builtin_amdgcn_permlane32_swap(__float_as_uint(l), __float_as_uint(l), false, false); l = __uint_as_float(rr[0]) + __uint_as_float(rr[1]); }
    LAS float* Op = (LAS float*)myreg;
#pragma unroll
    for (int d0 = 0; d0 < NDV; ++d0)
#pragma unroll
        for (int r = 0; r < 16; ++r) Op[crow(r, hi) * 64 + 32 * d0 + r32] = o[d0][r];
    LAS float* ML = (LAS float*)(lds + ATT_ML);
    if (hi == 0) { ML[w * 64 + r32] = m; ML[w * 64 + 32 + r32] = l; }
    ABAR_L();
    const int q = tid >> 4, seg = tid & 15;
    const int g2 = FOX ? 0 : (seg >> 3), d = FOX ? seg * 4 : (seg & 7) * 8;
    float mw[NSP], M = -1e30f;
#pragma unroll
    for (int ww = 0; ww < NSP; ++ww) { mw[ww] = ML[(g2 * NSP + ww) * 64 + q]; M = fmaxf(M, mw[ww]); }
    float L = 0.f, acc[DPT];
#pragma unroll
    for (int k = 0; k < DPT; ++k) acc[k] = 0.f;
#pragma unroll
    for (int ww = 0; ww < NSP; ++ww) { const float sc = __builtin_amdgcn_exp2f(mw[ww] - M); L += sc * ML[(g2 * NSP + ww) * 64 + 32 + q];
        LAS const float* src = (LAS const float*)(lds + (g2 * NSP + ww) * 16384) + q * 64 + d;
#pragma unroll
        for (int k = 0; k < DPT; ++k) acc[k] += sc * src[k]; }
    const float rl = 1.0f / L;
#pragma unroll
    for (int k = 0; k < DPT; ++k) res[k] = acc[k] * rl;
    ABAR_L();
}
}

__device__ __forceinline__ float wave_sum(float v) {
#pragma unroll
    for (int o = 1; o < 64; o <<= 1) v += __shfl_xor(v, o);
    return v;
}
__device__ __forceinline__ int src_col(int map, int n) {
    if (map == 0) return n;
    if (map == 1) { const int tile = n >> 8, i = n & 255; return i < 128 ? 128 * tile + i : DFF + 128 * tile + (i - 128); }
    if (n < 1536) return n;
    if (n < 3072) return n + 8;
    if (n < 3080) return 1536 + (n - 3072);
    return -1;
}
__device__ __forceinline__ void p0_transpose_item(const float* W, int K, int Nsrc, bf16* WT, const float* gain, int map, int nblk, LAS float* scr, int item, int lane) {
    const int kb = item / nblk, nb = item % nblk, k0 = 64 * kb, n0 = 32 * nb;
    const int sc = src_col(map, n0 + (lane & 31));
#pragma unroll 8
    for (int i = 0; i < 32; ++i) { const int kk = 2 * i + (lane >> 5); float v = sc >= 0 ? W[(size_t)(k0 + kk) * Nsrc + sc] : 0.f; if (gain) v *= gain[k0 + kk]; scr[kk * 33 + (lane & 31)] = v; }
    LDS_WAIT(); asm volatile("" ::: "memory");
    const int c = lane & 7;
#pragma unroll
    for (int j = 0; j < 4; ++j) { const int n = (lane >> 3) + 8 * j; const LAS float* s = scr + (8 * c) * 33 + n;
        v4u o; o.x = pk2(s[0 * 33], s[1 * 33]); o.y = pk2(s[2 * 33], s[3 * 33]); o.z = pk2(s[4 * 33], s[5 * 33]); o.w = pk2(s[6 * 33], s[7 * 33]);
        *(GAS v4u*)(WT + (size_t)(n0 + n) * K + k0 + 8 * c) = o; }
    LDS_WAIT(); asm volatile("" ::: "memory");
}

#define XB_TMO      128
#define XB_XCNT(j)  (256  + 64 * (j))
#define XB_XSUB(j)  (1280 + 64 * (j))
#define XB_XGEN(j)  (2304 + 64 * (j))
#define XB_TOP      3328
#define XB_TOPGEN   3392
#define XCD_BAR_WORDS 3456
#define XB_SPIN_CAP (1u << 18)

__device__ __forceinline__ unsigned xb_ld(unsigned* p)              { return __hip_atomic_load(p, __ATOMIC_RELAXED, __HIP_MEMORY_SCOPE_AGENT); }
__device__ __forceinline__ unsigned xb_add(unsigned* p, unsigned v) { return __hip_atomic_fetch_add(p, v, __ATOMIC_RELAXED, __HIP_MEMORY_SCOPE_AGENT); }
__device__ __forceinline__ unsigned xb_xcc_id() { return (unsigned)__builtin_amdgcn_s_getreg((3 << 11) | 20) & 0xFu; }
#define XB_SPIN(cond, bar) do { unsigned _sp = 0; while (cond) { __builtin_amdgcn_s_sleep(1); \
    if ((++_sp & 255u) == 0u) { if (xb_ld(&(bar)[XB_TMO])) break; if (_sp > XB_SPIN_CAP) { atomicAdd(&(bar)[XB_TMO], 1u); break; } } } } while (0)

struct XcdBarrier {
    unsigned* bar; unsigned x;
    volatile LAS unsigned* st;
};

__device__ __forceinline__ XcdBarrier xcd_barrier_post(unsigned* bar, volatile LAS unsigned* st) {
    XcdBarrier b; b.bar = bar; b.x = xb_xcc_id(); b.st = st;
    if (threadIdx.x == 0) (void)xb_add(&bar[XB_XCNT(b.x)], 1u);
    return b;
}
__device__ __forceinline__ void xcd_barrier_complete(unsigned* bar, unsigned x, unsigned& nloc, unsigned& nx) {
    const unsigned G = gridDim.x * gridDim.y * gridDim.z;
    unsigned sum, cnt, mine, sp = 0u;
    for (;;) {
        sum = 0u; cnt = 0u; mine = 0u;
#pragma unroll
        for (unsigned j = 0; j < 16; ++j) { const unsigned c = xb_ld(&bar[XB_XCNT(j)]); sum += c; cnt += (c > 0u) ? 1u : 0u; mine = (j == x) ? c : mine; }
        if (sum == G) break;
        __builtin_amdgcn_s_sleep(1);
        if ((++sp & 255u) == 0u) { if (xb_ld(&bar[XB_TMO])) break; if (sp > XB_SPIN_CAP) { atomicAdd(&bar[XB_TMO], 1u); break; } }
    }
    nloc = mine > 0u ? mine : 1u; nx = cnt > 0u ? cnt : 1u;
}

__device__ __forceinline__ void xcd_barrier(const XcdBarrier& b) {
    asm volatile("s_waitcnt vmcnt(0)" ::: "memory");
    __syncthreads();
    if (threadIdx.x == 0) {
        unsigned* bar = b.bar;
        __builtin_amdgcn_s_waitcnt(0);
        unsigned nloc = b.st[0], nx = b.st[1];
        if (nloc == 0u) { xcd_barrier_complete(bar, b.x, nloc, nx); b.st[0] = nloc; b.st[1] = nx; }
        const unsigned old = xb_add(&bar[XB_XSUB(b.x)], 1u);
        const unsigned gen = old / nloc;
        if (old + 1u == (gen + 1u) * nloc) {
            __builtin_amdgcn_fence(__ATOMIC_RELEASE, "agent");
            asm volatile("s_waitcnt vmcnt(0)" ::: "memory");
            const unsigned og = xb_add(&bar[XB_TOP], 1u);
            const unsigned tg = og / nx;
            if (og + 1u == (tg + 1u) * nx) xb_add(&bar[XB_TOPGEN], 1u);
            else XB_SPIN(xb_ld(&bar[XB_TOPGEN]) == tg, bar);
            __builtin_amdgcn_fence(__ATOMIC_ACQUIRE, "agent");
            xb_add(&bar[XB_XGEN(b.x)], 1u);
            asm volatile("s_waitcnt vmcnt(0)" ::: "memory");
        } else {
            XB_SPIN(xb_ld(&bar[XB_XGEN(b.x)]) == gen, bar);
            __builtin_amdgcn_fence(__ATOMIC_ACQUIRE, "agent");
            asm volatile("s_waitcnt vmcnt(0)" ::: "memory");
        }
    }
    __syncthreads();
}

constexpr int NPHASES = 9;
#ifndef DBG_PHMASK
#define DBG_PHMASK 0x1ff
#endif
#define PHEN(k) ((DBG_PHMASK >> (k)) & 1)
#ifndef DBG_UMASK
#define DBG_UMASK 0xf
#endif
#define UEN(k) ((DBG_UMASK >> (k)) & 1)
constexpr int N_LAUNCHES = MK_N_LAUNCHES;
constexpr int NUNITS = 1152;
struct Args { const float* in[23]; float* out; unsigned char* ws; int ph_lo, ph_hi; };

__global__ void __launch_bounds__(NWAVES * 64, 2) mk_fwd(Args args) {
    extern __shared__ __attribute__((aligned(16))) unsigned char lds_raw[];
    LAS unsigned char* lds = (LAS unsigned char*)lds_raw;
    volatile LAS unsigned* MISC = (volatile LAS unsigned*)(lds + MISC_OFF);
    const int tid = threadIdx.x, lane = tid & 63, wave = __builtin_amdgcn_readfirstlane(tid >> 6);
    const int G = gridDim.x, bx = blockIdx.x, vcu = (G % 8 == 0) ? (bx % 8) * (G / 8) + bx / 8 : bx;
    unsigned char* ws = args.ws; gu32* ctl = (gu32*)(ws + WS_CTL);
    float* out = args.out;
    bf16* W1I = (bf16*)(ws + WS_W1I); bf16* W1O = (bf16*)(ws + WS_W1O); bf16* WIN = (bf16*)(ws + WS_WIN); bf16* WOUT = (bf16*)(ws + WS_WOUT); bf16* W2I = (bf16*)(ws + WS_W2I); bf16* W2O = (bf16*)(ws + WS_W2O);
    float* BC = (float*)(ws + WS_BC); float* SS0 = (float*)(ws + WS_SS0); float* SS1 = (float*)(ws + WS_CTL) + CW_SS1; float* SS2 = (float*)(ws + WS_CTL) + CW_SS2;
    bf16* XA = (bf16*)(ws + WS_XA); bf16* HB = (bf16*)(ws + WS_H); float* X1 = (float*)(ws + WS_X1); float* X2 = (float*)(ws + WS_X2);
    bf16* QKV = (bf16*)(ws + WS_QKV); bf16* OB = (bf16*)(ws + WS_OB); float* OSCR = (float*)(ws + WS_OSCR);

    for (int u = tid; u < (LDS_BYTES - LDSCTL_OFF) / 4; u += NWAVES * 64) ((LAS unsigned*)(lds + LDSCTL_OFF))[u] = 0u;
    __syncthreads();
    XcdBarrier bar; bar.bar = (unsigned*)(ctl + CW_BAR); bar.x = 0; bar.st = nullptr;
    if (N_LAUNCHES == 1) bar = xcd_barrier_post((unsigned*)(ctl + CW_BAR), MISC + 8);

    const int gw = vcu * NWAVES + wave, NGW = G * NWAVES;
    for (int ph = args.ph_lo; ph < args.ph_hi; ++ph) {
        int tidp = tid; asm volatile("" : "+v"(tidp));
        const int lanep = tidp & 63;
        if (ph == 0 && PHEN(0)) {
            LAS float* scr = (LAS float*)(lds + wave * 16384);
            constexpr int I_1I = 16 * 176, I_1O = 44 * 32, I_IN = 16 * 104, I_O = 16 * 32;
            constexpr int NITEMS = 2 * (I_1I + I_1O) + I_IN + I_O;
            for (int it = gw; it < NITEMS; it += NGW) {
                int r = it;
                if (r < I_1I) { p0_transpose_item(args.in[8], 1024, NFF, W1I, args.in[7], 1, 176, scr, r, lanep); continue; } r -= I_1I;
                if (r < I_1O) { p0_transpose_item(args.in[9], 2816, 1024, W1O, nullptr, 0, 32, scr, r, lanep); continue; } r -= I_1O;
                if (r < I_IN) { p0_transpose_item(args.in[11], 1024, 3080, WIN, args.in[10], 2, 104, scr, r, lanep); continue; } r -= I_IN;
                if (r < I_O) { p0_transpose_item(args.in[18], 1024, 1024, WOUT, nullptr, 0, 32, scr, r, lanep); continue; } r -= I_O;
                if (r < I_1I) { p0_transpose_item(args.in[20], 1024, NFF, W2I, args.in[19], 1, 176, scr, r, lanep); continue; } r -= I_1I;
                p0_transpose_item(args.in[21], 2816, 1024, W2O, nullptr, 0, 32, scr, r, lanep);
            }
            for (int m = gw; m < MT; m += NGW) {
                const float* xrow = m < MP ? args.in[0] + (size_t)m * 1024 : args.in[1] + (size_t)(m - MP) * 1024;
                const GAS f32x4* xr = (const GAS f32x4*)xrow + lanep; f32x4 v[4]; float s = 0.f;
#pragma unroll
                for (int j = 0; j < 4; ++j) { v[j] = xr[64 * j]; s += (v[j].x * v[j].x + v[j].y * v[j].y) + (v[j].z * v[j].z + v[j].w * v[j].w); }
                s = wave_sum(s); if (lanep == 0) SS0[m] = s;
                GAS v2u* o8 = (GAS v2u*)(XA + (size_t)m * 1024) + lanep;
#pragma unroll
                for (int j = 0; j < 4; ++j) { v2u p; p.x = pk2(v[j].x, v[j].y); p.y = pk2(v[j].z, v[j].w); o8[64 * j] = p; }
            }
            for (int j = gw; j < 256; j += NGW) {
                const float* lf = args.in[4] + (size_t)(j >> 3) * 2048 * 8 + (j & 7);
                float e[32]; float run = 0.f;
#pragma unroll
                for (int i = 31; i >= 0; --i) { const float v = lf[(size_t)(32 * lanep + i) * 8]; e[i] = run; run += v; }
                float v = run;
#pragma unroll
                for (int o = 1; o < 64; o <<= 1) { const float t = __shfl_down(v, o); if (lanep + o < 64) v += t; }
                const float excl = v - run;
                float* dst = BC + (size_t)j * 2048 + 32 * lanep;
#pragma unroll
                for (int i = 0; i < 32; i += 4) { f32x4 q; q.x = (e[i] + excl) * LOG2E; q.y = (e[i + 1] + excl) * LOG2E; q.z = (e[i + 2] + excl) * LOG2E; q.w = (e[i + 3] + excl) * LOG2E; *(f32x4*)(dst + i) = q; }
            }
        } else if ((ph == 1 || ph == 6) && PHEN(1)) {
            pg8::Gemm g{XA, ph == 1 ? W1I : W2I, MT, NFF, 1024}; pg8::StaticOrder S; S.init(MT, NFF, G, bx);
            pg8::EpiSwiglu E{HB, ph == 1 ? SS0 : SS2};
            pg8::gemm_phase<pg8::EpiSwiglu, pg8::StaticOrder, true, true>(lds + RING_OFF, g, S, E, tidp);
        } else if ((ph == 2 || ph == 5 || ph == 7) && PHEN(2)) {
            pg8::Gemm g{ph == 5 ? OB : HB, ph == 2 ? W1O : (ph == 5 ? WOUT : W2O), MT, 1024, ph == 5 ? 1024 : 2816}; pg8::StaticOrder S; S.init(MT, 1024, G, bx);
            pg8::EpiResid E;
            if (ph == 2) { E.base0 = args.in[0]; E.base1 = args.in[1]; E.out = X1; E.xa = XA; E.ssout = SS1; E.alpha = 0.5f; }
            else if (ph == 5) { E.base0 = X1; E.base1 = X1 + (size_t)MP * 1024; E.out = X2; E.xa = XA; E.ssout = SS2; E.alpha = 1.0f; }
            else { E.base0 = X2; E.base1 = X2 + (size_t)MP * 1024; E.out = out + O_Y; E.xa = nullptr; E.ssout = nullptr; E.alpha = 0.5f; }
            pg8::gemm_phase<pg8::EpiResid, pg8::StaticOrder, true, true>(lds + RING_OFF, g, S, E, tidp);
        } else if (ph == 3 && PHEN(3)) {
            pg8::Gemm g{XA, WIN, MT, NINP, 1024}; pg8::StaticOrder S; S.init(MT, NINP, G, bx);
            pg8::EpiInProj E{QKV, out, SS1, args.in[12]};
            pg8::gemm_phase<pg8::EpiInProj, pg8::StaticOrder, true, true>(lds + RING_OFF, g, S, E, tidp);
        } else if (ph == 4 && PHEN(4)) {
            const float lam = expf(wave_sum(args.in[13][lanep] * args.in[14][lanep])) - expf(wave_sum(args.in[15][lanep] * args.in[16][lanep])) + LAMBDA_INIT;
            LAS char* al = (LAS char*)lds;
            for (;;) {
                if (tidp == 0) *(volatile LAS unsigned*)(lds + ATT_TMP + 64) = __hip_atomic_fetch_add(ctl + CW_QUEUE, 1u, RLX_AGENT);
                __syncthreads();
                const int idx = __builtin_amdgcn_readfirstlane(*(volatile LAS unsigned*)(lds + ATT_TMP + 64));
                __syncthreads();
                if (idx >= NUNITS) break;
                int tid2 = tidp; asm volatile("" : "+v"(tid2));
                const int lane2 = tid2 & 63, r32 = lane2 & 31, hi = lane2 >> 5;
                if (idx < 128 || (idx >= 256 && idx < 512)) {
                    const int q = tid2 >> 4, seg = tid2 & 15;
                    if (idx < 128 && UEN(0)) {
                        const int b = idx >> 2, h = idx & 3; const size_t rowq = (size_t)MP + b * 32;
                        const float slope2 = (0.25f / (float)(1 << (2 * h))) * LOG2E;
                        float r0[8], r1[8];
                        att::sample_pass<false>(QKV + rowq * 3072 + 1536 + h * 128, args.in[5] + ((size_t)b * 2048 * 4 + h) * 128, out + O_DKS + (size_t)(b * 32) * 512 + h * 128,
                                                   args.in[6] + ((size_t)b * 2048 * 4 + h) * 128, out + O_DVS + (size_t)(b * 32) * 512 + h * 128, nullptr, nullptr, slope2, wave, lane2, tid2, al, r0);
                        att::sample_pass<false>(QKV + rowq * 3072 + 1536 + h * 128 + 64, args.in[5] + ((size_t)b * 2048 * 4 + h) * 128 + 64, out + O_DKS + (size_t)(b * 32) * 512 + h * 128 + 64,
                                                   args.in[6] + ((size_t)b * 2048 * 4 + h) * 128, out + O_DVS + (size_t)(b * 32) * 512 + h * 128, nullptr, nullptr, slope2, wave, lane2, tid2, al, r1);
                        float ss = 0.f;
#pragma unroll
                        for (int k = 0; k < 8; ++k) { r0[k] -= lam * r1[k]; ss += r0[k] * r0[k]; }
                        ss += __shfl_xor(ss, 1); ss += __shfl_xor(ss, 2); ss += __shfl_xor(ss, 4); ss += __shfl_xor(ss, 8);
                        const float rn = __builtin_amdgcn_rsqf(ss * (1.0f / 128.0f) + EPS) * (1.0f - LAMBDA_INIT);
                        const float* gs = args.in[17] + seg * 8;
                        v4u w; w.x = pk2(r0[0] * rn * gs[0], r0[1] * rn * gs[1]); w.y = pk2(r0[2] * rn * gs[2], r0[3] * rn * gs[3]); w.z = pk2(r0[4] * rn * gs[4], r0[5] * rn * gs[5]); w.w = pk2(r0[6] * rn * gs[6], r0[7] * rn * gs[7]);
                        *(v4u*)(OB + (rowq + q) * 1024 + 512 + h * 128 + seg * 8) = w;
                    } else if (idx >= 256 && UEN(1)) {
                        const int j = idx - 256, b = j >> 3, h = j & 7; const size_t rowq = (size_t)MP + b * 32;
                        float r0[4];
                        att::sample_pass<true>(QKV + rowq * 3072 + h * 64, args.in[2] + ((size_t)b * 2048 * 8 + h) * 64, out + O_FKS + (size_t)(b * 32) * 512 + h * 64,
                                                  args.in[3] + ((size_t)b * 2048 * 8 + h) * 64, out + O_FVS + (size_t)(b * 32) * 512 + h * 64, BC + (size_t)(b * 8 + h) * 2048, out + O_FLS + (size_t)(b * 32) * 8 + h, 0.f, wave, lane2, tid2, al, r0);
                        v2u w; w.x = pk2(r0[0], r0[1]); w.y = pk2(r0[2], r0[3]);
                        *(v2u*)(OB + (rowq + q) * 1024 + h * 64 + seg * 4) = w;
                    }
                } else if (idx >= 640 && UEN(2)) {
                    const int j = idx - 640, qb = 7 - (j >> 6), b = (j & 63) >> 3, h = j & 7; const size_t R0 = (size_t)b * SEQ + 256 * qb;
                    att::fox_bias_scan(out + O_FLP + (size_t)b * SEQ * 8 + h, 256 * (qb + 1), qb, al, tid2, lane2, wave);
                    att::f32x16 o[2];
                    att::prompt_pass<2, true>(QKV + (R0 + 32 * wave) * 3072 + h * 64, QKV + (size_t)b * SEQ * 3072 + 512 + h * 64, QKV + (size_t)b * SEQ * 3072 + 1024 + h * 64, qb, wave, lane2, al, 0.f, o);
                    bf16* Ow = OB + (R0 + 32 * wave) * 1024 + h * 64;
#pragma unroll
                    for (int d0 = 0; d0 < 2; ++d0)
#pragma unroll
                        for (int r = 0; r < 16; ++r) Ow[(size_t)att::crow(r, hi) * 1024 + 32 * d0 + r32] = (bf16)(pk2(o[d0][r], 0.f) & 0xffffu);
                } else if (UEN(3)) {
                    const int j = idx < 256 ? idx - 128 : idx - 512, qb = (idx < 256 ? 7 : 3) - (j >> 5), b = (j & 31) >> 2, h = j & 3; const size_t R0 = (size_t)b * SEQ + 256 * qb;
                    const float slope2 = (0.25f / (float)(1 << (2 * h))) * LOG2E;
                    float* scr = OSCR + ((size_t)bx * 512 + tid2) * 64;
                    att::f32x16 o[4];
                    for (int e = 0; e < 2; ++e) {
                        att::prompt_pass<4, false>(QKV + (R0 + 32 * wave) * 3072 + 1536 + h * 128 + e * 64, QKV + (size_t)b * SEQ * 3072 + 2048 + h * 128 + e * 64, QKV + (size_t)b * SEQ * 3072 + 2560 + h * 128, qb, wave, lane2, al, slope2, o);
                        if (e == 0) {
#pragma unroll
                            for (int d0 = 0; d0 < 4; ++d0)
#pragma unroll
                                for (int g = 0; g < 4; ++g) { f32x4 t; t.x = o[d0][4 * g]; t.y = o[d0][4 * g + 1]; t.z = o[d0][4 * g + 2]; t.w = o[d0][4 * g + 3]; *(f32x4*)(scr + d0 * 16 + 4 * g) = t; }
                        }
                    }
                    float ssr[16];
#pragma unroll
                    for (int r = 0; r < 16; ++r) ssr[r] = 0.f;
#pragma unroll
                    for (int d0 = 0; d0 < 4; ++d0)
#pragma unroll
                        for (int g = 0; g < 4; ++g) { const f32x4 t = *(const f32x4*)(scr + d0 * 16 + 4 * g);
#pragma unroll
                            for (int k = 0; k < 4; ++k) { const float v = t[k] - lam * o[d0][4 * g + k]; o[d0][4 * g + k] = v; ssr[4 * g + k] += v * v; } }
                    bf16* Ow = OB + (R0 + 32 * wave) * 1024 + 512 + h * 128;
                    float gsub[4];
#pragma unroll
                    for (int d0 = 0; d0 < 4; ++d0) gsub[d0] = args.in[17][32 * d0 + r32] * (1.0f - LAMBDA_INIT);
#pragma unroll
                    for (int r = 0; r < 16; ++r) { float s = ssr[r]; s += __shfl_xor(s, 1); s += __shfl_xor(s, 2); s += __shfl_xor(s, 4); s += __shfl_xor(s, 8); s += __shfl_xor(s, 16);
                        const float rn = __builtin_amdgcn_rsqf(s * (1.0f / 128.0f) + EPS);
#pragma unroll
                        for (int d0 = 0; d0 < 4; ++d0) Ow[(size_t)att::crow(r, hi) * 1024 + 32 * d0 + r32] = (bf16)(pk2(o[d0][r] * rn * gsub[d0], 0.f) & 0xffffu); }
                }
            }
        } else if (ph == 8 && PHEN(8)) {
            for (int m = gw; m < MT; m += NGW) {
                GAS f32x4* yr = (GAS f32x4*)(out + O_Y + (size_t)m * 1024) + lanep; const GAS f32x4* gf = (const GAS f32x4*)args.in[22] + lanep; f32x4 v[4]; float s = 0.f;
#pragma unroll
                for (int j = 0; j < 4; ++j) { v[j] = yr[64 * j]; s += (v[j].x * v[j].x + v[j].y * v[j].y) + (v[j].z * v[j].z + v[j].w * v[j].w); }
                const float rs = __builtin_amdgcn_rsqf(wave_sum(s) * (1.0f / 1024.0f) + EPS);
#pragma unroll
                for (int j = 0; j < 4; ++j) yr[64 * j] = v[j] * rs * gf[64 * j];
            }
        }
        if (ph + 1 < args.ph_hi) xcd_barrier(bar);
    }
}

extern "C" void kernel_launch(void* const* d_in, const int* in_sizes, int n_in, void* d_out, int out_size, void* d_ws, size_t ws_size, hipStream_t stream) {
    static int grid = 0;
    if (grid == 0) {
        if (n_in != 23 || in_sizes[0] != MP * DM || (size_t)out_size != O_END || ws_size < WS_END) {
            fprintf(stderr, "kernel_launch: unexpected problem: n_in %d in0 %d out %d ws %zu; nothing launched\n", n_in, n_in > 0 ? in_sizes[0] : -1, out_size, ws_size); grid = -1; return; }
        int dev = 0, cus = 0, per_cu = 0;
        if (hipGetDevice(&dev) != hipSuccess || hipDeviceGetAttribute(&cus, hipDeviceAttributeMultiprocessorCount, dev) != hipSuccess) { fprintf(stderr, "kernel_launch: device query failed\n"); grid = -1; return; }
        if (hipFuncSetAttribute((const void*)mk_fwd, hipFuncAttributeMaxDynamicSharedMemorySize, LDS_BYTES) != hipSuccess) { fprintf(stderr, "kernel_launch: hipFuncSetAttribute failed\n"); grid = -1; return; }
        if (hipOccupancyMaxActiveBlocksPerMultiprocessor(&per_cu, (const void*)mk_fwd, NWAVES * 64, LDS_BYTES) != hipSuccess || per_cu < 1) {
            fprintf(stderr, "kernel_launch: occupancy query reports %d workgroups per CU; nothing launched\n", per_cu); (void)hipGetLastError(); grid = -1; return; }
        (void)hipGetLastError();
        grid = cus;
    }
    if (grid < 0) return;
    if (hipMemsetAsync((char*)d_ws + WS_CTL, 0, CTL_ZERO_BYTES, stream) != hipSuccess) { fprintf(stderr, "kernel_launch: memset failed\n"); return; }
    Args a{};
    for (int i = 0; i < 23; ++i) a.in[i] = (const float*)d_in[i];
    a.out = (float*)d_out; a.ws = (unsigned char*)d_ws;
    for (int li = 0; li < N_LAUNCHES; ++li) {
        a.ph_lo = (N_LAUNCHES == 1) ? 0 : li; a.ph_hi = (N_LAUNCHES == 1) ? NPHASES : li + 1;
        hipLaunchKernelGGL(mk_fwd, dim3(grid), dim3(NWAVES * 64), LDS_BYTES, stream, a);
        const hipError_t le = hipPeekAtLastError();
        if (le != hipSuccess) { fprintf(stderr, "kernel_launch: launch %d failed: %s\n", li, hipGetErrorName(le)); break; }
    }
}
```

```cpp
#include <hip/hip_runtime.h>
#include <hip/hip_bf16.h>
#include <cstdio>
#include <cstdint>
#include <cmath>

#ifndef MK_N_LAUNCHES
#define MK_N_LAUNCHES 1
#endif

constexpr int DM = 1024, NBP = 8, SEQ = 2048, NBS = 32, TSM = 32, PAST = 2048;
constexpr int MP = NBP * SEQ, MS = NBS * TSM, MT = MP + MS;
constexpr int DFF = 2816, NFF = 2 * DFF, NINP = 3328, NQKV = 3072;
constexpr float EPS = 1e-6f, LOG2E = 1.4426950408889634f, C2 = 0.125f * 1.4426950408889634f;
constexpr float LAMBDA_INIT = 0.2f;
constexpr size_t O_Y = 0;
constexpr size_t O_FKP = 17825792, O_FVP = 26214400, O_FLP = 34603008, O_DKP = 34734080, O_DVP = 43122688;
constexpr size_t O_FKS = 51511296, O_FVS = 52035584, O_FLS = 52559872, O_DKS = 52568064, O_DVS = 53092352, O_END = 53616640;

constexpr size_t MiB = 1u << 20;
constexpr size_t WS_CTL = 0, CTL_ZERO_BYTES = 1 * MiB;
constexpr size_t WS_W1I = 2 * MiB, WS_W1O = 14 * MiB, WS_WIN = 20 * MiB, WS_WOUT = 27 * MiB, WS_W2I = 30 * MiB, WS_W2O = 42 * MiB;
constexpr size_t WS_BC = 48 * MiB, WS_SS0 = 50 * MiB;
constexpr size_t WS_XA = 64 * MiB, WS_H = 100 * MiB, WS_X1 = 196 * MiB, WS_X2 = 264 * MiB, WS_QKV = 332 * MiB, WS_OB = 434 * MiB, WS_OSCR = 468 * MiB, WS_END = 500 * MiB;
constexpr int CW_BAR = 4096;
constexpr int CW_QUEUE = 8192;
constexpr int CW_SS1 = 65536, CW_SS2 = 65536 + 32768;
static_assert((CW_SS2 + 32768) * 4 <= (int)CTL_ZERO_BYTES, "CTL region");

constexpr int RING_OFF = 0, RING_BYTES = 131072;
constexpr int ATT_WSF = 131072, ATT_ML = 135168, ATT_TMP = 137216;
constexpr int LDSCTL_OFF = 143360, MISC_OFF = LDSCTL_OFF + 320;
constexpr int LDS_BYTES = 147456;
constexpr int NWAVES = 8;

#define GAS __attribute__((address_space(1)))
#define LAS __attribute__((address_space(3)))
typedef unsigned short bf16;
typedef unsigned v4u __attribute__((ext_vector_type(4)));
typedef unsigned v2u __attribute__((ext_vector_type(2)));
typedef float f32x4 __attribute__((ext_vector_type(4)));
typedef GAS unsigned gu32;
#define RLX_AGENT __ATOMIC_RELAXED, __HIP_MEMORY_SCOPE_AGENT
#define LDS_WAIT() asm volatile("s_waitcnt lgkmcnt(0)" ::: "memory")
#define VM_WAIT() asm volatile("s_waitcnt vmcnt(0)" ::: "memory")
typedef float f32x2_t __attribute__((ext_vector_type(2))); typedef __bf16 bf16x2_t __attribute__((ext_vector_type(2)));
__device__ __forceinline__ unsigned pk2(float lo, float hi) { f32x2_t v = {lo, hi}; bf16x2_t b = __builtin_convertvector(v, bf16x2_t); return __builtin_bit_cast(unsigned, b); }

namespace pg8 {
#define PG8_LAS __attribute__((address_space(3)))
typedef unsigned short bf16_t;
typedef short bf16x8 __attribute__((ext_vector_type(8)));
typedef float f32x4 __attribute__((ext_vector_type(4)));
typedef unsigned u32x4 __attribute__((ext_vector_type(4)));
constexpr int BM = 256, BK = 64, HALF = 128, HTB = HALF * BK * 2  , STAGE_BYTES = 8 * HTB, NXCD = 8, WGM = 8;

__host__ __device__ __forceinline__ int lds_byte(int r, int c) { const int st = (r >> 4) * 2 + (c >> 5), rr = r & 15, cc = c & 31, ob = rr * 64 + cc * 2; return st * 1024 + (ob ^ (((ob >> 9) & 1) << 5)); }
__host__ __device__ __forceinline__ void stage_rc(int b, int& R, int& C) { const int st = b / 1024, sb = b % 1024, swz = sb ^ (((sb >> 9) & 1) << 5); R = (st >> 1) * 16 + swz / 64; C = (st & 1) * 32 + (swz % 64) / 2; }
__host__ __device__ __forceinline__ int perm32(int rho) { const int n = rho >> 4, i = rho & 15; return 8 * (i >> 2) + 4 * n + (i & 3); }

struct Unit { int pm, pn; };
struct Gemm { const bf16_t* A; const bf16_t* Bt; int M, N, K; };

struct StaticOrder {
    int nM, nN, nwg, G, c;
    __host__ __device__ void init(int M, int N, int G_, int c_) { nM = M / BM; nN = N / BM; nwg = nM * nN; G = G_; c = c_; }
    __host__ __device__ bool next(int i, Unit& u) const {
        const long L = (long)i * G + c; if (L >= nwg) return false;
        int wgid = (int)L; { const int q = nwg / NXCD, r = nwg % NXCD, xcd = wgid % NXCD, off = wgid / NXCD; wgid = (xcd < r ? xcd * (q + 1) : r * (q + 1) + (xcd - r) * q) + off; }
        const int nig = WGM * nN, gid = wgid / nig, fm = gid * WGM, gsz = (nM - fm) < WGM ? (nM - fm) : WGM;
        u.pm = fm + ((wgid % nig) % gsz); u.pn = (wgid % nig) / gsz; return true;
    }
    __device__ __forceinline__ void a_ready(const Unit&) const {}
    __device__ __forceinline__ void done(const Unit&) const {}
};

__device__ __forceinline__ unsigned cvt_pk_bf16(float lo, float hi) { unsigned r; asm volatile("v_cvt_pk_bf16_f32 %0, %1, %2" : "=v"(r) : "v"(lo), "v"(hi)); return r; }
typedef float f32x2 __attribute__((ext_vector_type(2)));
struct EpiSwiglu {
    static constexpr bool PERM = true, AFTER_DRAIN = false;
    bf16_t* H; const float* ss;
    __device__ __forceinline__ void operator()(const f32x4 (&acc)[2][2][4][2], const Unit& u, int wr, int wc, int fr, int fq) const {
        const int row0 = u.pm * BM + wr * 64 + fr, hcol = u.pn * 128 + wc * 32 + 8 * fq;
#pragma unroll
        for (int ai = 0; ai < 2; ++ai)
#pragma unroll
            for (int m = 0; m < 4; ++m) {
                const int row = row0 + ai * HALF + m * 16;
                const float rs = __builtin_amdgcn_rsqf(ss[row] * (1.0f / 1024.0f) + 1e-6f);
                float h[8];
#pragma unroll
                for (int n = 0; n < 2; ++n)
#pragma unroll
                    for (int j = 0; j < 4; ++j) {
                        const float g = acc[ai][0][m][n][j] * rs, uu = acc[ai][1][m][n][j] * rs;
                        const float e = __builtin_amdgcn_exp2f(g * -1.4426950408889634f);
                        h[n * 4 + j] = g * uu * __builtin_amdgcn_rcpf(1.0f + e);
                    }
                u32x4 w; w.x = cvt_pk_bf16(h[0], h[1]); w.y = cvt_pk_bf16(h[2], h[3]); w.z = cvt_pk_bf16(h[4], h[5]); w.w = cvt_pk_bf16(h[6], h[7]);
                *(u32x4*)(H + (size_t)row * 2816 + hcol) = w;
            }
    }
};
struct EpiResid {
    static constexpr bool PERM = true, AFTER_DRAIN = false;
    const float* base0; const float* base1;
    float* out; bf16_t* xa; float* ssout; float alpha;
    __device__ __forceinline__ void operator()(const f32x4 (&acc)[2][2][4][2], const Unit& u, int wr, int wc, int fr, int fq) const {
        const float* bb = (u.pm < 64) ? base0 + (size_t)(u.pm * BM) * 1024 : base1 + (size_t)(u.pm * BM - 16384) * 1024;
        const int col0 = u.pn * BM + wc * 32 + 8 * fq;
#pragma unroll
        for (int ai = 0; ai < 2; ++ai)
#pragma unroll
            for (int m = 0; m < 4; ++m) {
                const int rl = wr * 64 + fr + ai * HALF + m * 16; const size_t row = (size_t)u.pm * BM + rl;
                float sq = 0.f;
#pragma unroll
                for (int bj = 0; bj < 2; ++bj) {
                    const float* bp = bb + (size_t)rl * 1024 + col0 + bj * HALF;
                    const f32x4 b0 = *(const f32x4*)bp, b1 = *(const f32x4*)(bp + 4);
                    const f32x4 v0 = b0 + acc[ai][bj][m][0] * alpha, v1 = b1 + acc[ai][bj][m][1] * alpha;
                    float* op = out + row * 1024 + col0 + bj * HALF;
                    *(f32x4*)op = v0; *(f32x4*)(op + 4) = v1;
                    if (xa) { u32x4 w; w.x = cvt_pk_bf16(v0[0], v0[1]); w.y = cvt_pk_bf16(v0[2], v0[3]); w.z = cvt_pk_bf16(v1[0], v1[1]); w.w = cvt_pk_bf16(v1[2], v1[3]);
                        *(u32x4*)(xa + row * 1024 + col0 + bj * HALF) = w; }
                    sq += (v0[0] * v0[0] + v0[1] * v0[1]) + (v0[2] * v0[2] + v0[3] * v0[3]) + (v1[0] * v1[0] + v1[1] * v1[1]) + (v1[2] * v1[2] + v1[3] * v1[3]);
                }
                if (ssout) { sq += __shfl_xor(sq, 16); sq += __shfl_xor(sq, 32);
                    if (fq == 0) __hip_atomic_fetch_add(ssout + row, sq, __ATOMIC_RELAXED, __HIP_MEMORY_SCOPE_AGENT); }
                if (m & 1) asm volatile("" ::: "memory");
            }
    }
};
struct EpiInProj {
    static constexpr bool PERM = true, AFTER_DRAIN = false;
    bf16_t* qkv; float* out; const float* ss; const float* bfg;
    __device__ __forceinline__ void operator()(const f32x4 (&acc)[2][2][4][2], const Unit& u, int wr, int wc, int fr, int fq) const {
        const int pn = u.pn, row0 = u.pm * BM + wr * 64 + fr;
        if (pn < 12) {
            const int kind = pn >> 1; const bool isq = (kind == 0 || kind == 3); const float sc = isq ? 0.125f * 1.4426950408889634f : 1.0f;
            size_t offp = 0, offs = 0;
            if (kind == 1) { offp = 17825792; offs = 51511296; } else if (kind == 2) { offp = 26214400; offs = 52035584; }
            else if (kind == 4) { offp = 34734080; offs = 52568064; } else if (kind == 5) { offp = 43122688; offs = 53092352; }
            const int cc = (pn & 1) * 256 + wc * 32 + 8 * fq, bc = pn * 256 + wc * 32 + 8 * fq;
#pragma unroll
            for (int ai = 0; ai < 2; ++ai)
#pragma unroll
                for (int m = 0; m < 4; ++m) {
                    const int row = row0 + ai * HALF + m * 16;
                    const float rs = __builtin_amdgcn_rsqf(ss[row] * (1.0f / 1024.0f) + 1e-6f);
                    float* fo = (row < 16384) ? out + offp + (size_t)row * 512 : out + offs + (size_t)(row - 16384) * 512;
#pragma unroll
                    for (int bj = 0; bj < 2; ++bj) {
                        const f32x4 v0 = acc[ai][bj][m][0] * rs, v1 = acc[ai][bj][m][1] * rs;
                        u32x4 w; w.x = cvt_pk_bf16(v0[0] * sc, v0[1] * sc); w.y = cvt_pk_bf16(v0[2] * sc, v0[3] * sc); w.z = cvt_pk_bf16(v1[0] * sc, v1[1] * sc); w.w = cvt_pk_bf16(v1[2] * sc, v1[3] * sc);
                        *(u32x4*)(qkv + (size_t)row * 3072 + bc + bj * HALF) = w;
                        if (!isq) { *(f32x4*)(fo + cc + bj * HALF) = v0; *(f32x4*)(fo + cc + bj * HALF + 4) = v1; }
                    }
                }
        } else if (wc == 0 && fq == 0) {
            const f32x4 b0 = *(const f32x4*)bfg, b1 = *(const f32x4*)(bfg + 4);
#pragma unroll
            for (int ai = 0; ai < 2; ++ai)
#pragma unroll
                for (int m = 0; m < 4; ++m) {
                    const int row = row0 + ai * HALF + m * 16;
                    const float rs = __builtin_amdgcn_rsqf(ss[row] * (1.0f / 1024.0f) + 1e-6f);
                    float* fo = (row < 16384) ? out + 34603008 + (size_t)row * 8 : out + 52559872 + (size_t)(row - 16384) * 8;
                    f32x4 z0 = acc[ai][0][m][0] * rs + b0, z1 = acc[ai][0][m][1] * rs + b1, l0, l1;
#pragma unroll
                    for (int j = 0; j < 4; ++j) { l0[j] = fminf(z0[j], 0.f) - log1pf(expf(-fabsf(z0[j]))); l1[j] = fminf(z1[j], 0.f) - log1pf(expf(-fabsf(z1[j]))); }
                    *(f32x4*)fo = l0; *(f32x4*)(fo + 4) = l1;
                }
        }
    }
};

template <class Epi, class Sched, bool ALIGN_EPI = false, bool SP2 = false>
__device__ __forceinline__ void gemm_phase(PG8_LAS unsigned char* lds, const Gemm g, const Sched& S, const Epi& E, const int tid) {
    const int wid = __builtin_amdgcn_readfirstlane(tid >> 6), lane = tid & 63, wr = wid >> 2, wc = wid & 3, fr = lane & 15, fq = lane >> 4;
    const int K = g.K, nt = K / BK;
    unsigned voffA[2], voffB[2];
#pragma unroll
    for (int i = 0; i < 2; ++i) { int R, C; stage_rc(tid * 16 + i * 8192, R, C); const int Rb = Epi::PERM ? ((R & ~31) + perm32(R & 31)) : R;
        voffA[i] = (unsigned)(R * K + C) * 2u; voffB[i] = (unsigned)(Rb * K + C) * 2u; }
    const size_t kstep = (size_t)(BK * 2);
    const size_t hstep = (size_t)HALF * K * 2;
    const size_t tstep = 2 * hstep;
    const unsigned ldsw = (unsigned)wid * 1024u;
    const int aoff = lds_byte(wr * 64 + fr, fq * 8), boff = lds_byte(wc * 32 + fr, fq * 8);
#define PG8_SA(b, h) (((b) * 2 + (h)) * HTB)
#define PG8_SB(b, h) ((4 + (b) * 2 + (h)) * HTB)
#define PG8_STAGE(bufoff, gbase, voff) do { _Pragma("unroll") for (int _i = 0; _i < 2; ++_i) \
        __builtin_amdgcn_global_load_lds((const unsigned*)((const char*)(gbase) + (voff)[_i]), (PG8_LAS unsigned*)(lds + (bufoff) + ldsw + _i * 8192), 16, 0, 0); } while (0)
#define PG8_LDA(dst, b, h) do { _Pragma("unroll") for (int m = 0; m < 4; ++m) _Pragma("unroll") for (int k = 0; k < 2; ++k) dst[m][k] = *(const PG8_LAS bf16x8*)(lds + PG8_SA(b, h) + aoff + m * 2048 + k * 1024); } while (0)
#define PG8_LDB(dst, b, h) do { _Pragma("unroll") for (int n = 0; n < 2; ++n) _Pragma("unroll") for (int k = 0; k < 2; ++k) dst[n][k] = *(const PG8_LAS bf16x8*)(lds + PG8_SB(b, h) + boff + n * 2048 + k * 1024); } while (0)
#define PG8_MMA(ai, bj, At, Bt) do { __builtin_amdgcn_s_setprio(1); _Pragma("unroll") for (int m = 0; m < 4; ++m) _Pragma("unroll") for (int n = 0; n < 2; ++n) _Pragma("unroll") for (int k = 0; k < 2; ++k) \
        acc[ai][bj][m][n] = __builtin_amdgcn_mfma_f32_16x16x32_bf16(Bt[n][k], At[m][k], acc[ai][bj][m][n], 0, 0, 0); __builtin_amdgcn_s_setprio(0); } while (0)
#define PG8_WAIT_V(n) asm volatile("s_waitcnt vmcnt(" #n ")" ::: "memory")
#define PG8_WAIT_L(n) asm volatile("s_waitcnt lgkmcnt(" #n ")" ::: "memory")
#define PG8_BAR __builtin_amdgcn_s_barrier()
#define PG8_SCHED __builtin_amdgcn_sched_barrier(0)
    Unit cur, nxt; int ui = 0;
    if (!S.next(0, cur)) return;
    f32x4 acc[2][2][4][2];
#pragma unroll
    for (int a = 0; a < 2; ++a)
#pragma unroll
        for (int b = 0; b < 2; ++b)
#pragma unroll
            for (int m = 0; m < 4; ++m)
#pragma unroll
                for (int n = 0; n < 2; ++n) acc[a][b][m][n] = (f32x4){0.f, 0.f, 0.f, 0.f};
    bf16x8 At[4][2], B0[2][2], B1[2][2];
    const char* cA = (const char*)g.A + (size_t)cur.pm * tstep; const char* cB = (const char*)g.Bt + (size_t)cur.pn * tstep;
    S.a_ready(cur);
    if constexpr (SP2) {
        PG8_STAGE(PG8_SB(0, 0), cB, voffB); PG8_STAGE(PG8_SB(0, 1), cB + hstep, voffB); PG8_STAGE(PG8_SA(0, 0), cA, voffA); PG8_STAGE(PG8_SA(0, 1), cA + hstep, voffA);
        if (wr == 1) PG8_BAR;
        PG8_WAIT_V(2); PG8_BAR;
        PG8_STAGE(PG8_SB(1, 0), cB + kstep, voffB); PG8_STAGE(PG8_SA(1, 0), cA + kstep, voffA); PG8_STAGE(PG8_SB(1, 1), cB + hstep + kstep, voffB);
        PG8_WAIT_V(6); PG8_BAR;
    } else {
        PG8_STAGE(PG8_SB(0, 0), cB, voffB); PG8_STAGE(PG8_SA(0, 0), cA, voffA); PG8_STAGE(PG8_SB(0, 1), cB + hstep, voffB); PG8_STAGE(PG8_SA(0, 1), cA + hstep, voffA);
        if (wr == 1) PG8_BAR;
        PG8_WAIT_V(4); PG8_BAR;
        PG8_STAGE(PG8_SB(1, 0), cB + kstep, voffB); PG8_STAGE(PG8_SA(1, 0), cA + kstep, voffA); PG8_STAGE(PG8_SB(1, 1), cB + hstep + kstep, voffB);
        PG8_WAIT_V(6); PG8_BAR;
    }
    for (;;) {
        const bool has_next = S.next(ui + 1, nxt);
        const char* nA = has_next ? (const char*)g.A + (size_t)nxt.pm * tstep : cA; const char* nB = has_next ? (const char*)g.Bt + (size_t)nxt.pn * tstep : cB;
        for (int t = 0; t < nt; t += 2) {
            const bool last = (t == nt - 2);
            const char* a1 = cA + (size_t)(t + 1) * kstep;
            const char* a2 = last ? nA : cA + (size_t)(t + 2) * kstep; const char* b2 = last ? nB : cB + (size_t)(t + 2) * kstep;
            const char* a3 = a2 + kstep; const char* b3 = b2 + kstep;
            if (last && has_next) S.a_ready(nxt);
            if constexpr (SP2) {
            PG8_LDB(B0, 0, 0); PG8_LDB(B1, 0, 1); PG8_SCHED; PG8_LDA(At, 0, 0); PG8_STAGE(PG8_SA(1, 1), a1 + hstep, voffA);
            PG8_WAIT_V(8); PG8_WAIT_L(0); PG8_BAR; PG8_MMA(0, 0, At, B0); PG8_MMA(0, 1, At, B1); PG8_BAR; PG8_SCHED;
            PG8_LDA(At, 0, 1); PG8_STAGE(PG8_SB(0, 0), b2, voffB); PG8_STAGE(PG8_SB(0, 1), b2 + hstep, voffB); PG8_STAGE(PG8_SA(0, 0), a2, voffA);
            PG8_WAIT_V(8); PG8_WAIT_L(0); PG8_BAR; PG8_MMA(1, 0, At, B0); PG8_MMA(1, 1, At, B1); PG8_BAR; PG8_SCHED;
            PG8_LDB(B0, 1, 0); PG8_LDB(B1, 1, 1); PG8_SCHED; PG8_LDA(At, 1, 0); PG8_STAGE(PG8_SA(0, 1), a2 + hstep, voffA);
            PG8_WAIT_V(8); PG8_WAIT_L(0); PG8_BAR; PG8_MMA(0, 0, At, B0); PG8_MMA(0, 1, At, B1); PG8_BAR; PG8_SCHED;
            PG8_LDA(At, 1, 1); PG8_STAGE(PG8_SB(1, 0), b3, voffB); PG8_STAGE(PG8_SB(1, 1), b3 + hstep, voffB); PG8_STAGE(PG8_SA(1, 0), a3, voffA);
            PG8_WAIT_V(8); PG8_WAIT_L(0); PG8_BAR; PG8_MMA(1, 0, At, B0); PG8_MMA(1, 1, At, B1); PG8_BAR; PG8_SCHED;
            } else {
            PG8_LDB(B0, 0, 0); PG8_SCHED; PG8_LDA(At, 0, 0); PG8_STAGE(PG8_SA(1, 1), a1 + hstep, voffA);
            PG8_WAIT_L(8); PG8_BAR; PG8_WAIT_L(0); PG8_MMA(0, 0, At, B0); PG8_BAR; PG8_SCHED;
            PG8_LDB(B1, 0, 1); PG8_STAGE(PG8_SB(0, 0), b2, voffB);
            PG8_BAR; PG8_WAIT_L(0); PG8_MMA(0, 1, At, B1); PG8_BAR;
            PG8_LDA(At, 0, 1); PG8_STAGE(PG8_SA(0, 0), a2, voffA);
            PG8_BAR; PG8_WAIT_L(0); PG8_MMA(1, 0, At, B0); PG8_BAR; PG8_SCHED;
            PG8_STAGE(PG8_SB(0, 1), b2 + hstep, voffB);
            PG8_WAIT_V(6); PG8_BAR; PG8_MMA(1, 1, At, B1); PG8_BAR;
            PG8_LDB(B0, 1, 0); PG8_SCHED; PG8_LDA(At, 1, 0); PG8_STAGE(PG8_SA(0, 1), a2 + hstep, voffA);
            PG8_WAIT_L(8); PG8_BAR; PG8_WAIT_L(0); PG8_MMA(0, 0, At, B0); PG8_BAR; PG8_SCHED;
            PG8_LDB(B1, 1, 1); PG8_STAGE(PG8_SB(1, 0), b3, voffB);
            PG8_BAR; PG8_WAIT_L(0); PG8_MMA(0, 1, At, B1); PG8_BAR;
            PG8_LDA(At, 1, 1); PG8_STAGE(PG8_SA(1, 0), a3, voffA);
            PG8_BAR; PG8_WAIT_L(0); PG8_MMA(1, 0, At, B0); PG8_BAR; PG8_SCHED;
            PG8_STAGE(PG8_SB(1, 1), b3 + hstep, voffB);
            PG8_WAIT_V(6); PG8_BAR; PG8_MMA(1, 1, At, B1); PG8_BAR;
            }
        }
        if constexpr (ALIGN_EPI) { if (wr == 0) PG8_BAR; }
        if constexpr (!Epi::AFTER_DRAIN) { E(acc, cur, wr, wc, fr, fq); S.done(cur); }
        if (!has_next) break;
#pragma unroll
        for (int a = 0; a < 2; ++a)
#pragma unroll
            for (int b = 0; b < 2; ++b)
#pragma unroll
                for (int m = 0; m < 4; ++m)
#pragma unroll
                    for (int n = 0; n < 2; ++n) acc[a][b][m][n] = (f32x4){0.f, 0.f, 0.f, 0.f};
        cur = nxt; cA = nA; cB = nB; ++ui;
        if constexpr (ALIGN_EPI) { if (wr == 1) PG8_BAR; }
    }
    PG8_WAIT_V(0);
    if constexpr (!ALIGN_EPI) { if (wr == 0) PG8_BAR; }
    PG8_BAR;
    if constexpr (Epi::AFTER_DRAIN) { E.fused(acc, cur, wr, wc, fr, fq, lds, wid, lane); S.done(cur); }
#undef PG8_SA
#undef PG8_SB
#undef PG8_STAGE
#undef PG8_LDA
#undef PG8_LDB
#undef PG8_MMA
#undef PG8_WAIT_V
#undef PG8_WAIT_L
#undef PG8_BAR
#undef PG8_SCHED
}
}
namespace att {
typedef short bf16x8 __attribute__((ext_vector_type(8)));
typedef short s16x4 __attribute__((ext_vector_type(4)));
typedef float f32x16 __attribute__((ext_vector_type(16)));
typedef unsigned u32x4 __attribute__((ext_vector_type(4)));
typedef LAS const char* lds_cptr;
typedef short v4i16_t __attribute__((ext_vector_type(4)));
constexpr float THR = 8.0f;
constexpr int PITCH = 3072;

__device__ __forceinline__ int crow(int r, int hi) { return (r & 3) + 8 * (r >> 2) + 4 * hi; }
__device__ __forceinline__ void glds16(const void* gsrc, unsigned lds_dst) { unsigned keep;
    asm volatile("s_mov_b32 %0, m0\n\ts_mov_b32 m0, %2\n\ts_nop 0\n\tglobal_load_lds_dwordx4 %1, off\n\ts_mov_b32 m0, %0" : "=&s"(keep) : "v"(gsrc), "s"(lds_dst) : "memory"); }
__device__ __forceinline__ s16x4 vtr(lds_cptr p) { return __builtin_bit_cast(s16x4, __builtin_amdgcn_ds_read_tr16_b64_v4i16((LAS v4i16_t*)p)); }
#define ABAR_L() asm volatile("s_waitcnt lgkmcnt(0)\n\ts_barrier" ::: "memory")
#define ABAR_VL() asm volatile("s_waitcnt vmcnt(0) lgkmcnt(0)\n\ts_barrier" ::: "memory")

template <int NDV>
__device__ __forceinline__ void sm_part(f32x16 s, float& m, float& l, f32x16 (&o)[NDV], LAS float* wsf, int r32, int hi, bf16x8& pa0, bf16x8& pa1) {
    float pm = s[0];
#pragma unroll
    for (int r = 1; r < 16; ++r) pm = fmaxf(pm, s[r]);
    { auto rr = __builtin_amdgcn_permlane32_swap(__float_as_uint(pm), __float_as_uint(pm), false, false); pm = fmaxf(__uint_as_float(rr[0]), __uint_as_float(rr[1])); }
    if (!__all(pm <= m + THR)) {
        const float mn = fmaxf(m, pm), alpha = __builtin_amdgcn_exp2f(m - mn); m = mn; l *= alpha;
        if (hi == 0) wsf[r32] = alpha;
        LDS_WAIT();
#pragma unroll
        for (int r = 0; r < 16; ++r) { const float a = wsf[crow(r, hi)];
#pragma unroll
            for (int d0 = 0; d0 < NDV; ++d0) o[d0][r] *= a; }
        LDS_WAIT();
    }
    float ps = 0.f;
#pragma unroll
    for (int r = 0; r < 16; ++r) { s[r] = __builtin_amdgcn_exp2f(s[r] - m); ps += s[r]; }
    l += ps;
    u32x4 w0, w1;
    w0.x = pk2(s[0], s[1]); w0.y = pk2(s[2], s[3]); w0.z = pk2(s[4], s[5]); w0.w = pk2(s[6], s[7]);
    w1.x = pk2(s[8], s[9]); w1.y = pk2(s[10], s[11]); w1.z = pk2(s[12], s[13]); w1.w = pk2(s[14], s[15]);
    pa0 = __builtin_bit_cast(bf16x8, w0); pa1 = __builtin_bit_cast(bf16x8, w1);
}
template <int NDV, int KG>
__device__ __forceinline__ void pv_part(bf16x8 pa0, bf16x8 pa1, f32x16 (&o)[NDV], lds_cptr vb) {
#pragma unroll
    for (int d0 = 0; d0 < NDV; ++d0) {
        const s16x4 a0 = vtr(vb + (d0 * KG + 0) * 1024), a1 = vtr(vb + (d0 * KG + 0) * 1024 + 512);
        const s16x4 b0 = vtr(vb + (d0 * KG + 1) * 1024), b1 = vtr(vb + (d0 * KG + 1) * 1024 + 512);
        const bf16x8 v0 = {a0[0], a0[1], a0[2], a0[3], a1[0], a1[1], a1[2], a1[3]}, v1 = {b0[0], b0[1], b0[2], b0[3], b1[0], b1[1], b1[2], b1[3]};
        o[d0] = __builtin_amdgcn_mfma_f32_32x32x16_bf16(pa0, v0, o[d0], 0, 0, 0);
        o[d0] = __builtin_amdgcn_mfma_f32_32x32x16_bf16(pa1, v1, o[d0], 0, 0, 0);
    }
}
template <int NDV, int KG>
__device__ __forceinline__ void sm_pv(f32x16 s, float& m, float& l, f32x16 (&o)[NDV], lds_cptr vb, LAS float* wsf, int r32, int hi) {
    bf16x8 pa0, pa1; sm_part<NDV>(s, m, l, o, wsf, r32, hi, pa0, pa1); pv_part<NDV, KG>(pa0, pa1, o, vb);
}
template <int NDV>
__device__ __forceinline__ void normalize_o(f32x16 (&o)[NDV], float l, LAS float* wsf, int r32, int hi) {
    { auto rr = __builtin_amdgcn_permlane32_swap(__float_as_uint(l), __float_as_uint(l), false, false); l = __uint_as_float(rr[0]) + __uint_as_float(rr[1]); }
    if (hi == 0) wsf[64 + r32] = l;
    LDS_WAIT();
#pragma unroll
    for (int r = 0; r < 16; ++r) { const float a = __builtin_amdgcn_rcpf(wsf[64 + crow(r, hi)]);
#pragma unroll
        for (int d0 = 0; d0 < NDV; ++d0) o[d0][r] *= a; }
    LDS_WAIT();
}

template <int NDV, bool FOX>
__device__ __forceinline__ void prompt_pass(const bf16* Qw, const bf16* Kg, const bf16* Vg, int qb, int w, int lane, LAS char* lds, float slope2, f32x16 (&o)[NDV]) {
    const int r32 = lane & 31, hi = lane >> 5;
    const unsigned lds0 = (unsigned)(uintptr_t)lds;
    LAS float* wsf = (LAS float*)(lds + ATT_WSF) + w * 128;
    LAS const float* cb = (LAS const float*)(lds + 49152);
    bf16x8 qr[4];
#pragma unroll
    for (int d0 = 0; d0 < 4; ++d0) qr[d0] = *(const bf16x8*)(Qw + (size_t)r32 * PITCH + d0 * 16 + hi * 8);
#pragma unroll
    for (int d0 = 0; d0 < NDV; ++d0) o[d0] = f32x16{};
    float m = -1e30f, l = 0.f;
    const int NT = 4 * qb + 4;
    const int my_last = FOX ? 8 * qb + w : 8 * qb + 2 * (w >> 1) + 1;
    const bf16* ksrc = Kg + (size_t)lane * PITCH + w * 8;
    const bf16* vsrc0 = Vg + (size_t)(16 * (w & 3) + (lane >> 2)) * PITCH + (w >> 2) * 32 + (lane & 3) * 8;
    const bf16* vsrc1 = vsrc0 + 64;
#define DMA_TILE(t, bufi) do { const size_t go_ = (size_t)(t) * 64 * PITCH; \
        glds16(ksrc + go_, (unsigned)__builtin_amdgcn_readfirstlane(lds0 + (bufi) * 8192 + w * 1024)); \
        glds16(vsrc0 + go_, (unsigned)__builtin_amdgcn_readfirstlane(lds0 + 16384 + (bufi) * 16384 + w * 1024)); \
        if (NDV == 4) glds16(vsrc1 + go_, (unsigned)__builtin_amdgcn_readfirstlane(lds0 + 16384 + (bufi) * 16384 + (w + 8) * 1024)); } while (0)
    DMA_TILE(NT - 1, 0);
    ABAR_VL();
    for (int i = 0; i < NT; ++i) {
        const int t = NT - 1 - i, buf = i & 1;
        if (i + 1 < NT) DMA_TILE(t - 1, buf ^ 1);
        const lds_cptr kimg = (lds_cptr)lds + buf * 8192, vimg = (lds_cptr)lds + 16384 + buf * 16384;
#pragma unroll
        for (int sub = 1; sub >= 0; --sub) {
            const int gs = 2 * t + sub;
            if (gs <= my_last) {
                f32x16 c;
                if (FOX) {
#pragma unroll
                    for (int g = 0; g < 4; ++g) { const f32x4 x = *(LAS const f32x4*)(cb + 32 * gs + 8 * g + 4 * hi); c[4 * g] = x[0]; c[4 * g + 1] = x[1]; c[4 * g + 2] = x[2]; c[4 * g + 3] = x[3]; }
                } else {
                    const int kb = 32 * gs - 256 * qb;
                    if (t == 4 * qb + (w >> 1)) { const int tq2 = 2 * (32 * w + r32);
#pragma unroll
                        for (int r = 0; r < 16; ++r) { const int s = kb + crow(r, hi); const int v = s < tq2 - s ? s : tq2 - s; c[r] = slope2 * (float)v; }
                    } else {
#pragma unroll
                        for (int r = 0; r < 16; ++r) c[r] = slope2 * (float)(kb + crow(r, hi));
                    }
                }
#pragma unroll
                for (int d0 = 0; d0 < 4; ++d0) { const bf16x8 kf = *(LAS const bf16x8*)(kimg + (2 * d0 + hi) * 1024 + (32 * sub + r32) * 16);
                    c = __builtin_amdgcn_mfma_f32_32x32x16_bf16(kf, qr[d0], c, 0, 0, 0); }
                if (FOX && gs == my_last) {
#pragma unroll
                    for (int r = 0; r < 16; ++r) if (crow(r, hi) > r32) c[r] = -INFINITY;
                }
                const lds_cptr vb = vimg + (2 * sub) * 1024 + (4 * hi + ((lane & 15) >> 2)) * 64 + ((lane >> 4) & 1) * 32 + (lane & 3) * 8;
                sm_pv<NDV, 4>(c, m, l, o, vb, wsf, r32, hi);
            }
        }
        ABAR_VL();
    }
#undef DMA_TILE
    normalize_o<NDV>(o, l, wsf, r32, hi);
}

__device__ __forceinline__ void fox_bias_scan(const float* lf, int n, int qb, LAS char* lds, int tid, int lane, int w) {
    LAS float* cb = (LAS float*)(lds + 49152); LAS float* tmp = (LAS float*)(lds + ATT_TMP);
    float a[4];
#pragma unroll
    for (int k = 0; k < 4; ++k) { const int s = 4 * tid + k; a[k] = s < n ? lf[(size_t)s * 8] : 0.f; }
    a[1] += a[0]; a[2] += a[1]; a[3] += a[2];
    const float tot = a[3]; float v = tot;
#pragma unroll
    for (int o = 1; o < 64; o <<= 1) { const float t = __shfl_up(v, o); if (lane >= o) v += t; }
    if (lane == 63) tmp[w] = v;
    ABAR_L();
    float base = 0.f;
    for (int ww = 0; ww < w; ++ww) base += tmp[ww];
    const float excl = base + v - tot;
#pragma unroll
    for (int k = 0; k < 4; ++k) a[k] += excl;
    if (qb > 0 && tid == 64 * qb - 1) tmp[8] = a[3];
    ABAR_L();
    const float R = qb > 0 ? tmp[8] : 0.f;
    f32x4 cv; cv[0] = (R - a[0]) * LOG2E; cv[1] = (R - a[1]) * LOG2E; cv[2] = (R - a[2]) * LOG2E; cv[3] = (R - a[3]) * LOG2E;
    *(LAS f32x4*)(cb + 4 * tid) = cv;
    ABAR_L();
}

template <bool FOX>
__device__ __forceinline__ void sample_pass(const bf16* Qg, const float* Kc, const float* Kn, const float* Vc, const float* Vn, const float* bcs, const float* lfn, float slope2,
                                            int w, int lane, int tid, LAS char* lds, float (&res)[FOX ? 4 : 8]) {
    constexpr int NSP = FOX ? 8 : 4, DPT = FOX ? 4 : 8, NDV = 2;
    const int wsub = w % NSP, grp = w / NSP;
    const int r32 = lane & 31, hi = lane >> 5;
    LAS float* wsf = (LAS float*)(lds + ATT_WSF) + w * 128;
    LAS char* myreg = lds + w * 16384;
    Vc += grp * 64; Vn += grp * 64;
    bf16x8 qr[4];
#pragma unroll
    for (int d0 = 0; d0 < 4; ++d0) qr[d0] = *(const bf16x8*)(Qg + (size_t)r32 * PITCH + d0 * 16 + hi * 8);
    f32x16 o[NDV];
#pragma unroll
    for (int d0 = 0; d0 < NDV; ++d0) o[d0] = f32x16{};
    float m = -1e30f, l = 0.f;
    float nbias = 0.f;
    if (FOX && w == 0) { float v = lane < 32 ? lfn[(size_t)lane * 8] : 0.f;
#pragma unroll
        for (int o2 = 1; o2 < 32; o2 <<= 1) { const float t = __shfl_up(v, o2); if (lane >= o2) v += t; }
        nbias = -v * LOG2E; }
    constexpr int CNT = 64 / NSP;
    const int nsteps = (wsub == 0) ? CNT + 1 : CNT;
    const lds_cptr vbw = (lds_cptr)myreg + (4 * hi + ((lane & 15) >> 2)) * 64 + ((lane >> 4) & 1) * 32 + (lane & 3) * 8;
    for (int i = 0; i < nsteps; ++i) {
        const int s = (wsub == 0) ? (i == 0 ? 64 : NSP * (CNT - i)) : (wsub + NSP * (CNT - 1 - i));
        const bool isnew = (s == 64);
        const float* Kb = isnew ? Kn : Kc + (size_t)(32 * s) * 512;
        const float* Vb = isnew ? Vn : Vc + (size_t)(32 * s) * 512;
        int lv = lane; asm volatile("" : "+v"(lv));
        const int r32v = lv & 31, hiv = lv >> 5;
        const int vkey = lv >> 4, vdd = 4 * (lv & 15);
        const float* vp = Vb + (size_t)vkey * 512 + vdd;
        LAS char* vdst = myreg + ((vdd >> 5) * 2) * 1024 + vkey * 64 + (vdd & 31) * 2;
        f32x4 kx[8], vx[8];
#pragma unroll
        for (int d0 = 0; d0 < 4; ++d0) { const float* kp = Kb + (size_t)r32v * 512 + 16 * d0 + 8 * hiv; kx[2 * d0] = *(const f32x4*)kp; kx[2 * d0 + 1] = *(const f32x4*)(kp + 4); }
#pragma unroll
        for (int i2 = 0; i2 < 8; ++i2) vx[i2] = *(const f32x4*)(vp + (size_t)(4 * i2) * 512);
        __builtin_amdgcn_sched_barrier(0);
        bf16x8 kf[4];
#pragma unroll
        for (int d0 = 0; d0 < 4; ++d0) { const f32x4 a = kx[2 * d0], b = kx[2 * d0 + 1];
            u32x4 pk; pk.x = pk2(a[0], a[1]); pk.y = pk2(a[2], a[3]); pk.z = pk2(b[0], b[1]); pk.w = pk2(b[2], b[3]); kf[d0] = __builtin_bit_cast(bf16x8, pk); }
        f32x16 c;
        if (FOX) {
            if (!isnew) {
#pragma unroll
                for (int g = 0; g < 4; ++g) { const f32x4 x = *(const f32x4*)(bcs + 32 * s + 8 * g + 4 * hiv); c[4 * g] = x[0]; c[4 * g + 1] = x[1]; c[4 * g + 2] = x[2]; c[4 * g + 3] = x[3]; }
            } else {
#pragma unroll
                for (int r = 0; r < 16; ++r) c[r] = __shfl(nbias, crow(r, hiv));
            }
        } else {
            if (!isnew) {
#pragma unroll
                for (int r = 0; r < 16; ++r) c[r] = slope2 * (float)(32 * s + crow(r, hiv) - 2048);
            } else {
#pragma unroll
                for (int r = 0; r < 16; ++r) { const int j = crow(r, hiv), v2 = 2 * r32v - j; c[r] = slope2 * (float)(j < v2 ? j : v2); }
            }
        }
#pragma unroll
        for (int d0 = 0; d0 < 4; ++d0) c = __builtin_amdgcn_mfma_f32_32x32x16_bf16(kf[d0], qr[d0], c, 0, 0, 0);
        if (FOX && isnew) {
#pragma unroll
            for (int r = 0; r < 16; ++r) if (crow(r, hiv) > r32v) c[r] = -INFINITY;
        }
        __builtin_amdgcn_sched_barrier(0);
#pragma unroll
        for (int i2 = 0; i2 < 8; ++i2) { const int kk = 4 * i2; v2u pk; pk.x = pk2(vx[i2][0], vx[i2][1]); pk.y = pk2(vx[i2][2], vx[i2][3]); *(LAS v2u*)(vdst + (kk >> 4) * 1024 + (kk & 15) * 64) = pk; }
        __builtin_amdgcn_sched_barrier(0);
        sm_pv<NDV, 2>(c, m, l, o, vbw, wsf, r32v, hiv);
    }
    { auto rr = __builtin_amdgcn_permlane32_swap(__float_as_uint(l), __float_as_uint(l), false, false); l = __uint_as_float(rr[0]) + __uint_as_float(rr[1]); }
    LAS float* Op = (LAS float*)myreg;
#pragma unroll
    for (int d0 = 0; d0 < NDV; ++d0)
#pragma unroll
        for (int r = 0; r < 16; ++r) Op[crow(r, hi) * 64 + 32 * d0 + r32] = o[d0][r];
    LAS float* ML = (LAS float*)(lds + ATT_ML);
    if (hi == 0) { ML[w * 64 + r32] = m; ML[w * 64 + 32 + r32] = l; }
    ABAR_L();
    const int q = tid >> 4, seg = tid & 15;
    const int g2 = FOX ? 0 : (seg >> 3), d = FOX ? seg * 4 : (seg & 7) * 8;
    float mw[NSP], M = -1e30f;
#pragma unroll
    for (int ww = 0; ww < NSP; ++ww) { mw[ww] = ML[(g2 * NSP + ww) * 64 + q]; M = fmaxf(M, mw[ww]); }
    float L = 0.f, acc[DPT];
#pragma unroll
    for (int k = 0; k < DPT; ++k) acc[k] = 0.f;
#pragma unroll
    for (int ww = 0; ww < NSP; ++ww) { const float sc = __builtin_amdgcn_exp2f(mw[ww] - M); L += sc * ML[(g2 * NSP + ww) * 64 + 32 + q];
        LAS const float* src = (LAS const float*)(lds + (g2 * NSP + ww) * 16384) + q * 64 + d;
#pragma unroll
        for (int k = 0; k < DPT; ++k) acc[k] += sc * src[k]; }
    const float rl = 1.0f / L;
#pragma unroll
    for (int k = 0; k < DPT; ++k) res[k] = acc[k] * rl;
    ABAR_L();
}
}

__device__ __forceinline__ float wave_sum(float v) {
#pragma unroll
    for (int o = 1; o < 64; o <<= 1) v += __shfl_xor(v, o);
    return v;
}
__device__ __forceinline__ int src_col(int map, int n) {
    if (map == 0) return n;
    if (map == 1) { const int tile = n >> 8, i = n & 255; return i < 128 ? 128 * tile + i : DFF + 128 * tile + (i - 128); }
    if (n < 1536) return n;
    if (n < 3072) return n + 8;
    if (n < 3080) return 1536 + (n - 3072);
    return -1;
}
__device__ __forceinline__ void p0_transpose_item(const float* W, int K, int Nsrc, bf16* WT, const float* gain, int map, int nblk, LAS float* scr, int item, int lane) {
    const int kb = item / nblk, nb = item % nblk, k0 = 64 * kb, n0 = 32 * nb;
    const int sc = src_col(map, n0 + (lane & 31));
#pragma unroll 8
    for (int i = 0; i < 32; ++i) { const int kk = 2 * i + (lane >> 5); float v = sc >= 0 ? W[(size_t)(k0 + kk) * Nsrc + sc] : 0.f; if (gain) v *= gain[k0 + kk]; scr[kk * 33 + (lane & 31)] = v; }
    LDS_WAIT(); asm volatile("" ::: "memory");
    const int c = lane & 7;
#pragma unroll
    for (int j = 0; j < 4; ++j) { const int n = (lane >> 3) + 8 * j; const LAS float* s = scr + (8 * c) * 33 + n;
        v4u o; o.x = pk2(s[0 * 33], s[1 * 33]); o.y = pk2(s[2 * 33], s[3 * 33]); o.z = pk2(s[4 * 33], s[5 * 33]); o.w = pk2(s[6 * 33], s[7 * 33]);
        *(GAS v4u*)(WT + (size_t)(n0 + n) * K + k0 + 8 * c) = o; }
    LDS_WAIT(); asm volatile("" ::: "memory");
}

#define XB_TMO      128
#define XB_XCNT(j)  (256  + 64 * (j))
#define XB_XSUB(j)  (1280 + 64 * (j))
#define XB_XGEN(j)  (2304 + 64 * (j))
#define XB_TOP      3328
#define XB_TOPGEN   3392
#define XCD_BAR_WORDS 3456
#define XB_SPIN_CAP (1u << 18)

__device__ __forceinline__ unsigned xb_ld(unsigned* p)              { return __hip_atomic_load(p, __ATOMIC_RELAXED, __HIP_MEMORY_SCOPE_AGENT); }
__device__ __forceinline__ unsigned xb_add(unsigned* p, unsigned v) { return __hip_atomic_fetch_add(p, v, __ATOMIC_RELAXED, __HIP_MEMORY_SCOPE_AGENT); }
__device__ __forceinline__ unsigned xb_xcc_id() { return (unsigned)__builtin_amdgcn_s_getreg((3 << 11) | 20) & 0xFu; }
#define XB_SPIN(cond, bar) do { unsigned _sp = 0; while (cond) { __builtin_amdgcn_s_sleep(1); \
    if ((++_sp & 255u) == 0u) { if (xb_ld(&(bar)[XB_TMO])) break; if (_sp > XB_SPIN_CAP) { atomicAdd(&(bar)[XB_TMO], 1u); break; } } } } while (0)

struct XcdBarrier {
    unsigned* bar; unsigned x;
    volatile LAS unsigned* st;
};

__device__ __forceinline__ XcdBarrier xcd_barrier_post(unsigned* bar, volatile LAS unsigned* st) {
    XcdBarrier b; b.bar = bar; b.x = xb_xcc_id(); b.st = st;
    if (threadIdx.x == 0) (void)xb_add(&bar[XB_XCNT(b.x)], 1u);
    return b;
}
__device__ __forceinline__ void xcd_barrier_complete(unsigned* bar, unsigned x, unsigned& nloc, unsigned& nx) {
    const unsigned G = gridDim.x * gridDim.y * gridDim.z;
    unsigned sum, cnt, mine, sp = 0u;
    for (;;) {
        sum = 0u; cnt = 0u; mine = 0u;
#pragma unroll
        for (unsigned j = 0; j < 16; ++j) { const unsigned c = xb_ld(&bar[XB_XCNT(j)]); sum += c; cnt += (c > 0u) ? 1u : 0u; mine = (j == x) ? c : mine; }
        if (sum == G) break;
        __builtin_amdgcn_s_sleep(1);
        if ((++sp & 255u) == 0u) { if (xb_ld(&bar[XB_TMO])) break; if (sp > XB_SPIN_CAP) { atomicAdd(&bar[XB_TMO], 1u); break; } }
    }
    nloc = mine > 0u ? mine : 1u; nx = cnt > 0u ? cnt : 1u;
}

__device__ __forceinline__ void xcd_barrier(const XcdBarrier& b) {
    asm volatile("s_waitcnt vmcnt(0)" ::: "memory");
    __syncthreads();
    if (threadIdx.x == 0) {
        unsigned* bar = b.bar;
        __builtin_amdgcn_s_waitcnt(0);
        unsigned nloc = b.st[0], nx = b.st[1];
        if (nloc == 0u) { xcd_barrier_complete(bar, b.x, nloc, nx); b.st[0] = nloc; b.st[1] = nx; }
        const unsigned old = xb_add(&bar[XB_XSUB(b.x)], 1u);
        const unsigned gen = old / nloc;
        if (old + 1u == (gen + 1u) * nloc) {
            __builtin_amdgcn_fence(__ATOMIC_RELEASE, "agent");
            asm volatile("s_waitcnt vmcnt(0)" ::: "memory");
            const unsigned og = xb_add(&bar[XB_TOP], 1u);
            const unsigned tg = og / nx;
            if (og + 1u == (tg + 1u) * nx) xb_add(&bar[XB_TOPGEN], 1u);
            else XB_SPIN(xb_ld(&bar[XB_TOPGEN]) == tg, bar);
            __builtin_amdgcn_fence(__ATOMIC_ACQUIRE, "agent");
            xb_add(&bar[XB_XGEN(b.x)], 1u);
            asm volatile("s_waitcnt vmcnt(0)" ::: "memory");
        } else {
            XB_SPIN(xb_ld(&bar[XB_XGEN(b.x)]) == gen, bar);
            __builtin_amdgcn_fence(__ATOMIC_ACQUIRE, "agent");
            asm volatile("s_waitcnt vmcnt(0)" ::: "memory");
        }
    }
    __syncthreads();
}

constexpr int NPHASES = 9;
#ifndef DBG_PHMASK
#define DBG_PHMASK 0x1ff
#endif
#define PHEN(k) ((DBG_PHMASK >> (k)) & 1)
#ifndef DBG_UMASK
#define DBG_UMASK 0xf
#endif
#define UEN(k) ((DBG_UMASK >> (k)) & 1)
constexpr int N_LAUNCHES = MK_N_LAUNCHES;
constexpr int NUNITS = 1152;
struct Args { const float* in[23]; float* out; unsigned char* ws; int ph_lo, ph_hi; };

__global__ void __launch_bounds__(NWAVES * 64, 2) mk_fwd(Args args) {
    extern __shared__ __attribute__((aligned(16))) unsigned char lds_raw[];
    LAS unsigned char* lds = (LAS unsigned char*)lds_raw;
    volatile LAS unsigned* MISC = (volatile LAS unsigned*)(lds + MISC_OFF);
    const int tid = threadIdx.x, lane = tid & 63, wave = __builtin_amdgcn_readfirstlane(tid >> 6);
    const int G = gridDim.x, bx = blockIdx.x, vcu = (G % 8 == 0) ? (bx % 8) * (G / 8) + bx / 8 : bx;
    unsigned char* ws = args.ws; gu32* ctl = (gu32*)(ws + WS_CTL);
    float* out = args.out;
    bf16* W1I = (bf16*)(ws + WS_W1I); bf16* W1O = (bf16*)(ws + WS_W1O); bf16* WIN = (bf16*)(ws + WS_WIN); bf16* WOUT = (bf16*)(ws + WS_WOUT); bf16* W2I = (bf16*)(ws + WS_W2I); bf16* W2O = (bf16*)(ws + WS_W2O);
    float* BC = (float*)(ws + WS_BC); float* SS0 = (float*)(ws + WS_SS0); float* SS1 = (float*)(ws + WS_CTL) + CW_SS1; float* SS2 = (float*)(ws + WS_CTL) + CW_SS2;
    bf16* XA = (bf16*)(ws + WS_XA); bf16* HB = (bf16*)(ws + WS_H); float* X1 = (float*)(ws + WS_X1); float* X2 = (float*)(ws + WS_X2);
    bf16* QKV = (bf16*)(ws + WS_QKV); bf16* OB = (bf16*)(ws + WS_OB); float* OSCR = (float*)(ws + WS_OSCR);

    for (int u = tid; u < (LDS_BYTES - LDSCTL_OFF) / 4; u += NWAVES * 64) ((LAS unsigned*)(lds + LDSCTL_OFF))[u] = 0u;
    __syncthreads();
    XcdBarrier bar; bar.bar = (unsigned*)(ctl + CW_BAR); bar.x = 0; bar.st = nullptr;
    if (N_LAUNCHES == 1) bar = xcd_barrier_post((unsigned*)(ctl + CW_BAR), MISC + 8);

    const int gw = vcu * NWAVES + wave, NGW = G * NWAVES;
    for (int ph = args.ph_lo; ph < args.ph_hi; ++ph) {
        int tidp = tid; asm volatile("" : "+v"(tidp));
        const int lanep = tidp & 63;
        if (ph == 0 && PHEN(0)) {
            LAS float* scr = (LAS float*)(lds + wave * 16384);
            constexpr int I_1I = 16 * 176, I_1O = 44 * 32, I_IN = 16 * 104, I_O = 16 * 32;
            constexpr int NITEMS = 2 * (I_1I + I_1O) + I_IN + I_O;
            for (int it = gw; it < NITEMS; it += NGW) {
                int r = it;
                if (r < I_1I) { p0_transpose_item(args.in[8], 1024, NFF, W1I, args.in[7], 1, 176, scr, r, lanep); continue; } r -= I_1I;
                if (r < I_1O) { p0_transpose_item(args.in[9], 2816, 1024, W1O, nullptr, 0, 32, scr, r, lanep); continue; } r -= I_1O;
                if (r < I_IN) { p0_transpose_item(args.in[11], 1024, 3080, WIN, args.in[10], 2, 104, scr, r, lanep); continue; } r -= I_IN;
                if (r < I_O) { p0_transpose_item(args.in[18], 1024, 1024, WOUT, nullptr, 0, 32, scr, r, lanep); continue; } r -= I_O;
                if (r < I_1I) { p0_transpose_item(args.in[20], 1024, NFF, W2I, args.in[19], 1, 176, scr, r, lanep); continue; } r -= I_1I;
                p0_transpose_item(args.in[21], 2816, 1024, W2O, nullptr, 0, 32, scr, r, lanep);
            }
            for (int m = gw; m < MT; m += NGW) {
                const float* xrow = m < MP ? args.in[0] + (size_t)m * 1024 : args.in[1] + (size_t)(m - MP) * 1024;
                const GAS f32x4* xr = (const GAS f32x4*)xrow + lanep; f32x4 v[4]; float s = 0.f;
#pragma unroll
                for (int j = 0; j < 4; ++j) { v[j] = xr[64 * j]; s += (v[j].x * v[j].x + v[j].y * v[j].y) + (v[j].z * v[j].z + v[j].w * v[j].w); }
                s = wave_sum(s); if (lanep == 0) SS0[m] = s;
                GAS v2u* o8 = (GAS v2u*)(XA + (size_t)m * 1024) + lanep;
#pragma unroll
                for (int j = 0; j < 4; ++j) { v2u p; p.x = pk2(v[j].x, v[j].y); p.y = pk2(v[j].z, v[j].w); o8[64 * j] = p; }
            }
            for (int j = gw; j < 256; j += NGW) {
                const float* lf = args.in[4] + (size_t)(j >> 3) * 2048 * 8 + (j & 7);
                float e[32]; float run = 0.f;
#pragma unroll
                for (int i = 31; i >= 0; --i) { const float v = lf[(size_t)(32 * lanep + i) * 8]; e[i] = run; run += v; }
                float v = run;
#pragma unroll
                for (int o = 1; o < 64; o <<= 1) { const float t = __shfl_down(v, o); if (lanep + o < 64) v += t; }
                const float excl = v - run;
                float* dst = BC + (size_t)j * 2048 + 32 * lanep;
#pragma unroll
                for (int i = 0; i < 32; i += 4) { f32x4 q; q.x = (e[i] + excl) * LOG2E; q.y = (e[i + 1] + excl) * LOG2E; q.z = (e[i + 2] + excl) * LOG2E; q.w = (e[i + 3] + excl) * LOG2E; *(f32x4*)(dst + i) = q; }
            }
        } else if ((ph == 1 || ph == 6) && PHEN(1)) {
            pg8::Gemm g{XA, ph == 1 ? W1I : W2I, MT, NFF, 1024}; pg8::StaticOrder S; S.init(MT, NFF, G, bx);
            pg8::EpiSwiglu E{HB, ph == 1 ? SS0 : SS2};
            pg8::gemm_phase<pg8::EpiSwiglu, pg8::StaticOrder, true, true>(lds + RING_OFF, g, S, E, tidp);
        } else if ((ph == 2 || ph == 5 || ph == 7) && PHEN(2)) {
            pg8::Gemm g{ph == 5 ? OB : HB, ph == 2 ? W1O : (ph == 5 ? WOUT : W2O), MT, 1024, ph == 5 ? 1024 : 2816}; pg8::StaticOrder S; S.init(MT, 1024, G, bx);
            pg8::EpiResid E;
            if (ph == 2) { E.base0 = args.in[0]; E.base1 = args.in[1]; E.out = X1; E.xa = XA; E.ssout = SS1; E.alpha = 0.5f; }
            else if (ph == 5) { E.base0 = X1; E.base1 = X1 + (size_t)MP * 1024; E.out = X2; E.xa = XA; E.ssout = SS2; E.alpha = 1.0f; }
            else { E.base0 = X2; E.base1 = X2 + (size_t)MP * 1024; E.out = out + O_Y; E.xa = nullptr; E.ssout = nullptr; E.alpha = 0.5f; }
            pg8::gemm_phase<pg8::EpiResid, pg8::StaticOrder, true, true>(lds + RING_OFF, g, S, E, tidp);
        } else if (ph == 3 && PHEN(3)) {
            pg8::Gemm g{XA, WIN, MT, NINP, 1024}; pg8::StaticOrder S; S.init(MT, NINP, G, bx);
            pg8::EpiInProj E{QKV, out, SS1, args.in[12]};
            pg8::gemm_phase<pg8::EpiInProj, pg8::StaticOrder, true, true>(lds + RING_OFF, g, S, E, tidp);
        } else if (ph == 4 && PHEN(4)) {
            const float lam = expf(wave_sum(args.in[13][lanep] * args.in[14][lanep])) - expf(wave_sum(args.in[15][lanep] * args.in[16][lanep])) + LAMBDA_INIT;
            LAS char* al = (LAS char*)lds;
            for (;;) {
                if (tidp == 0) *(volatile LAS unsigned*)(lds + ATT_TMP + 64) = __hip_atomic_fetch_add(ctl + CW_QUEUE, 1u, RLX_AGENT);
                __syncthreads();
                const int idx = __builtin_amdgcn_readfirstlane(*(volatile LAS unsigned*)(lds + ATT_TMP + 64));
                __syncthreads();
                if (idx >= NUNITS) break;
                int tid2 = tidp; asm volatile("" : "+v"(tid2));
                const int lane2 = tid2 & 63, r32 = lane2 & 31, hi = lane2 >> 5;
                if (idx < 128 || (idx >= 256 && idx < 512)) {
                    const int q = tid2 >> 4, seg = tid2 & 15;
                    if (idx < 128 && UEN(0)) {
                        const int b = idx >> 2, h = idx & 3; const size_t rowq = (size_t)MP + b * 32;
                        const float slope2 = (0.25f / (float)(1 << (2 * h))) * LOG2E;
                        float r0[8], r1[8];
                        att::sample_pass<false>(QKV + rowq * 3072 + 1536 + h * 128, args.in[5] + ((size_t)b * 2048 * 4 + h) * 128, out + O_DKS + (size_t)(b * 32) * 512 + h * 128,
                                                   args.in[6] + ((size_t)b * 2048 * 4 + h) * 128, out + O_DVS + (size_t)(b * 32) * 512 + h * 128, nullptr, nullptr, slope2, wave, lane2, tid2, al, r0);
                        att::sample_pass<false>(QKV + rowq * 3072 + 1536 + h * 128 + 64, args.in[5] + ((size_t)b * 2048 * 4 + h) * 128 + 64, out + O_DKS + (size_t)(b * 32) * 512 + h * 128 + 64,
                                                   args.in[6] + ((size_t)b * 2048 * 4 + h) * 128, out + O_DVS + (size_t)(b * 32) * 512 + h * 128, nullptr, nullptr, slope2, wave, lane2, tid2, al, r1);
                        float ss = 0.f;
#pragma unroll
                        for (int k = 0; k < 8; ++k) { r0[k] -= lam * r1[k]; ss += r0[k] * r0[k]; }
                        ss += __shfl_xor(ss, 1); ss += __shfl_xor(ss, 2); ss += __shfl_xor(ss, 4); ss += __shfl_xor(ss, 8);
                        const float rn = __builtin_amdgcn_rsqf(ss * (1.0f / 128.0f) + EPS) * (1.0f - LAMBDA_INIT);
                        const float* gs = args.in[17] + seg * 8;
                        v4u w; w.x = pk2(r0[0] * rn * gs[0], r0[1] * rn * gs[1]); w.y = pk2(r0[2] * rn * gs[2], r0[3] * rn * gs[3]); w.z = pk2(r0[4] * rn * gs[4], r0[5] * rn * gs[5]); w.w = pk2(r0[6] * rn * gs[6], r0[7] * rn * gs[7]);
                        *(v4u*)(OB + (rowq + q) * 1024 + 512 + h * 128 + seg * 8) = w;
                    } else if (idx >= 256 && UEN(1)) {
                        const int j = idx - 256, b = j >> 3, h = j & 7; const size_t rowq = (size_t)MP + b * 32;
                        float r0[4];
                        att::sample_pass<true>(QKV + rowq * 3072 + h * 64, args.in[2] + ((size_t)b * 2048 * 8 + h) * 64, out + O_FKS + (size_t)(b * 32) * 512 + h * 64,
                                                  args.in[3] + ((size_t)b * 2048 * 8 + h) * 64, out + O_FVS + (size_t)(b * 32) * 512 + h * 64, BC + (size_t)(b * 8 + h) * 2048, out + O_FLS + (size_t)(b * 32) * 8 + h, 0.f, wave, lane2, tid2, al, r0);
                        v2u w; w.x = pk2(r0[0], r0[1]); w.y = pk2(r0[2], r0[3]);
                        *(v2u*)(OB + (rowq + q) * 1024 + h * 64 + seg * 4) = w;
                    }
                } else if (idx >= 640 && UEN(2)) {
                    const int j = idx - 640, qb = 7 - (j >> 6), b = (j & 63) >> 3, h = j & 7; const size_t R0 = (size_t)b * SEQ + 256 * qb;
                    att::fox_bias_scan(out + O_FLP + (size_t)b * SEQ * 8 + h, 256 * (qb + 1), qb, al, tid2, lane2, wave);
                    att::f32x16 o[2];
                    att::prompt_pass<2, true>(QKV + (R0 + 32 * wave) * 3072 + h * 64, QKV + (size_t)b * SEQ * 3072 + 512 + h * 64, QKV + (size_t)b * SEQ * 3072 + 1024 + h * 64, qb, wave, lane2, al, 0.f, o);
                    bf16* Ow = OB + (R0 + 32 * wave) * 1024 + h * 64;
#pragma unroll
                    for (int d0 = 0; d0 < 2; ++d0)
#pragma unroll
                        for (int r = 0; r < 16; ++r) Ow[(size_t)att::crow(r, hi) * 1024 + 32 * d0 + r32] = (bf16)(pk2(o[d0][r], 0.f) & 0xffffu);
                } else if (UEN(3)) {
                    const int j = idx < 256 ? idx - 128 : idx - 512, qb = (idx < 256 ? 7 : 3) - (j >> 5), b = (j & 31) >> 2, h = j & 3; const size_t R0 = (size_t)b * SEQ + 256 * qb;
                    const float slope2 = (0.25f / (float)(1 << (2 * h))) * LOG2E;
                    float* scr = OSCR + ((size_t)bx * 512 + tid2) * 64;
                    att::f32x16 o[4];
                    for (int e = 0; e < 2; ++e) {
                        att::prompt_pass<4, false>(QKV + (R0 + 32 * wave) * 3072 + 1536 + h * 128 + e * 64, QKV + (size_t)b * SEQ * 3072 + 2048 + h * 128 + e * 64, QKV + (size_t)b * SEQ * 3072 + 2560 + h * 128, qb, wave, lane2, al, slope2, o);
                        if (e == 0) {
#pragma unroll
                            for (int d0 = 0; d0 < 4; ++d0)
#pragma unroll
                                for (int g = 0; g < 4; ++g) { f32x4 t; t.x = o[d0][4 * g]; t.y = o[d0][4 * g + 1]; t.z = o[d0][4 * g + 2]; t.w = o[d0][4 * g + 3]; *(f32x4*)(scr + d0 * 16 + 4 * g) = t; }
                        }
                    }
                    float ssr[16];
#pragma unroll
                    for (int r = 0; r < 16; ++r) ssr[r] = 0.f;
#pragma unroll
                    for (int d0 = 0; d0 < 4; ++d0)
#pragma unroll
                        for (int g = 0; g < 4; ++g) { const f32x4 t = *(const f32x4*)(scr + d0 * 16 + 4 * g);
#pragma unroll
                            for (int k = 0; k < 4; ++k) { const float v = t[k] - lam * o[d0][4 * g + k]; o[d0][4 * g + k] = v; ssr[4 * g + k] += v * v; } }
                    bf16* Ow = OB + (R0 + 32 * wave) * 1024 + 512 + h * 128;
                    float gsub[4];
#pragma unroll
                    for (int d0 = 0; d0 < 4; ++d0) gsub[d0] = args.in[17][32 * d0 + r32] * (1.0f - LAMBDA_INIT);
#pragma unroll
                    for (int r = 0; r < 16; ++r) { float s = ssr[r]; s += __shfl_xor(s, 1); s += __shfl_xor(s, 2); s += __shfl_xor(s, 4); s += __shfl_xor(s, 8); s += __shfl_xor(s, 16);
                        const float rn = __builtin_amdgcn_rsqf(s * (1.0f / 128.0f) + EPS);
#pragma unroll
                        for (int d0 = 0; d0 < 4; ++d0) Ow[(size_t)att::crow(r, hi) * 1024 + 32 * d0 + r32] = (bf16)(pk2(o[d0][r] * rn * gsub[d0], 0.f) & 0xffffu); }
                }
            }
        } else if (ph == 8 && PHEN(8)) {
            for (int m = gw; m < MT; m += NGW) {
                GAS f32x4* yr = (GAS f32x4*)(out + O_Y + (size_t)m * 1024) + lanep; const GAS f32x4* gf = (const GAS f32x4*)args.in[22] + lanep; f32x4 v[4]; float s = 0.f;
#pragma unroll
                for (int j = 0; j < 4; ++j) { v[j] = yr[64 * j]; s += (v[j].x * v[j].x + v[j].y * v[j].y) + (v[j].z * v[j].z + v[j].w * v[j].w); }
                const float rs = __builtin_amdgcn_rsqf(wave_sum(s) * (1.0f / 1024.0f) + EPS);
#pragma unroll
                for (int j = 0; j < 4; ++j) yr[64 * j] = v[j] * rs * gf[64 * j];
            }
        }
        if (ph + 1 < args.ph_hi) xcd_barrier(bar);
    }
}

extern "C" void kernel_launch(void* const* d_in, const int* in_sizes, int n_in, void* d_out, int out_size, void* d_ws, size_t ws_size, hipStream_t stream) {
    static int grid = 0;
    if (grid == 0) {
        if (n_in != 23 || in_sizes[0] != MP * DM || (size_t)out_size != O_END || ws_size < WS_END) {
            fprintf(stderr, "kernel_launch: unexpected problem: n_in %d in0 %d out %d ws %zu; nothing launched\n", n_in, n_in > 0 ? in_sizes[0] : -1, out_size, ws_size); grid = -1; return; }
        int dev = 0, cus = 0, per_cu = 0;
        if (hipGetDevice(&dev) != hipSuccess || hipDeviceGetAttribute(&cus, hipDeviceAttributeMultiprocessorCount, dev) != hipSuccess) { fprintf(stderr, "kernel_launch: device query failed\n"); grid = -1; return; }
        if (hipFuncSetAttribute((const void*)mk_fwd, hipFuncAttributeMaxDynamicSharedMemorySize, LDS_BYTES) != hipSuccess) { fprintf(stderr, "kernel_launch: hipFuncSetAttribute failed\n"); grid = -1; return; }
        if (hipOccupancyMaxActiveBlocksPerMultiprocessor(&per_cu, (const void*)mk_fwd, NWAVES * 64, LDS_BYTES) != hipSuccess || per_cu < 1) {
            fprintf(stderr, "kernel_launch: occupancy query reports %d workgroups per CU; nothing launched\n", per_cu); (void)hipGetLastError(); grid = -1; return; }
        (void)hipGetLastError();
        grid = cus;
    }
    if (grid < 0) return;
    if (hipMemsetAsync((char*)d_ws + WS_CTL, 0, CTL_ZERO_BYTES, stream) != hipSuccess) { fprintf(stderr, "kernel_launch: memset failed\n"); return; }
    Args a{};
    for (int i = 0; i < 23; ++i) a.in[i] = (const float*)d_in[i];
    a.out = (float*)d_out; a.ws = (unsigned char*)d_ws;
    for (int li = 0; li < N_LAUNCHES; ++li) {
        a.ph_lo = (N_LAUNCHES == 1) ? 0 : li; a.ph_hi = (N_LAUNCHES == 1) ? NPHASES : li + 1;
        hipLaunchKernelGGL(mk_fwd, dim3(grid), dim3(NWAVES * 64), LDS_BYTES, stream, a);
        const hipError_t le = hipPeekAtLastError();
        if (le != hipSuccess) { fprintf(stderr, "kernel_launch: launch %d failed: %s\n", li, hipGetErrorName(le)); break; }
    }
}
```

```cpp
#include <hip/hip_runtime.h>
#include <hip/hip_bf16.h>
#include <cstdio>
#include <cstdint>
#include <cmath>


constexpr int DM = 1024, NBP = 8, SEQ = 2048, NBS = 32, TSM = 32, PAST = 2048;
constexpr int MP = NBP * SEQ, MS = NBS * TSM, MT = MP + MS;
constexpr int DFF = 2816, NFF = 2 * DFF, NINP = 3328, NQKV = 3072;
constexpr float EPS = 1e-6f, LOG2E = 1.4426950408889634f, C2 = 0.125f * 1.4426950408889634f;
constexpr float LAMBDA_INIT = 0.2f;
constexpr size_t O_Y = 0;
constexpr size_t O_FKP = 17825792, O_FVP = 26214400, O_FLP = 34603008, O_DKP = 34734080, O_DVP = 43122688;
constexpr size_t O_FKS = 51511296, O_FVS = 52035584, O_FLS = 52559872, O_DKS = 52568064, O_DVS = 53092352, O_END = 53616640;

constexpr size_t MiB = 1u << 20;
constexpr size_t WS_CTL = 0, CTL_ZERO_BYTES = 1 * MiB;
constexpr size_t WS_W1I = 2 * MiB, WS_W1O = 14 * MiB, WS_WIN = 20 * MiB, WS_WOUT = 27 * MiB, WS_W2I = 30 * MiB, WS_W2O = 42 * MiB;
constexpr size_t WS_BC = 48 * MiB, WS_SS0 = 50 * MiB;
constexpr size_t WS_XA = 64 * MiB, WS_H = 100 * MiB, WS_X1 = 196 * MiB, WS_X2 = 230 * MiB, WS_X3 = 264 * MiB, WS_QKV = 332 * MiB, WS_OB = 434 * MiB, WS_OSCR = 468 * MiB, WS_H2 = 500 * MiB, WS_END = 596 * MiB;
constexpr int CW_BAR = 4096;
constexpr int CW_QUEUE = 8192;
constexpr int CW_SS1 = 65536, CW_SS2 = 65536 + 32768, CW_SS3 = 65536 + 65536;
static_assert((CW_SS3 + 32768) * 4 <= (int)CTL_ZERO_BYTES, "CTL region");

constexpr int RING_OFF = 0, RING_BYTES = 131072;
constexpr int ATT_WSF = 131072, ATT_ML = 135168, ATT_TMP = 137216;
constexpr int LDSCTL_OFF = 143360, MISC_OFF = LDSCTL_OFF + 320;
constexpr int LDS_BYTES = 147456;
constexpr int NWAVES = 8;

#define GAS __attribute__((address_space(1)))
#define LAS __attribute__((address_space(3)))
typedef unsigned short bf16;
typedef unsigned v4u __attribute__((ext_vector_type(4)));
typedef unsigned v2u __attribute__((ext_vector_type(2)));
typedef float f32x4 __attribute__((ext_vector_type(4)));
typedef GAS unsigned gu32;
#define RLX_AGENT __ATOMIC_RELAXED, __HIP_MEMORY_SCOPE_AGENT
#define LDS_WAIT() asm volatile("s_waitcnt lgkmcnt(0)" ::: "memory")
#define VM_WAIT() asm volatile("s_waitcnt vmcnt(0)" ::: "memory")
typedef float f32x2_t __attribute__((ext_vector_type(2))); typedef __bf16 bf16x2_t __attribute__((ext_vector_type(2)));
__device__ __forceinline__ unsigned pk2(float lo, float hi) { f32x2_t v = {lo, hi}; bf16x2_t b = __builtin_convertvector(v, bf16x2_t); return __builtin_bit_cast(unsigned, b); }

__device__ __forceinline__ float shx(float v, int m, int lane) { return __uint_as_float(__builtin_amdgcn_ds_bpermute((lane ^ m) << 2, __float_as_uint(v))); }
__device__ __forceinline__ float shl_from(float v, int src) { return __uint_as_float(__builtin_amdgcn_ds_bpermute(src << 2, __float_as_uint(v))); }
__device__ __forceinline__ void st16_sc1_v(GAS void* p, v4u v) { asm volatile("global_store_dwordx4 %0, %1, off sc1\n\ts_nop 1" :: "v"(p), "v"(v) : "memory"); }
__device__ __forceinline__ void st8_sc1_v(GAS void* p, v2u v) { asm volatile("global_store_dwordx2 %0, %1, off sc1\n\ts_nop 1" :: "v"(p), "v"(v) : "memory"); }
namespace pg8 {
#define PG8_LAS __attribute__((address_space(3)))
typedef unsigned short bf16_t;
typedef short bf16x8 __attribute__((ext_vector_type(8)));
typedef float f32x4 __attribute__((ext_vector_type(4)));
typedef unsigned u32x4 __attribute__((ext_vector_type(4)));
constexpr int BM = 256, BK = 64, HALF = 128, HTB = HALF * BK * 2  , STAGE_BYTES = 8 * HTB, NXCD = 8, WGM = 8;

__host__ __device__ __forceinline__ int lds_byte(int r, int c) { const int st = (r >> 4) * 2 + (c >> 5), rr = r & 15, cc = c & 31, ob = rr * 64 + cc * 2; return st * 1024 + (ob ^ (((ob >> 9) & 1) << 5)); }
__host__ __device__ __forceinline__ void stage_rc(int b, int& R, int& C) { const int st = b / 1024, sb = b % 1024, swz = sb ^ (((sb >> 9) & 1) << 5); R = (st >> 1) * 16 + swz / 64; C = (st & 1) * 32 + (swz % 64) / 2; }
__host__ __device__ __forceinline__ int perm32(int rho) { const int n = rho >> 4, i = rho & 15; return 8 * (i >> 2) + 4 * n + (i & 3); }

struct Unit { int pm, pn; };
struct Gemm { const __attribute__((address_space(1))) bf16_t* A; const __attribute__((address_space(1))) bf16_t* Bt; int M, N, K; };

struct StaticOrder {
    int nM, nN, nwg, G, c;
    __host__ __device__ void init(int M, int N, int G_, int c_) { nM = M / BM; nN = N / BM; nwg = nM * nN; G = G_; c = c_; }
    __host__ __device__ bool next(int i, Unit& u) const {
        const long L = (long)i * G + c; if (L >= nwg) return false;
        int wgid = (int)L; { const int q = nwg / NXCD, r = nwg % NXCD, xcd = wgid % NXCD, off = wgid / NXCD; wgid = (xcd < r ? xcd * (q + 1) : r * (q + 1) + (xcd - r) * q) + off; }
        const int nig = WGM * nN, gid = wgid / nig, fm = gid * WGM, gsz = (nM - fm) < WGM ? (nM - fm) : WGM;
        u.pm = fm + ((wgid % nig) % gsz); u.pn = (wgid % nig) / gsz; return true;
    }
    __device__ __forceinline__ void a_ready(const Unit&) const {}
    __device__ __forceinline__ void done(const Unit&) const {}
};

__device__ __forceinline__ unsigned cvt_pk_bf16(float lo, float hi) { unsigned r; asm volatile("v_cvt_pk_bf16_f32 %0, %1, %2" : "=v"(r) : "v"(lo), "v"(hi)); return r; }
typedef float f32x2 __attribute__((ext_vector_type(2)));
__device__ __forceinline__ void st16_sc1(const GAS void* base, unsigned boff, u32x4 v) { asm volatile("global_store_dwordx4 %0, %1, %2 sc1\n\ts_nop 1" :: "v"(boff), "v"(v), "s"(base) : "memory"); }
__device__ __forceinline__ void st16_sc1(const GAS void* base, unsigned boff, f32x4 v) { asm volatile("global_store_dwordx4 %0, %1, %2 sc1\n\ts_nop 1" :: "v"(boff), "v"(v), "s"(base) : "memory"); }
__device__ __forceinline__ void st16_x(const GAS void* base, unsigned boff, u32x4 v, bool wt) { if (wt) st16_sc1(base, boff, v); else asm volatile("global_store_dwordx4 %0, %1, %2\n\ts_nop 1" :: "v"(boff), "v"(v), "s"(base) : "memory"); }
__device__ __forceinline__ void st16_x(const GAS void* base, unsigned boff, f32x4 v, bool wt) { if (wt) st16_sc1(base, boff, v); else asm volatile("global_store_dwordx4 %0, %1, %2\n\ts_nop 1" :: "v"(boff), "v"(v), "s"(base) : "memory"); }
struct EpiSwiglu {
    static constexpr bool PERM = true, AFTER_DRAIN = false;
    GAS bf16_t* H; const GAS float* ss; bool pure;
    __device__ __forceinline__ void operator()(const f32x4 (&acc)[2][2][4][2], const Unit& u, int wr, int wc, int fr, int fq) const {
        const int row0 = u.pm * BM + wr * 64 + fr, hcol = u.pn * 128 + wc * 32 + 8 * fq; const bool wt = !pure || u.pm >= 64;
        float rsv[2][4];
#pragma unroll
        for (int ai = 0; ai < 2; ++ai)
#pragma unroll
            for (int m = 0; m < 4; ++m) rsv[ai][m] = ss[row0 + ai * HALF + m * 16];
#pragma unroll
        for (int ai = 0; ai < 2; ++ai)
#pragma unroll
            for (int m = 0; m < 4; ++m) {
                const int row = row0 + ai * HALF + m * 16;
                const float rs = __builtin_amdgcn_rsqf(rsv[ai][m] * (1.0f / 1024.0f) + 1e-6f);
                float h[8];
                const float c1 = rs * -1.4426950408889634f, c2 = rs * rs;
#pragma unroll
                for (int n = 0; n < 2; ++n) {
                    const f32x4 ga = acc[ai][0][m][n], ua = acc[ai][1][m][n];
                    const f32x4 t = ga * c1, p = (ga * ua) * c2;
                    f32x4 d;
#pragma unroll
                    for (int j = 0; j < 4; ++j) d[j] = __builtin_amdgcn_exp2f(t[j]);
                    d = d + 1.0f;
#pragma unroll
                    for (int j = 0; j < 4; ++j) h[n * 4 + j] = p[j] * __builtin_amdgcn_rcpf(d[j]);
                }
                u32x4 w; w.x = cvt_pk_bf16(h[0], h[1]); w.y = cvt_pk_bf16(h[2], h[3]); w.z = cvt_pk_bf16(h[4], h[5]); w.w = cvt_pk_bf16(h[6], h[7]);
                st16_x(H, (unsigned)(row * 2816 + hcol) * 2u, w, wt);
            }
    }
};
struct EpiResid {
    static constexpr bool PERM = true, AFTER_DRAIN = false;
    const GAS float* base0; const GAS float* base1;
    const GAS bf16_t* baseh;
    GAS float* out; GAS bf16_t* xa; GAS float* ssout; float alpha; bool pure;
    __device__ __forceinline__ void operator()(const f32x4 (&acc)[2][2][4][2], const Unit& u, int wr, int wc, int fr, int fq) const {
        const GAS float* bb = (u.pm < 64) ? base0 + (size_t)(u.pm * BM) * 1024 : base1 + (size_t)(u.pm * BM - 16384) * 1024;
        const GAS bf16_t* bh = baseh + (size_t)(u.pm * BM) * 1024;
        GAS float* ob = out + (size_t)(u.pm * BM) * 1024; GAS bf16_t* xb = xa + (size_t)(u.pm * BM) * 1024; GAS float* sb = ssout + u.pm * BM;
        const unsigned off0 = (unsigned)((wr * 64 + fr) * 1024 + u.pn * BM + wc * 32 + 8 * fq); const bool wt = !pure || u.pm >= 64;
        if (baseh) {
            u32x4 hbv[2][4][2];
#pragma unroll
            for (int ai = 0; ai < 2; ++ai)
#pragma unroll
                for (int m = 0; m < 4; ++m)
#pragma unroll
                    for (int bj = 0; bj < 2; ++bj) hbv[ai][m][bj] = *(const GAS u32x4*)(bh + off0 + (unsigned)((ai * HALF + m * 16) * 1024) + bj * HALF);
#pragma unroll
            for (int ai = 0; ai < 2; ++ai)
#pragma unroll
                for (int m = 0; m < 4; ++m) {
                    const unsigned offr = off0 + (unsigned)((ai * HALF + m * 16) * 1024);
                    float sq = 0.f;
#pragma unroll
                    for (int bj = 0; bj < 2; ++bj) {
                        const unsigned off = offr + bj * HALF; const u32x4 hb = hbv[ai][m][bj]; f32x4 b0, b1;
                        b0[0] = __uint_as_float(hb.x << 16); b0[1] = __uint_as_float(hb.x & 0xffff0000u); b0[2] = __uint_as_float(hb.y << 16); b0[3] = __uint_as_float(hb.y & 0xffff0000u);
                        b1[0] = __uint_as_float(hb.z << 16); b1[1] = __uint_as_float(hb.z & 0xffff0000u); b1[2] = __uint_as_float(hb.w << 16); b1[3] = __uint_as_float(hb.w & 0xffff0000u);
                        const f32x4 v0 = b0 + acc[ai][bj][m][0] * alpha, v1 = b1 + acc[ai][bj][m][1] * alpha;
                        if (out) { st16_x(ob, off * 4u, v0, wt); st16_x(ob, off * 4u + 16u, v1, wt); }
                        if (xa) { u32x4 w; w.x = cvt_pk_bf16(v0[0], v0[1]); w.y = cvt_pk_bf16(v0[2], v0[3]); w.z = cvt_pk_bf16(v1[0], v1[1]); w.w = cvt_pk_bf16(v1[2], v1[3]);
                            st16_x(xb, off * 2u, w, wt); }
                        sq += (v0[0] * v0[0] + v0[1] * v0[1]) + (v0[2] * v0[2] + v0[3] * v0[3]) + (v1[0] * v1[0] + v1[1] * v1[1]) + (v1[2] * v1[2] + v1[3] * v1[3]);
                    }
                    if (ssout) { sq += shx(sq, 16, fr + 16 * fq); sq += shx(sq, 32, fr + 16 * fq);
                        if (fq == 0) __hip_atomic_fetch_add(sb + (unsigned)(wr * 64 + fr + ai * HALF + m * 16), sq, __ATOMIC_RELAXED, __HIP_MEMORY_SCOPE_AGENT); }
                    asm volatile("" ::: "memory");
                }
        } else {
#pragma unroll
            for (int ai = 0; ai < 2; ++ai) {
                f32x4 bv[4][2][2];
#pragma unroll
                for (int m = 0; m < 4; ++m)
#pragma unroll
                    for (int bj = 0; bj < 2; ++bj) { const GAS float* p_ = bb + off0 + (unsigned)((ai * HALF + m * 16) * 1024) + bj * HALF; bv[m][bj][0] = *(const GAS f32x4*)p_; bv[m][bj][1] = *(const GAS f32x4*)(p_ + 4); }
#pragma unroll
                for (int m = 0; m < 4; ++m) {
                    const unsigned offr = off0 + (unsigned)((ai * HALF + m * 16) * 1024);
                    float sq = 0.f;
#pragma unroll
                    for (int bj = 0; bj < 2; ++bj) {
                        const unsigned off = offr + bj * HALF;
                        const f32x4 v0 = bv[m][bj][0] + acc[ai][bj][m][0] * alpha, v1 = bv[m][bj][1] + acc[ai][bj][m][1] * alpha;
                        if (out) { st16_x(ob, off * 4u, v0, wt); st16_x(ob, off * 4u + 16u, v1, wt); }
                        if (xa) { u32x4 w; w.x = cvt_pk_bf16(v0[0], v0[1]); w.y = cvt_pk_bf16(v0[2], v0[3]); w.z = cvt_pk_bf16(v1[0], v1[1]); w.w = cvt_pk_bf16(v1[2], v1[3]);
                            st16_x(xb, off * 2u, w, wt); }
                        sq += (v0[0] * v0[0] + v0[1] * v0[1]) + (v0[2] * v0[2] + v0[3] * v0[3]) + (v1[0] * v1[0] + v1[1] * v1[1]) + (v1[2] * v1[2] + v1[3] * v1[3]);
                    }
                    if (ssout) { sq += shx(sq, 16, fr + 16 * fq); sq += shx(sq, 32, fr + 16 * fq);
                        if (fq == 0) __hip_atomic_fetch_add(sb + (unsigned)(wr * 64 + fr + ai * HALF + m * 16), sq, __ATOMIC_RELAXED, __HIP_MEMORY_SCOPE_AGENT); }
                    asm volatile("" ::: "memory");
                }
            }
        }
    }
};
struct EpiInProj {
    static constexpr bool PERM = true, AFTER_DRAIN = false;
    GAS bf16_t* qkv; GAS float* out; const GAS float* ss; const GAS float* bfg; bool pure;
    __device__ __forceinline__ void operator()(const f32x4 (&acc)[2][2][4][2], const Unit& u, int wr, int wc, int fr, int fq) const {
        const int pn = u.pn, row0 = u.pm * BM + wr * 64 + fr; const bool wt = !pure || u.pm >= 64;
        if (pn < 12) {
            const int kind = pn >> 1; const bool isq = (kind == 0 || kind == 3); const float sc = isq ? 0.125f * 1.4426950408889634f : 1.0f;
            size_t offp = 0, offs = 0;
            if (kind == 1) { offp = 17825792; offs = 51511296; } else if (kind == 2) { offp = 26214400; offs = 52035584; }
            else if (kind == 4) { offp = 34734080; offs = 52568064; } else if (kind == 5) { offp = 43122688; offs = 53092352; }
            const int cc = (pn & 1) * 256 + wc * 32 + 8 * fq, bc = pn * 256 + wc * 32 + 8 * fq;
            float rsv[2][4];
#pragma unroll
            for (int ai = 0; ai < 2; ++ai)
#pragma unroll
                for (int m = 0; m < 4; ++m) rsv[ai][m] = ss[row0 + ai * HALF + m * 16];
#pragma unroll
            for (int ai = 0; ai < 2; ++ai)
#pragma unroll
                for (int m = 0; m < 4; ++m) {
                    const int row = row0 + ai * HALF + m * 16;
                    const float rs = __builtin_amdgcn_rsqf(rsv[ai][m] * (1.0f / 1024.0f) + 1e-6f);
                    const unsigned fo = (unsigned)(row < 16384 ? row * 512 : (row - 16384) * 512) + cc; GAS float* fob = (u.pm < 64) ? out + offp : out + offs;
#pragma unroll
                    for (int bj = 0; bj < 2; ++bj) {
                        const f32x4 v0 = acc[ai][bj][m][0] * rs, v1 = acc[ai][bj][m][1] * rs;
                        u32x4 w; w.x = cvt_pk_bf16(v0[0] * sc, v0[1] * sc); w.y = cvt_pk_bf16(v0[2] * sc, v0[3] * sc); w.z = cvt_pk_bf16(v1[0] * sc, v1[1] * sc); w.w = cvt_pk_bf16(v1[2] * sc, v1[3] * sc);
                        st16_x(qkv, (unsigned)(row * 3072 + bc + bj * HALF) * 2u, w, wt);
                        if (!isq) { if (u.pm < 64) { *(GAS f32x4*)(fob + fo + bj * HALF) = v0; *(GAS f32x4*)(fob + fo + bj * HALF + 4) = v1; }
                                    else { st16_sc1(fob, (fo + bj * HALF) * 4u, v0); st16_sc1(fob, (fo + bj * HALF) * 4u + 16u, v1); } }
                    }
                }
        } else if (wc == 0 && fq == 0) {
            const f32x4 b0 = *(const GAS f32x4*)bfg, b1 = *(const GAS f32x4*)(bfg + 4);
            float rsv[2][4];
#pragma unroll
            for (int ai = 0; ai < 2; ++ai)
#pragma unroll
                for (int m = 0; m < 4; ++m) rsv[ai][m] = ss[row0 + ai * HALF + m * 16];
#pragma unroll
            for (int ai = 0; ai < 2; ++ai)
#pragma unroll
                for (int m = 0; m < 4; ++m) {
                    const int row = row0 + ai * HALF + m * 16;
                    const float rs = __builtin_amdgcn_rsqf(rsv[ai][m] * (1.0f / 1024.0f) + 1e-6f);
                    const GAS float* lfb = (u.pm < 64) ? out + 34603008 : out + 52559872; const unsigned lfo = (unsigned)(row < 16384 ? row : row - 16384) * 32u;
                    f32x4 z0 = acc[ai][0][m][0] * rs + b0, z1 = acc[ai][0][m][1] * rs + b1, l0, l1;
#pragma unroll
                    for (int j = 0; j < 4; ++j) { l0[j] = fminf(z0[j], 0.f) - log1pf(expf(-fabsf(z0[j]))); l1[j] = fminf(z1[j], 0.f) - log1pf(expf(-fabsf(z1[j]))); }
                    st16_x(lfb, lfo, l0, wt); st16_x(lfb, lfo + 16u, l1, wt);
                }
        }
    }
};

struct DynSched {
    int nN, xg;
    int seg_base, seg_cnt, kind, jj0;
    int first;
    gu32* qhead; gu32* dep; unsigned need0, need1; gu32* pub; gu32* fail; LAS unsigned* slot; int tid;
    mutable int acall = 0;
    __device__ __forceinline__ bool decode(int lidx, Unit& u) const {
        const int j = lidx - seg_base; if (j >= seg_cnt) return false;
        if (kind == 0) { const int half = xg & 1, c0 = half ? nN / 2 : 0; u.pm = 64 + (xg >> 1); u.pn = c0 + j; }
        else { const int jj = jj0 + j; u.pm = 8 * xg + 7 - (jj & 7); u.pn = jj >> 3; }
        return true;
    }
    __device__ __forceinline__ bool next(int i, Unit& u) const {
        return decode(first, u);
    }
    __device__ __forceinline__ unsigned next_issue() const {
        unsigned v = 0xffffffffu, zero = 0u, one = 1u; asm volatile("" : "+v"(zero), "+v"(one), "+v"(v));
        if (tid == 0) asm volatile("s_nop 4\n\tglobal_atomic_add %0, %1, %2, %3 sc0" : "+v"(v) : "v"(zero), "v"(one), "s"(qhead) : "memory");
        return v;
    }
    __device__ __forceinline__ void next_stash(unsigned v) const {
        if (tid == 0) { const unsigned a = (unsigned)(uintptr_t)slot;
            asm volatile("s_waitcnt vmcnt(16)\n\tv_cmp_eq_u32 vcc, -1, %1\n\ts_cbranch_vccz .Lqs%=\n\ts_waitcnt vmcnt(0)\n.Lqs%=:\n\tds_write_b32 %0, %1" :: "v"(a), "v"(v) : "memory", "vcc"); }
    }
    __device__ __forceinline__ bool next_collect(Unit& u) const {
        asm volatile("s_waitcnt lgkmcnt(0)" ::: "memory"); __builtin_amdgcn_s_barrier(); asm volatile("" ::: "memory");
        const int lidx = __builtin_amdgcn_readfirstlane(slot[0]);
        return decode(lidx, u);
    }
    __device__ __forceinline__ void a_ready(const Unit& u) const {
        if (!dep) return;
        const int k = acall++; const bool skip = (int)slot[2 + (k & 1)] == u.pm;
        if (!skip) {
            if (tid < 64) {
#ifdef DBG_WAITACC_G
                const unsigned tw0_ = (unsigned)__builtin_amdgcn_s_memrealtime();
#endif
                const unsigned need = u.pm < 64 ? need0 : need1; unsigned spins = 0;
                while ((unsigned)__builtin_amdgcn_readfirstlane(__hip_atomic_load(dep + 64 * u.pm, __ATOMIC_RELAXED, __HIP_MEMORY_SCOPE_AGENT)) < need) {
                    __builtin_amdgcn_s_sleep(8);
                    if ((++spins & 1023u) == 0u) { if (__builtin_amdgcn_readfirstlane(__hip_atomic_load(fail, __ATOMIC_RELAXED, __HIP_MEMORY_SCOPE_AGENT)) != 0u) break;
                        if (spins > (1u << 16)) { if (tid == 0) __hip_atomic_store(fail, 1u, __ATOMIC_RELAXED, __HIP_MEMORY_SCOPE_AGENT); break; } }
                }
#ifdef DBG_CONSDELAY
                if (u.pm >= 64) { const unsigned long long t0d_ = __builtin_amdgcn_s_memrealtime(); while (__builtin_amdgcn_s_memrealtime() - t0d_ < (unsigned long long)DBG_CONSDELAY) __builtin_amdgcn_s_sleep(8); }
#endif
                __builtin_amdgcn_fence(__ATOMIC_ACQUIRE, "agent");
                asm volatile("s_waitcnt vmcnt(0)" ::: "memory");
#ifdef DBG_WAITACC_G
                if (tid == 0) slot[8] += (unsigned)__builtin_amdgcn_s_memrealtime() - tw0_;
#endif
            }
            asm volatile("" ::: "memory"); __builtin_amdgcn_s_barrier(); asm volatile("" ::: "memory");
        }
        if (tid == 0) slot[2 + ((k + 1) & 1)] = (unsigned)u.pm;
    }
    __device__ __forceinline__ void done(const Unit& u) const {
        asm volatile("s_waitcnt vmcnt(0)" ::: "memory");
        if ((tid & 63) == 0) __hip_atomic_fetch_add(pub + 64 * u.pm, 1u, __ATOMIC_RELAXED, __HIP_MEMORY_SCOPE_AGENT);
    }
};

template <class Epi, class Sched, bool ALIGN_EPI = false, bool SP2 = false>
__device__ __forceinline__ void gemm_phase(PG8_LAS unsigned char* lds, const Gemm g, const Sched& S, const Epi& E, const int tid) {
    const int wid = __builtin_amdgcn_readfirstlane(tid >> 6), lane = tid & 63, wr = wid >> 2, wc = wid & 3, fr = lane & 15, fq = lane >> 4;
    const int K = g.K, nt = K / BK;
    unsigned voffA[2], voffB[2];
#pragma unroll
    for (int i = 0; i < 2; ++i) { int R, C; stage_rc(tid * 16 + i * 8192, R, C); const int Rb = Epi::PERM ? ((R & ~31) + perm32(R & 31)) : R;
        voffA[i] = (unsigned)(R * K + C) * 2u; voffB[i] = (unsigned)(Rb * K + C) * 2u; }
    const size_t kstep = (size_t)(BK * 2);
    const size_t hstep = (size_t)HALF * K * 2;
    const size_t tstep = 2 * hstep;
    const unsigned ldsw = (unsigned)wid * 1024u;
    const int aoff = lds_byte(wr * 64 + fr, fq * 8), boff = lds_byte(wc * 32 + fr, fq * 8);
#define PG8_SA(b, h) (((b) * 2 + (h)) * HTB)
#define PG8_SB(b, h) ((4 + (b) * 2 + (h)) * HTB)
#define PG8_STAGE(bufoff, gbase, voff) do { _Pragma("unroll") for (int _i = 0; _i < 2; ++_i) \
        __builtin_amdgcn_global_load_lds((const unsigned*)((const char*)(gbase) + (voff)[_i]), (PG8_LAS unsigned*)(lds + (bufoff) + ldsw + _i * 8192), 16, 0, 0); } while (0)
#define PG8_LDA(dst, b, h) do { _Pragma("unroll") for (int m = 0; m < 4; ++m) _Pragma("unroll") for (int k = 0; k < 2; ++k) dst[m][k] = *(const PG8_LAS bf16x8*)(lds + PG8_SA(b, h) + aoff + m * 2048 + k * 1024); } while (0)
#define PG8_LDB(dst, b, h) do { _Pragma("unroll") for (int n = 0; n < 2; ++n) _Pragma("unroll") for (int k = 0; k < 2; ++k) dst[n][k] = *(const PG8_LAS bf16x8*)(lds + PG8_SB(b, h) + boff + n * 2048 + k * 1024); } while (0)
#define PG8_MMA(ai, bj, At, Bt) do { __builtin_amdgcn_s_setprio(1); _Pragma("unroll") for (int m = 0; m < 4; ++m) _Pragma("unroll") for (int n = 0; n < 2; ++n) _Pragma("unroll") for (int k = 0; k < 2; ++k) \
        acc[ai][bj][m][n] = __builtin_amdgcn_mfma_f32_16x16x32_bf16(Bt[n][k], At[m][k], acc[ai][bj][m][n], 0, 0, 0); __builtin_amdgcn_s_setprio(0); } while (0)
#define PG8_WAIT_V(n) asm volatile("s_waitcnt vmcnt(" #n ")" ::: "memory")
#define PG8_WAIT_L(n) asm volatile("s_waitcnt lgkmcnt(" #n ")" ::: "memory")
#define PG8_BAR __builtin_amdgcn_s_barrier()
#define PG8_SCHED __builtin_amdgcn_sched_barrier(0)
    Unit cur, nxt; int ui = 0;
    if (!S.next(0, cur)) return;
    f32x4 acc[2][2][4][2];
#pragma unroll
    for (int a = 0; a < 2; ++a)
#pragma unroll
        for (int b = 0; b < 2; ++b)
#pragma unroll
            for (int m = 0; m < 4; ++m)
#pragma unroll
                for (int n = 0; n < 2; ++n) acc[a][b][m][n] = (f32x4){0.f, 0.f, 0.f, 0.f};
    bf16x8 At[4][2], B0[2][2], B1[2][2];
    const char* cA = (const char*)g.A + (size_t)cur.pm * tstep; const char* cB = (const char*)g.Bt + (size_t)cur.pn * tstep;
    S.a_ready(cur);
    if constexpr (SP2) {
        PG8_STAGE(PG8_SB(0, 0), cB, voffB); PG8_STAGE(PG8_SB(0, 1), cB + hstep, voffB); PG8_STAGE(PG8_SA(0, 0), cA, voffA); PG8_STAGE(PG8_SA(0, 1), cA + hstep, voffA);
        if (wr == 1) PG8_BAR;
        PG8_WAIT_V(2); PG8_BAR;
        PG8_STAGE(PG8_SB(1, 0), cB + kstep, voffB); PG8_STAGE(PG8_SA(1, 0), cA + kstep, voffA); PG8_STAGE(PG8_SB(1, 1), cB + hstep + kstep, voffB);
        PG8_WAIT_V(6); PG8_BAR;
    } else {
        PG8_STAGE(PG8_SB(0, 0), cB, voffB); PG8_STAGE(PG8_SA(0, 0), cA, voffA); PG8_STAGE(PG8_SB(0, 1), cB + hstep, voffB); PG8_STAGE(PG8_SA(0, 1), cA + hstep, voffA);
        if (wr == 1) PG8_BAR;
        PG8_WAIT_V(4); PG8_BAR;
        PG8_STAGE(PG8_SB(1, 0), cB + kstep, voffB); PG8_STAGE(PG8_SA(1, 0), cA + kstep, voffA); PG8_STAGE(PG8_SB(1, 1), cB + hstep + kstep, voffB);
        PG8_WAIT_V(6); PG8_BAR;
    }
    for (;;) {
        const unsigned pend = S.next_issue();
        bool has_next = false;
        const char* nA = cA; const char* nB = cB;
#ifdef DBG_KACC
        const unsigned tk0_ = (unsigned)__builtin_amdgcn_s_memrealtime();
#endif
        for (int t = 0; t < nt; t += 2) {
            const bool last = (t == nt - 2);
            if (t == 2) S.next_stash(pend);
            if (last) { has_next = S.next_collect(nxt); if (has_next) { nA = (const char*)g.A + (size_t)nxt.pm * tstep; nB = (const char*)g.Bt + (size_t)nxt.pn * tstep; S.a_ready(nxt); } }
            const char* a1 = cA + (size_t)(t + 1) * kstep;
            const char* a2 = last ? nA : cA + (size_t)(t + 2) * kstep; const char* b2 = last ? nB : cB + (size_t)(t + 2) * kstep;
            const char* a3 = a2 + kstep; const char* b3 = b2 + kstep;
            if constexpr (SP2) {
            PG8_LDB(B0, 0, 0); PG8_LDB(B1, 0, 1); PG8_SCHED; PG8_LDA(At, 0, 0); PG8_STAGE(PG8_SA(1, 1), a1 + hstep, voffA);
            PG8_WAIT_V(8); PG8_WAIT_L(0); PG8_BAR; PG8_MMA(0, 0, At, B0); PG8_MMA(0, 1, At, B1); PG8_BAR; PG8_SCHED;
            PG8_LDA(At, 0, 1); PG8_STAGE(PG8_SB(0, 0), b2, voffB); PG8_STAGE(PG8_SB(0, 1), b2 + hstep, voffB); PG8_STAGE(PG8_SA(0, 0), a2, voffA);
            PG8_WAIT_V(8); PG8_WAIT_L(0); PG8_BAR; PG8_MMA(1, 0, At, B0); PG8_MMA(1, 1, At, B1); PG8_BAR; PG8_SCHED;
            PG8_LDB(B0, 1, 0); PG8_LDB(B1, 1, 1); PG8_SCHED; PG8_LDA(At, 1, 0); PG8_STAGE(PG8_SA(0, 1), a2 + hstep, voffA);
            PG8_WAIT_V(8); PG8_WAIT_L(0); PG8_BAR; PG8_MMA(0, 0, At, B0); PG8_MMA(0, 1, At, B1); PG8_BAR; PG8_SCHED;
            PG8_LDA(At, 1, 1); PG8_STAGE(PG8_SB(1, 0), b3, voffB); PG8_STAGE(PG8_SB(1, 1), b3 + hstep, voffB); PG8_STAGE(PG8_SA(1, 0), a3, voffA);
            PG8_WAIT_V(8); PG8_WAIT_L(0); PG8_BAR; PG8_MMA(1, 0, At, B0); PG8_MMA(1, 1, At, B1); PG8_BAR; PG8_SCHED;
            } else {
            PG8_LDB(B0, 0, 0); PG8_SCHED; PG8_LDA(At, 0, 0); PG8_STAGE(PG8_SA(1, 1), a1 + hstep, voffA);
            PG8_WAIT_L(8); PG8_BAR; PG8_WAIT_L(0); PG8_MMA(0, 0, At, B0); PG8_BAR; PG8_SCHED;
            PG8_LDB(B1, 0, 1); PG8_STAGE(PG8_SB(0, 0), b2, voffB);
            PG8_BAR; PG8_WAIT_L(0); PG8_MMA(0, 1, At, B1); PG8_BAR;
            PG8_LDA(At, 0, 1); PG8_STAGE(PG8_SA(0, 0), a2, voffA);
            PG8_BAR; PG8_WAIT_L(0); PG8_MMA(1, 0, At, B0); PG8_BAR; PG8_SCHED;
            PG8_STAGE(PG8_SB(0, 1), b2 + hstep, voffB);
            PG8_WAIT_V(6); PG8_BAR; PG8_MMA(1, 1, At, B1); PG8_BAR;
            PG8_LDB(B0, 1, 0); PG8_SCHED; PG8_LDA(At, 1, 0); PG8_STAGE(PG8_SA(0, 1), a2 + hstep, voffA);
            PG8_WAIT_L(8); PG8_BAR; PG8_WAIT_L(0); PG8_MMA(0, 0, At, B0); PG8_BAR; PG8_SCHED;
            PG8_LDB(B1, 1, 1); PG8_STAGE(PG8_SB(1, 0), b3, voffB);
            PG8_BAR; PG8_WAIT_L(0); PG8_MMA(0, 1, At, B1); PG8_BAR;
            PG8_LDA(At, 1, 1); PG8_STAGE(PG8_SA(1, 0), a3, voffA);
            PG8_BAR; PG8_WAIT_L(0); PG8_MMA(1, 0, At, B0); PG8_BAR; PG8_SCHED;
            PG8_STAGE(PG8_SB(1, 1), b3 + hstep, voffB);
            PG8_WAIT_V(6); PG8_BAR; PG8_MMA(1, 1, At, B1); PG8_BAR;
            }
        }
#ifdef DBG_KACC
        const unsigned tk1_ = (unsigned)__builtin_amdgcn_s_memrealtime(); if (tid == 0) { S.slot[9] += tk1_ - tk0_; S.slot[11] += 1u; }
#endif
        if constexpr (ALIGN_EPI) { if (wr == 0) PG8_BAR; }
        if constexpr (!Epi::AFTER_DRAIN) { E(acc, cur, wr, wc, fr, fq); S.done(cur); }
#ifdef DBG_KACC
        if (tid == 0) S.slot[10] += (unsigned)__builtin_amdgcn_s_memrealtime() - tk1_;
#endif
        if (!has_next) break;
#pragma unroll
        for (int a = 0; a < 2; ++a)
#pragma unroll
            for (int b = 0; b < 2; ++b)
#pragma unroll
                for (int m = 0; m < 4; ++m)
#pragma unroll
                    for (int n = 0; n < 2; ++n) acc[a][b][m][n] = (f32x4){0.f, 0.f, 0.f, 0.f};
        cur = nxt; cA = nA; cB = nB; ++ui;
        if constexpr (ALIGN_EPI) { if (wr == 1) PG8_BAR; }
    }
    PG8_WAIT_V(0);
    if constexpr (!ALIGN_EPI) { if (wr == 0) PG8_BAR; }
    PG8_BAR;
    if constexpr (Epi::AFTER_DRAIN) { E.fused(acc, cur, wr, wc, fr, fq, lds, wid, lane); S.done(cur); }
#undef PG8_SA
#undef PG8_SB
#undef PG8_STAGE
#undef PG8_LDA
#undef PG8_LDB
#undef PG8_MMA
#undef PG8_WAIT_V
#undef PG8_WAIT_L
#undef PG8_BAR
#undef PG8_SCHED
}
}
namespace att {
typedef short bf16x8 __attribute__((ext_vector_type(8)));
typedef short s16x4 __attribute__((ext_vector_type(4)));
typedef float f32x16 __attribute__((ext_vector_type(16)));
typedef unsigned u32x4 __attribute__((ext_vector_type(4)));
typedef LAS const char* lds_cptr;
typedef short v4i16_t __attribute__((ext_vector_type(4)));
constexpr float THR = 8.0f;
constexpr int PITCH = 3072;

__device__ __forceinline__ int crow(int r, int hi) { return (r & 3) + 8 * (r >> 2) + 4 * hi; }
__device__ __forceinline__ float neg_inf_s() { float v; asm volatile("s_mov_b32 %0, 0xff800000" : "=s"(v)); return v; }
__device__ __forceinline__ void glds16(const GAS void* gsrc, unsigned lds_dst) { unsigned keep;
    asm volatile("s_mov_b32 %0, m0\n\ts_mov_b32 m0, %2\n\ts_nop 0\n\tglobal_load_lds_dwordx4 %1, off\n\ts_mov_b32 m0, %0" : "=&s"(keep) : "v"(gsrc), "s"(lds_dst) : "memory"); }
__device__ __forceinline__ s16x4 vtr(lds_cptr p) { return __builtin_bit_cast(s16x4, __builtin_amdgcn_ds_read_tr16_b64_v4i16((LAS v4i16_t*)p)); }
#define ABAR_L() asm volatile("s_waitcnt lgkmcnt(0)\n\ts_barrier" ::: "memory")
#define ABAR_VL() asm volatile("s_waitcnt vmcnt(0) lgkmcnt(0)\n\ts_barrier" ::: "memory")

template <int NDV>
__device__ __forceinline__ void sm_part(f32x16 s, float& m, float& l, f32x16 (&o)[NDV], LAS float* wsf, int r32, int hi, bf16x8& pa0, bf16x8& pa1) {
    float pm = s[0];
#pragma unroll
    for (int r = 1; r < 16; ++r) pm = fmaxf(pm, s[r]);
    { auto rr = __builtin_amdgcn_permlane32_swap(__float_as_uint(pm), __float_as_uint(pm), false, false); pm = fmaxf(__uint_as_float(rr[0]), __uint_as_float(rr[1])); }
    if (!__all(pm <= m + THR)) {
        const float mn = fmaxf(m, pm), alpha = __builtin_amdgcn_exp2f(m - mn); m = mn; l *= alpha;
        if (hi == 0) wsf[r32] = alpha;
        LDS_WAIT();
#pragma unroll
        for (int r = 0; r < 16; ++r) { const float a = wsf[crow(r, hi)];
#pragma unroll
            for (int d0 = 0; d0 < NDV; ++d0) o[d0][r] *= a; }
        LDS_WAIT();
    }
    float ps = 0.f;
#pragma unroll
    for (int r = 0; r < 16; ++r) { s[r] = __builtin_amdgcn_exp2f(s[r] - m); ps += s[r]; }
    l += ps;
    u32x4 w0, w1;
    w0.x = pk2(s[0], s[1]); w0.y = pk2(s[2], s[3]); w0.z = pk2(s[4], s[5]); w0.w = pk2(s[6], s[7]);
    w1.x = pk2(s[8], s[9]); w1.y = pk2(s[10], s[11]); w1.z = pk2(s[12], s[13]); w1.w = pk2(s[14], s[15]);
    pa0 = __builtin_bit_cast(bf16x8, w0); pa1 = __builtin_bit_cast(bf16x8, w1);
}
template <int NDV, int KG>
__device__ __forceinline__ void pv_part(bf16x8 pa0, bf16x8 pa1, f32x16 (&o)[NDV], lds_cptr vb) {
#pragma unroll
    for (int d0 = 0; d0 < NDV; ++d0) {
        const s16x4 a0 = vtr(vb + (d0 * KG + 0) * 1024), a1 = vtr(vb + (d0 * KG + 0) * 1024 + 512);
        const s16x4 b0 = vtr(vb + (d0 * KG + 1) * 1024), b1 = vtr(vb + (d0 * KG + 1) * 1024 + 512);
        const bf16x8 v0 = {a0[0], a0[1], a0[2], a0[3], a1[0], a1[1], a1[2], a1[3]}, v1 = {b0[0], b0[1], b0[2], b0[3], b1[0], b1[1], b1[2], b1[3]};
        o[d0] = __builtin_amdgcn_mfma_f32_32x32x16_bf16(pa0, v0, o[d0], 0, 0, 0);
        o[d0] = __builtin_amdgcn_mfma_f32_32x32x16_bf16(pa1, v1, o[d0], 0, 0, 0);
    }
}
template <int NDV, int KG>
__device__ __forceinline__ void sm_pv(f32x16 s, float& m, float& l, f32x16 (&o)[NDV], lds_cptr vb, LAS float* wsf, int r32, int hi) {
    bf16x8 pa0, pa1; sm_part<NDV>(s, m, l, o, wsf, r32, hi, pa0, pa1); pv_part<NDV, KG>(pa0, pa1, o, vb);
}
template <int NDV>
__device__ __forceinline__ void sm_pv64(f32x16 s0, f32x16 s1, float& m, float& l, f32x16 (&o)[NDV], lds_cptr vb, LAS float* wsf, int r32, int hi) {
    float pa = fmaxf(s0[0], s1[0]), pb = fmaxf(s0[1], s1[1]);
#pragma unroll
    for (int r = 2; r < 16; r += 2) { pa = fmaxf(pa, fmaxf(s0[r], s1[r])); pb = fmaxf(pb, fmaxf(s0[r + 1], s1[r + 1])); }
    float pm = fmaxf(pa, pb);
    { auto rr = __builtin_amdgcn_permlane32_swap(__float_as_uint(pm), __float_as_uint(pm), false, false); pm = fmaxf(__uint_as_float(rr[0]), __uint_as_float(rr[1])); }
    if (!__all(pm <= m + THR)) {
        const float mn = fmaxf(m, pm), alpha = __builtin_amdgcn_exp2f(m - mn); m = mn; l *= alpha;
        if (hi == 0) wsf[r32] = alpha;
        LDS_WAIT();
#pragma unroll
        for (int r = 0; r < 16; ++r) { const float a = wsf[crow(r, hi)];
#pragma unroll
            for (int d0 = 0; d0 < NDV; ++d0) o[d0][r] *= a; }
        LDS_WAIT();
    }
    float ps0 = 0.f, ps1 = 0.f;
#pragma unroll
    for (int r = 0; r < 16; ++r) { s0[r] = __builtin_amdgcn_exp2f(s0[r] - m); ps0 += s0[r]; s1[r] = __builtin_amdgcn_exp2f(s1[r] - m); ps1 += s1[r]; }
    l += ps0 + ps1;
    u32x4 w0, w1, w2, w3;
    w0.x = pk2(s0[0], s0[1]); w0.y = pk2(s0[2], s0[3]); w0.z = pk2(s0[4], s0[5]); w0.w = pk2(s0[6], s0[7]);
    w1.x = pk2(s0[8], s0[9]); w1.y = pk2(s0[10], s0[11]); w1.z = pk2(s0[12], s0[13]); w1.w = pk2(s0[14], s0[15]);
    w2.x = pk2(s1[0], s1[1]); w2.y = pk2(s1[2], s1[3]); w2.z = pk2(s1[4], s1[5]); w2.w = pk2(s1[6], s1[7]);
    w3.x = pk2(s1[8], s1[9]); w3.y = pk2(s1[10], s1[11]); w3.z = pk2(s1[12], s1[13]); w3.w = pk2(s1[14], s1[15]);
    const bf16x8 pa0 = __builtin_bit_cast(bf16x8, w0), pa1 = __builtin_bit_cast(bf16x8, w1), pa2 = __builtin_bit_cast(bf16x8, w2), pa3 = __builtin_bit_cast(bf16x8, w3);
#pragma unroll
    for (int d0 = 0; d0 < NDV; ++d0) {
        s16x4 lo[4], hh[4];
#pragma unroll
        for (int ks = 0; ks < 4; ++ks) { lo[ks] = vtr(vb + (d0 * 4 + ks) * 1024); hh[ks] = vtr(vb + (d0 * 4 + ks) * 1024 + 512); }
#define VF_(k) (bf16x8){lo[k][0], lo[k][1], lo[k][2], lo[k][3], hh[k][0], hh[k][1], hh[k][2], hh[k][3]}
        o[d0] = __builtin_amdgcn_mfma_f32_32x32x16_bf16(pa0, VF_(0), o[d0], 0, 0, 0);
        o[d0] = __builtin_amdgcn_mfma_f32_32x32x16_bf16(pa1, VF_(1), o[d0], 0, 0, 0);
        o[d0] = __builtin_amdgcn_mfma_f32_32x32x16_bf16(pa2, VF_(2), o[d0], 0, 0, 0);
        o[d0] = __builtin_amdgcn_mfma_f32_32x32x16_bf16(pa3, VF_(3), o[d0], 0, 0, 0);
#undef VF_
    }
}
template <int NDV>
__device__ __forceinline__ void normalize_o(f32x16 (&o)[NDV], float l, LAS float* wsf, int r32, int hi) {
    { auto rr = __builtin_amdgcn_permlane32_swap(__float_as_uint(l), __float_as_uint(l), false, false); l = __uint_as_float(rr[0]) + __uint_as_float(rr[1]); }
    if (hi == 0) wsf[64 + r32] = l;
    LDS_WAIT();
#pragma unroll
    for (int r = 0; r < 16; ++r) { const float a = __builtin_amdgcn_rcpf(wsf[64 + crow(r, hi)]);
#pragma unroll
        for (int d0 = 0; d0 < NDV; ++d0) o[d0][r] *= a; }
    LDS_WAIT();
}

constexpr int PSLOT = 24576, PCB = 98304;
template <int NDV, bool FOX>
__device__ __forceinline__ void prompt_pass(const GAS bf16* Qw, const GAS bf16* Kg, const GAS bf16* Vg, int qb, int w, int lane, LAS char* lds, float slope2, f32x16 (&o)[NDV]) {
    const int r32 = lane & 31, hi = lane >> 5;
    const unsigned lds0 = (unsigned)(uintptr_t)lds;
    LAS float* wsf = (LAS float*)(lds + ATT_WSF) + w * 128;
    LAS const float* cb = (LAS const float*)(lds + PCB);
    bf16x8 qr[4];
#pragma unroll
    for (int d0 = 0; d0 < 4; ++d0) qr[d0] = *(const GAS bf16x8*)(Qw + (size_t)r32 * PITCH + d0 * 16 + hi * 8);
#pragma unroll
    for (int d0 = 0; d0 < NDV; ++d0) o[d0] = f32x16{};
    float m = -1e30f, l = 0.f;
    const int NT = 4 * qb + 4;
    const int my_last_t = 4 * qb + (w >> 1);
    const GAS bf16* ksrc = Kg + (size_t)lane * PITCH + w * 8;
    const GAS bf16* vsrc0 = Vg + (size_t)(16 * (w & 3) + (lane >> 2)) * PITCH + (w >> 2) * 32 + (lane & 3) * 8;
    const GAS bf16* vsrc1 = vsrc0 + 64;
#define DMA_TILE(i_) do { const size_t go_ = (size_t)(NT - 1 - (i_)) * 64 * PITCH; const unsigned sl_ = lds0 + ((i_) & 3) * PSLOT; \
        glds16(ksrc + go_, (unsigned)__builtin_amdgcn_readfirstlane(sl_ + w * 1024)); \
        glds16(vsrc0 + go_, (unsigned)__builtin_amdgcn_readfirstlane(sl_ + 8192 + w * 1024)); \
        if (NDV == 4) glds16(vsrc1 + go_, (unsigned)__builtin_amdgcn_readfirstlane(sl_ + 8192 + (w + 8) * 1024)); } while (0)
#define WAIT_TILES(n_) do { if (NDV == 4) { if ((n_) == 2) asm volatile("s_waitcnt vmcnt(6) lgkmcnt(0)\n\ts_barrier" ::: "memory"); else if ((n_) == 1) asm volatile("s_waitcnt vmcnt(3) lgkmcnt(0)\n\ts_barrier" ::: "memory"); else ABAR_VL(); } \
        else { if ((n_) == 2) asm volatile("s_waitcnt vmcnt(4) lgkmcnt(0)\n\ts_barrier" ::: "memory"); else if ((n_) == 1) asm volatile("s_waitcnt vmcnt(2) lgkmcnt(0)\n\ts_barrier" ::: "memory"); else ABAR_VL(); } } while (0)
    asm volatile("s_waitcnt vmcnt(0)" ::: "memory");
    DMA_TILE(0); DMA_TILE(1); DMA_TILE(2);
    WAIT_TILES(2);
    for (int i = 0; i < NT; ++i) {
        const int t = NT - 1 - i;
        if (i + 3 < NT) DMA_TILE(i + 3);
        const lds_cptr kimg = (lds_cptr)lds + (i & 3) * PSLOT, vimg = kimg + 8192;
        if (t <= my_last_t) {
            f32x16 c0, c1;
            if (FOX) {
#pragma unroll
                for (int g = 0; g < 4; ++g) { const f32x4 x = *(LAS const f32x4*)(cb + 64 * t + 8 * g + 4 * hi), y = *(LAS const f32x4*)(cb + 64 * t + 32 + 8 * g + 4 * hi);
                    c0[4 * g] = x[0]; c0[4 * g + 1] = x[1]; c0[4 * g + 2] = x[2]; c0[4 * g + 3] = x[3]; c1[4 * g] = y[0]; c1[4 * g + 1] = y[1]; c1[4 * g + 2] = y[2]; c1[4 * g + 3] = y[3]; }
            } else {
                const int kb = 64 * t - 256 * qb;
                if (t == my_last_t) { const int tq2 = 2 * (32 * w + r32);
#pragma unroll
                    for (int r = 0; r < 16; ++r) { const int sa = kb + crow(r, hi), sb = sa + 32; const int va = sa < tq2 - sa ? sa : tq2 - sa, vb2 = sb < tq2 - sb ? sb : tq2 - sb; c0[r] = slope2 * (float)va; c1[r] = slope2 * (float)vb2; }
                } else {
#pragma unroll
                    for (int r = 0; r < 16; ++r) { c0[r] = slope2 * (float)(kb + crow(r, hi)); c1[r] = slope2 * (float)(kb + 32 + crow(r, hi)); }
                }
            }
#pragma unroll
            for (int d0 = 0; d0 < 4; ++d0) { const bf16x8 ka = *(LAS const bf16x8*)(kimg + (2 * d0 + hi) * 1024 + r32 * 16), kb2 = *(LAS const bf16x8*)(kimg + (2 * d0 + hi) * 1024 + (32 + r32) * 16);
                c0 = __builtin_amdgcn_mfma_f32_32x32x16_bf16(ka, qr[d0], c0, 0, 0, 0); c1 = __builtin_amdgcn_mfma_f32_32x32x16_bf16(kb2, qr[d0], c1, 0, 0, 0); }
            if (FOX && t == my_last_t) { const int qrow = 32 * (w & 1) + r32; const float ninf = neg_inf_s();
#pragma unroll
                for (int r = 0; r < 16; ++r) { if (crow(r, hi) > qrow) c0[r] = ninf; if (32 + crow(r, hi) > qrow) c1[r] = ninf; }
            }
            const lds_cptr vb = vimg + (4 * hi + ((lane & 15) >> 2)) * 64 + ((lane >> 4) & 1) * 32 + (lane & 3) * 8;
            sm_pv64<NDV>(c0, c1, m, l, o, vb, wsf, r32, hi);
        }
        if (i + 3 < NT) WAIT_TILES(2); else if (i + 2 < NT) WAIT_TILES(1); else WAIT_TILES(0);
    }
#undef DMA_TILE
#undef WAIT_TILES
    normalize_o<NDV>(o, l, wsf, r32, hi);
}

__device__ __forceinline__ void fox_bias_scan(const GAS float* lf, int n, int qb, LAS char* lds, int tid, int lane, int w) {
    LAS float* cb = (LAS float*)(lds + PCB); LAS float* tmp = (LAS float*)(lds + ATT_TMP);
    float a[4];
#pragma unroll
    for (int k = 0; k < 4; ++k) { const int s = 4 * tid + k; a[k] = s < n ? lf[(size_t)s * 8] : 0.f; }
    a[1] += a[0]; a[2] += a[1]; a[3] += a[2];
    const float tot = a[3]; float v = tot;
#pragma unroll
    for (int o = 1; o < 64; o <<= 1) { const float t = shl_from(v, lane >= o ? lane - o : lane); if (lane >= o) v += t; }
    if (lane == 63) tmp[w] = v;
    ABAR_L();
    float base = 0.f;
    for (int ww = 0; ww < w; ++ww) base += tmp[ww];
    const float excl = base + v - tot;
#pragma unroll
    for (int k = 0; k < 4; ++k) a[k] += excl;
    if (qb > 0 && tid == 64 * qb - 1) tmp[8] = a[3];
    ABAR_L();
    const float R = qb > 0 ? tmp[8] : 0.f;
    f32x4 cv; cv[0] = (R - a[0]) * LOG2E; cv[1] = (R - a[1]) * LOG2E; cv[2] = (R - a[2]) * LOG2E; cv[3] = (R - a[3]) * LOG2E;
    *(LAS f32x4*)(cb + 4 * tid) = cv;
    ABAR_L();
}

template <bool FOX>
__device__ __forceinline__ void sample_pass(const GAS bf16* Qg, const GAS float* Kc, const GAS float* Kn, const GAS float* Vc, const GAS float* Vn, const GAS float* bcs, const GAS float* lfn, float slope2,
                                            int w, int lane, int tid, LAS char* lds, float (&res)[FOX ? 4 : 8]) {
    constexpr int NSP = FOX ? 8 : 4, DPT = FOX ? 4 : 8, NDV = 2;
    const int wsub = w % NSP, grp = w / NSP;
    const int r32 = lane & 31, hi = lane >> 5;
    LAS float* wsf = (LAS float*)(lds + ATT_WSF) + w * 128;
    LAS char* myreg = lds + w * 16384;
    Vc += grp * 64; Vn += grp * 64;
    bf16x8 qr[4];
#pragma unroll
    for (int d0 = 0; d0 < 4; ++d0) qr[d0] = *(const GAS bf16x8*)(Qg + (size_t)r32 * PITCH + d0 * 16 + hi * 8);
    f32x16 o[NDV];
#pragma unroll
    for (int d0 = 0; d0 < NDV; ++d0) o[d0] = f32x16{};
    float m = -1e30f, l = 0.f;
    float nbias = 0.f;
    if (FOX && w == 0) { float v = lane < 32 ? lfn[(size_t)lane * 8] : 0.f;
#pragma unroll
        for (int o2 = 1; o2 < 32; o2 <<= 1) { const float t = shl_from(v, lane >= o2 ? lane - o2 : lane); if (lane >= o2) v += t; }
        nbias = -v * LOG2E; }
    constexpr int CNT = 64 / NSP;
    const int nsteps = (wsub == 0) ? CNT + 1 : CNT;
    const lds_cptr vbw = (lds_cptr)myreg + (4 * hi + ((lane & 15) >> 2)) * 64 + ((lane >> 4) & 1) * 32 + (lane & 3) * 8;
    f32x4 kx[2][8], vx[8];
#define STEP_OF(i_) ((wsub == 0) ? ((i_) == 0 ? 64 : NSP * (CNT - (i_))) : (wsub + NSP * (CNT - 1 - (i_))))
#define ISSUE_K(U, i_) do { const int s_ = STEP_OF(i_); const bool new_ = (s_ == 64); \
        const GAS float* Kb_ = new_ ? Kn : Kc + (size_t)(32 * s_) * 512; \
        int lv_ = lane; asm volatile("" : "+v"(lv_)); \
        const GAS float* kp_ = Kb_ + (size_t)(lv_ & 31) * 512 + 8 * (lv_ >> 5); \
        _Pragma("unroll") for (int d0 = 0; d0 < 4; ++d0) { kx[U][2 * d0] = *(const GAS f32x4*)(kp_ + 16 * d0); kx[U][2 * d0 + 1] = *(const GAS f32x4*)(kp_ + 16 * d0 + 4); } } while (0)
#define ISSUE_V(i_) do { const int s_ = STEP_OF(i_); const bool new_ = (s_ == 64); \
        const GAS float* Vb_ = new_ ? Vn : Vc + (size_t)(32 * s_) * 512; \
        int lv_ = lane; asm volatile("" : "+v"(lv_)); \
        const GAS float* vp_ = Vb_ + (size_t)(lv_ >> 4) * 512 + 4 * (lv_ & 15); \
        _Pragma("unroll") for (int i2 = 0; i2 < 8; ++i2) vx[i2] = *(const GAS f32x4*)(vp_ + (size_t)(4 * i2) * 512); } while (0)
    ISSUE_K(0, 0); ISSUE_V(0);
    constexpr bool DEEP = FOX;
    if (DEEP && 1 < nsteps) ISSUE_K(1, 1);
    for (int i0 = 0; i0 < nsteps; i0 += 2) {
#pragma unroll
      for (int u = 0; u < 2; ++u) {
        const int i = i0 + u;
        if (i >= nsteps) break;
        const int s = STEP_OF(i);
        const bool isnew = (s == 64);
        int lv = lane; asm volatile("" : "+v"(lv));
        const int r32v = lv & 31, hiv = lv >> 5;
        const int vkey = lv >> 4, vdd = 4 * (lv & 15);
        LAS char* vdst = myreg + ((vdd >> 5) * 2) * 1024 + vkey * 64 + (vdd & 31) * 2;
        __builtin_amdgcn_sched_barrier(0);
        bf16x8 kf[4];
#pragma unroll
        for (int d0 = 0; d0 < 4; ++d0) { const f32x4 a = kx[DEEP ? u : 0][2 * d0], b = kx[DEEP ? u : 0][2 * d0 + 1];
            u32x4 pk; pk.x = pk2(a[0], a[1]); pk.y = pk2(a[2], a[3]); pk.z = pk2(b[0], b[1]); pk.w = pk2(b[2], b[3]); kf[d0] = __builtin_bit_cast(bf16x8, pk); }
#pragma unroll
        for (int i2 = 0; i2 < 8; ++i2) { const int kk = 4 * i2; v2u pk; pk.x = pk2(vx[i2][0], vx[i2][1]); pk.y = pk2(vx[i2][2], vx[i2][3]); *(LAS v2u*)(vdst + (kk >> 4) * 1024 + (kk & 15) * 64) = pk; }
        __builtin_amdgcn_sched_barrier(0);
        if (i + 1 < nsteps) ISSUE_V(i + 1);
        if (DEEP) { if (i + 2 < nsteps) ISSUE_K(u, i + 2); } else { if (i + 1 < nsteps) ISSUE_K(0, i + 1); }
        __builtin_amdgcn_sched_barrier(0);
        f32x16 c;
        if (FOX) {
            if (!isnew) {
#pragma unroll
                for (int g = 0; g < 4; ++g) { const f32x4 x = *(const GAS f32x4*)(bcs + 32 * s + 8 * g + 4 * hiv); c[4 * g] = x[0]; c[4 * g + 1] = x[1]; c[4 * g + 2] = x[2]; c[4 * g + 3] = x[3]; }
            } else {
#pragma unroll
                for (int r = 0; r < 16; ++r) c[r] = shl_from(nbias, crow(r, hiv));
            }
        } else {
            if (!isnew) {
#pragma unroll
                for (int r = 0; r < 16; ++r) c[r] = slope2 * (float)(32 * s + crow(r, hiv) - 2048);
            } else {
#pragma unroll
                for (int r = 0; r < 16; ++r) { const int j = crow(r, hiv), v2 = 2 * r32v - j; c[r] = slope2 * (float)(j < v2 ? j : v2); }
            }
        }
#pragma unroll
        for (int d0 = 0; d0 < 4; ++d0) c = __builtin_amdgcn_mfma_f32_32x32x16_bf16(kf[d0], qr[d0], c, 0, 0, 0);
        if (FOX && isnew) { const float ninf = neg_inf_s();
#pragma unroll
            for (int r = 0; r < 16; ++r) if (crow(r, hiv) > r32v) c[r] = ninf;
        }
        sm_pv<NDV, 2>(c, m, l, o, vbw, wsf, r32v, hiv);
      }
    }
#undef ISSUE_K
#undef ISSUE_V
#undef STEP_OF
    { auto rr = __builtin_amdgcn_permlane32_swap(__float_as_uint(l), __float_as_uint(l), false, false); l = __uint_as_float(rr[0]) + __uint_as_float(rr[1]); }
    LAS float* Op = (LAS float*)myreg;
#pragma unroll
    for (int d0 = 0; d0 < NDV; ++d0)
#pragma unroll
        for (int r = 0; r < 16; ++r) Op[crow(r, hi) * 64 + 32 * d0 + r32] = o[d0][r];
    LAS float* ML = (LAS float*)(lds + ATT_ML);
    if (hi == 0) { ML[w * 64 + r32] = m; ML[w * 64 + 32 + r32] = l; }
    ABAR_L();
    const int q = tid >> 4, seg = tid & 15;
    const int g2 = FOX ? 0 : (seg >> 3), d = FOX ? seg * 4 : (seg & 7) * 8;
    float mw[NSP], M = -1e30f;
#pragma unroll
    for (int ww = 0; ww < NSP; ++ww) { mw[ww] = ML[(g2 * NSP + ww) * 64 + q]; M = fmaxf(M, mw[ww]); }
    float L = 0.f, acc[DPT];
#pragma unroll
    for (int k = 0; k < DPT; ++k) acc[k] = 0.f;
#pragma unroll
    for (int ww = 0; ww < NSP; ++ww) { const float sc = __builtin_amdgcn_exp2f(mw[ww] - M); L += sc * ML[(g2 * NSP + ww) * 64 + 32 + q];
        LAS const float* src = (LAS const float*)(lds + (g2 * NSP + ww) * 16384) + q * 64 + d;
#pragma unroll
        for (int k = 0; k < DPT; ++k) acc[k] += sc * src[k]; }
    const float rl = 1.0f / L;
#pragma unroll
    for (int k = 0; k < DPT; ++k) res[k] = acc[k] * rl;
    ABAR_L();
}
}

namespace attx {
using att::bf16x8; using att::s16x4; using att::f32x16; using att::u32x4; using att::lds_cptr; using att::crow; using att::glds16; using att::vtr; using att::PITCH;
constexpr int NSLOT = 3, SLOTB = 8192;
constexpr int LDS_K = 0, LDS_V = NSLOT * SLOTB, LDS_WS = LDS_V + NSLOT * 2 * SLOTB, LDS_OST = LDS_WS + 8 * 64 * 4, LDS_CB = LDS_OST + 8 * 4096, LDS_NEG = LDS_CB + 2048 * 4, LDS_END = LDS_NEG + 64 * 4;
static_assert(LDS_END <= RING_BYTES, "attention LDS map");
#define XSBAR() __builtin_amdgcn_sched_barrier(0)
#define XWAIT_BAR(N) asm volatile("s_waitcnt vmcnt(" #N ") lgkmcnt(0)\n\ts_barrier" ::: "memory")
__device__ __forceinline__ unsigned cvtpk_s(float lo, float hi) { return pk2(lo, hi); }

template <int MODE>
__device__ __forceinline__ void attn_pass(const GAS bf16* Qw, const GAS bf16* Kh, const GAS bf16* Vh, int qb, int wid, int lane, LAS char* shm, float slope2, f32x16 (&o)[2]) {
    const int r32 = lane & 31, hi = lane >> 5;
    const unsigned lds0 = (unsigned)(uintptr_t)shm;
    LAS float* wsf = (LAS float*)(shm + LDS_WS) + wid * 64;
    LAS const float* cb = (LAS const float*)(shm + LDS_CB);
    LAS const float* negblk = (LAS const float*)(shm + LDS_NEG);
    const GAS bf16* ksrc = Kh + (size_t)lane * PITCH + wid * 8;
    const GAS bf16* vsrc = Vh + (size_t)(16 * (wid & 3) + (lane >> 2)) * PITCH + (wid >> 2) * 32 + (lane & 3) * 8;
    const unsigned kdst = lds0 + LDS_K + wid * 1024, vdst = lds0 + LDS_V + wid * 1024;
#define DMA_K(t, slot) glds16(ksrc + (size_t)(t) * 64 * PITCH, (unsigned)__builtin_amdgcn_readfirstlane(kdst + (slot)))
#define DMA_V(t, slot) glds16(vsrc + (size_t)(t) * 64 * PITCH, (unsigned)__builtin_amdgcn_readfirstlane(vdst + 2 * (slot)))
    const lds_cptr shm3 = (lds_cptr)shm; const lds_cptr kp0 = shm3 + LDS_K + hi * 1024 + r32 * 16;
    const lds_cptr vp0 = shm3 + LDS_V + ((lane >> 4) & 1) * 32 + (lane & 3) * 8 + (4 * hi + ((lane & 15) >> 2)) * 64;
    bf16x8 kf[8];
    const int NT = 4 * qb + 4;
    const int tdiag = NT - 4 + (wid >> 1);
    asm volatile("s_waitcnt vmcnt(0)" ::: "memory");
    DMA_K(0, 0); DMA_V(0, 0); DMA_K(1, SLOTB);
    bf16x8 qr[4];
#pragma unroll
    for (int d0 = 0; d0 < 4; ++d0) qr[d0] = *(const GAS bf16x8*)(Qw + (size_t)r32 * PITCH + d0 * 16 + hi * 8);
    float l_reg = 0.f; o[0] = f32x16{}; o[1] = f32x16{};
    const int qrel = wid * 32 + r32;
#define CBPTR(t) (((t) > tdiag) ? negblk : cb + 64 * (t))
#define CBLOAD(P0, P1, ptr) do { LAS const float* p_ = (ptr); _Pragma("unroll") for (int g = 0; g < 4; ++g) { const f32x4 x_ = *(LAS const f32x4*)(p_ + 8 * g + 4 * hi), y_ = *(LAS const f32x4*)(p_ + 32 + 8 * g + 4 * hi); \
        P0[4 * g] = x_[0]; P0[4 * g + 1] = x_[1]; P0[4 * g + 2] = x_[2]; P0[4 * g + 3] = x_[3]; P1[4 * g] = y_[0]; P1[4 * g + 1] = y_[1]; P1[4 * g + 2] = y_[2]; P1[4 * g + 3] = y_[3]; } } while (0)
#define DIAGFIX(C0, C1, t) do { if ((t) == tdiag) { const int kb_ = 64 * (wid >> 1) + 4 * hi; \
        if (MODE == 0) { const float ninf_ = att::neg_inf_s(); _Pragma("unroll") for (int r = 0; r < 16; ++r) { const int kv = kb_ + (r & 3) + 8 * (r >> 2); if (kv > qrel) C0[r] = ninf_; if (kv + 32 > qrel) C1[r] = ninf_; } } \
        else { const float m2_ = -2.0f * slope2; float bf_ = (float)(kb_ - qrel); asm volatile("" : "+v"(bf_)); \
            _Pragma("unroll") for (int r = 0; r < 16; ++r) { const float c_ = (float)((r & 3) + 8 * (r >> 2)); \
                C0[r] = __builtin_fmaf(__builtin_fmaxf(bf_ + c_, 0.f), m2_, C0[r]); C1[r] = __builtin_fmaf(__builtin_fmaxf(bf_ + (c_ + 32.f), 0.f), m2_, C1[r]); asm volatile("" : "+v"(C0), "+v"(C1)); } } } } while (0)
    f32x16 pA0, pA1, pB0, pB1;
    int sl_prev = 0, sl_cur = 0, sl_next = SLOTB;
#define ROT() do { sl_prev = sl_cur; sl_cur = sl_next; sl_next = (sl_next == (NSLOT - 1) * SLOTB) ? 0 : sl_next + SLOTB; } while (0)
    DMA_K(2, 2 * SLOTB);
    CBLOAD(pA0, pA1, CBPTR(0)); CBLOAD(pB0, pB1, CBPTR(1));
    XWAIT_BAR(3);
    {
        const lds_cptr kb = kp0;
#pragma unroll
        for (int d0 = 0; d0 < 4; ++d0) { const bf16x8 b0 = *(LAS const bf16x8*)(kb + d0 * 2048), b1 = *(LAS const bf16x8*)(kb + d0 * 2048 + 512);
            pA0 = __builtin_amdgcn_mfma_f32_32x32x16_bf16(b0, qr[d0], pA0, 0, 0, 0); pA1 = __builtin_amdgcn_mfma_f32_32x32x16_bf16(b1, qr[d0], pA1, 0, 0, 0); }
    }
    DIAGFIX(pA0, pA1, 0);
#pragma unroll
    for (int r = 0; r < 16; ++r) { pA0[r] = __builtin_amdgcn_exp2f(pA0[r]); pA1[r] = __builtin_amdgcn_exp2f(pA1[r]); }
    XWAIT_BAR(0);
    DMA_K(3, 0); DMA_V(1, SLOTB);
    ROT();
#define KLOAD2(j, kp) do { kf[2 * (j)] = *(LAS const bf16x8*)((kp) + (j) * 2048); kf[2 * (j) + 1] = *(LAS const bf16x8*)((kp) + (j) * 2048 + 512); } while (0)
    { const lds_cptr kp = kp0 + sl_cur; KLOAD2(0, kp); KLOAD2(1, kp); KLOAD2(2, kp); KLOAD2(3, kp); }
    XWAIT_BAR(2);
    s16x4 vlo[8], vhi[8]; u32x4 pw0, pw1, pw2, pw3;
#define PKW(P, B) cvtpk_s(P[B], P[B + 1])
#define PAF(k) __builtin_bit_cast(bf16x8, pw##k)
#define VFR(i) (bf16x8){vlo[i][0], vlo[i][1], vlo[i][2], vlo[i][3], vhi[i][0], vhi[i][1], vhi[i][2], vhi[i][3]}
#define PIN(x) asm volatile("" : "+v"(x))
#define GAPA(MF, A0, A1, A2, A3, W0, W1, PW) do { MF; sacc += A0; sacc += A1; sacc += A2; sacc += A3; PIN(sacc); W0; W1; PIN(PW); XSBAR(); } while (0)
#define EX(v) __builtin_amdgcn_exp2f(v)
#define GAPB(MF, X, B) do { MF; X[B] = EX(X[B]); X[B + 1] = EX(X[B + 1]); X[B + 2] = EX(X[B + 2]); X[B + 3] = EX(X[B + 3]); PIN(X); XSBAR(); } while (0)
#define VRD(i) do { vlo[i] = vtr(vp_ + (((i) >> 2) * 4096 + ((i) & 3) * 1024)); vhi[i] = vtr(vp_ + (((i) >> 2) * 4096 + ((i) & 3) * 1024 + 512)); } while (0)
#define KRD(G, j) do { if (G) { KLOAD2(j, kp0 + sl_next); XSBAR(); } } while (0)
#define CRD(GC, P, g, off) do { if (GC) { const f32x4 x_ = *(LAS const f32x4*)(cbn_ + (off) + 8 * (g) + 4 * hi); P[4 * (g)] = x_[0]; P[4 * (g) + 1] = x_[1]; P[4 * (g) + 2] = x_[2]; P[4 * (g) + 3] = x_[3]; XSBAR(); } } while (0)
#define STEP(C0, C1, P0, P1, t, GK, GV, GL, GC) do { XSBAR(); \
    const lds_cptr vp_ = vp0 + 2 * sl_prev; LAS const float* cbn_ = CBPTR((t) + 1); \
    VRD(0); XSBAR(); float sacc = (P0[0] + P0[1]); \
    GAPA(C0 = __builtin_amdgcn_mfma_f32_32x32x16_bf16(kf[0], qr[0], C0, 0, 0, 0), P0[2], P0[3], P0[4], P0[5],     pw0[0] = PKW(P0, 0), pw0[1] = PKW(P0, 2), pw0); \
    VRD(4); XSBAR(); GAPA(C1 = __builtin_amdgcn_mfma_f32_32x32x16_bf16(kf[1], qr[0], C1, 0, 0, 0), P0[6], P0[7], P0[8], P0[9],     pw0[2] = PKW(P0, 4), pw0[3] = PKW(P0, 6), pw0); \
    VRD(1); XSBAR(); GAPA(C0 = __builtin_amdgcn_mfma_f32_32x32x16_bf16(kf[2], qr[1], C0, 0, 0, 0), P0[10], P0[11], P0[12], P0[13], pw1[0] = PKW(P0, 8), pw1[1] = PKW(P0, 10), pw1); \
    VRD(5); XSBAR(); GAPA(C1 = __builtin_amdgcn_mfma_f32_32x32x16_bf16(kf[3], qr[1], C1, 0, 0, 0), P0[14], P0[15], P1[0], P1[1],   pw1[2] = PKW(P0, 12), pw1[3] = PKW(P0, 14), pw1); \
    VRD(2); XSBAR(); GAPA(C0 = __builtin_amdgcn_mfma_f32_32x32x16_bf16(kf[4], qr[2], C0, 0, 0, 0), P1[2], P1[3], P1[4], P1[5],     pw2[0] = PKW(P1, 0), pw2[1] = PKW(P1, 2), pw2); \
    VRD(6); XSBAR(); GAPA(C1 = __builtin_amdgcn_mfma_f32_32x32x16_bf16(kf[5], qr[2], C1, 0, 0, 0), P1[6], P1[7], P1[8], P1[9],     pw2[2] = PKW(P1, 4), pw2[3] = PKW(P1, 6), pw2); \
    VRD(3); XSBAR(); GAPA(C0 = __builtin_amdgcn_mfma_f32_32x32x16_bf16(kf[6], qr[3], C0, 0, 0, 0), P1[10], P1[11], P1[12], P1[13], pw3[0] = PKW(P1, 8), pw3[1] = PKW(P1, 10), pw3); \
    VRD(7); XSBAR(); GAPA(C1 = __builtin_amdgcn_mfma_f32_32x32x16_bf16(kf[7], qr[3], C1, 0, 0, 0), P1[14], P1[15], 0.f, 0.f,       pw3[2] = PKW(P1, 12), pw3[3] = PKW(P1, 14), pw3); \
    l_reg += sacc; \
    if (GK) { DMA_K((t) + 3, sl_cur); } if (GV) { DMA_V((t) + 1, sl_next); } \
    DFX(C0, C1, t); \
    XSBAR(); \
    CRD(GC, P0, 0, 0);  GAPB(o[0] = __builtin_amdgcn_mfma_f32_32x32x16_bf16(PAF(0), VFR(0), o[0], 0, 0, 0), C0, 0); \
    CRD(GC, P0, 1, 0);  GAPB(o[1] = __builtin_amdgcn_mfma_f32_32x32x16_bf16(PAF(0), VFR(4), o[1], 0, 0, 0), C0, 4); \
    CRD(GC, P0, 2, 0);  KRD(GL, 0); GAPB(o[0] = __builtin_amdgcn_mfma_f32_32x32x16_bf16(PAF(1), VFR(1), o[0], 0, 0, 0), C0, 8); \
    CRD(GC, P0, 3, 0);  KRD(GL, 1); GAPB(o[1] = __builtin_amdgcn_mfma_f32_32x32x16_bf16(PAF(1), VFR(5), o[1], 0, 0, 0), C0, 12); \
    CRD(GC, P1, 0, 32); KRD(GL, 2); GAPB(o[0] = __builtin_amdgcn_mfma_f32_32x32x16_bf16(PAF(2), VFR(2), o[0], 0, 0, 0), C1, 0); \
    CRD(GC, P1, 1, 32); KRD(GL, 3); GAPB(o[1] = __builtin_amdgcn_mfma_f32_32x32x16_bf16(PAF(2), VFR(6), o[1], 0, 0, 0), C1, 4); \
    CRD(GC, P1, 2, 32); GAPB(o[0] = __builtin_amdgcn_mfma_f32_32x32x16_bf16(PAF(3), VFR(3), o[0], 0, 0, 0), C1, 8); \
    CRD(GC, P1, 3, 32); GAPB(o[1] = __builtin_amdgcn_mfma_f32_32x32x16_bf16(PAF(3), VFR(7), o[1], 0, 0, 0), C1, 12); \
    } while (0)
    int t = 1;
#define DFX(C0, C1, t) do {} while (0)
    for (; t + 5 < NT; t += 2) {
        STEP(pB0, pB1, pA0, pA1, t, true, true, true, true);     XWAIT_BAR(2); ROT();
        STEP(pA0, pA1, pB0, pB1, t + 1, true, true, true, true); XWAIT_BAR(2); ROT();
    }
#undef DFX
#define DFX(C0, C1, t) DIAGFIX(C0, C1, t)
#define ENDW(tt) do { if ((tt) + 3 < NT) { XWAIT_BAR(2); } else if ((tt) + 2 < NT) { XWAIT_BAR(1); } else { XWAIT_BAR(0); } } while (0)
    for (; t + 1 < NT; t += 2) {
        STEP(pB0, pB1, pA0, pA1, t, (t + 3 < NT), (t + 1 < NT), (t + 1 < NT), (t + 1 < NT));         ENDW(t);     ROT();
        STEP(pA0, pA1, pB0, pB1, t + 1, (t + 4 < NT), (t + 2 < NT), (t + 2 < NT), (t + 2 < NT));     ENDW(t + 1); ROT();
    }
    STEP(pB0, pB1, pA0, pA1, NT - 1, false, false, false, false);
    { float sacc = pB0[0] + pB0[1];
#pragma unroll
      for (int r = 2; r < 16; ++r) sacc += pB0[r];
#pragma unroll
      for (int r = 0; r < 16; ++r) sacc += pB1[r];
      l_reg += sacc;
      pw0 = (u32x4){PKW(pB0, 0), PKW(pB0, 2), PKW(pB0, 4), PKW(pB0, 6)}; pw1 = (u32x4){PKW(pB0, 8), PKW(pB0, 10), PKW(pB0, 12), PKW(pB0, 14)};
      pw2 = (u32x4){PKW(pB1, 0), PKW(pB1, 2), PKW(pB1, 4), PKW(pB1, 6)}; pw3 = (u32x4){PKW(pB1, 8), PKW(pB1, 10), PKW(pB1, 12), PKW(pB1, 14)};
      XSBAR();
      const lds_cptr vp_ = vp0 + 2 * sl_cur;
#pragma unroll
      for (int d0 = 0; d0 < 2; ++d0) { s16x4 lo[4], hh[4];
#pragma unroll
          for (int ks = 0; ks < 4; ++ks) { lo[ks] = vtr(vp_ + d0 * 4096 + ks * 1024); hh[ks] = vtr(vp_ + d0 * 4096 + ks * 1024 + 512); }
#define PK_(k) (bf16x8){lo[k][0], lo[k][1], lo[k][2], lo[k][3], hh[k][0], hh[k][1], hh[k][2], hh[k][3]}
          o[d0] = __builtin_amdgcn_mfma_f32_32x32x16_bf16(PAF(0), PK_(0), o[d0], 0, 0, 0);
          o[d0] = __builtin_amdgcn_mfma_f32_32x32x16_bf16(PAF(1), PK_(1), o[d0], 0, 0, 0);
          o[d0] = __builtin_amdgcn_mfma_f32_32x32x16_bf16(PAF(2), PK_(2), o[d0], 0, 0, 0);
          o[d0] = __builtin_amdgcn_mfma_f32_32x32x16_bf16(PAF(3), PK_(3), o[d0], 0, 0, 0);
#undef PK_
      } }
    { auto rr = __builtin_amdgcn_permlane32_swap(__float_as_uint(l_reg), __float_as_uint(l_reg), false, false); l_reg = __uint_as_float(rr[0]) + __uint_as_float(rr[1]); }
    if (hi == 0) wsf[32 + r32] = l_reg;
    LDS_WAIT();
#pragma unroll
    for (int r = 0; r < 16; ++r) { const float a = __builtin_amdgcn_rcpf(wsf[32 + crow(r, hi)]); o[0][r] *= a; o[1][r] *= a; }
    asm volatile("s_waitcnt lgkmcnt(0)\n\ts_barrier" ::: "memory");
#undef DMA_K
#undef DMA_V
#undef CBPTR
#undef CBLOAD
#undef DIAGFIX
#undef ROT
#undef KLOAD2
#undef PKW
#undef PAF
#undef VFR
#undef PIN
#undef GAPA
#undef EX
#undef GAPB
#undef VRD
#undef KRD
#undef CRD
#undef STEP
#undef ENDW
#undef DFX
}

template <int MODE>
__device__ __forceinline__ void attn_pass4(const GAS bf16* Qw, const GAS bf16* Kh, const GAS bf16* Vh, int qb, int wid, int lane, LAS char* shm, float slope2, f32x16 (&o)[4]) {
    const int r32 = lane & 31, hi = lane >> 5;
    const unsigned lds0 = (unsigned)(uintptr_t)shm;
    LAS float* wsf = (LAS float*)(shm + LDS_WS) + wid * 64;
    LAS const float* cb = (LAS const float*)(shm + LDS_CB);
    LAS const float* negblk = (LAS const float*)(shm + LDS_NEG);
    const GAS bf16* ksrc = Kh + (size_t)lane * PITCH + wid * 8;
    const GAS bf16* vsrc = Vh + (size_t)(16 * (wid & 3) + (lane >> 2)) * PITCH + (wid >> 2) * 32 + (lane & 3) * 8;
    const unsigned kdst = lds0 + LDS_K + wid * 1024, vdst = lds0 + LDS_V + wid * 1024;
#define DMA_K(t, slot) glds16(ksrc + (size_t)(t) * 64 * PITCH, (unsigned)__builtin_amdgcn_readfirstlane(kdst + (slot)))
#define DMA_V(t, slot) do { glds16(vsrc + (size_t)(t) * 64 * PITCH, (unsigned)__builtin_amdgcn_readfirstlane(vdst + 2 * (slot))); \
        glds16(vsrc + 64 + (size_t)(t) * 64 * PITCH, (unsigned)__builtin_amdgcn_readfirstlane(vdst + 2 * (slot) + 8192)); } while (0)
    const lds_cptr shm3 = (lds_cptr)shm; const lds_cptr kp0 = shm3 + LDS_K + hi * 1024 + r32 * 16;
    const lds_cptr vp0 = shm3 + LDS_V + ((lane >> 4) & 1) * 32 + (lane & 3) * 8 + (4 * hi + ((lane & 15) >> 2)) * 64;
    LAS char* qst = shm + LDS_OST + wid * 4096 + lane * 16;
    const int NT = 4 * qb + 4, tdiag = NT - 4 + (wid >> 1);
    asm volatile("s_waitcnt vmcnt(0)" ::: "memory");
    DMA_K(0, 0); DMA_V(0, 0); DMA_K(1, SLOTB);
#pragma unroll
    for (int d0 = 0; d0 < 4; ++d0) { const bf16x8 q = *(const GAS bf16x8*)(Qw + (size_t)r32 * PITCH + d0 * 16 + hi * 8); *(LAS bf16x8*)(qst + d0 * 1024) = q; }
    float l_reg = 0.f;
#pragma unroll
    for (int d0 = 0; d0 < 4; ++d0) o[d0] = f32x16{};
    const int qrel = wid * 32 + r32;
#define CBPTR(t) (((t) > tdiag) ? negblk : cb + 64 * (t))
#define CBLOAD(P0, P1, ptr) do { LAS const float* p_ = (ptr); _Pragma("unroll") for (int g = 0; g < 4; ++g) { const f32x4 x_ = *(LAS const f32x4*)(p_ + 8 * g + 4 * hi), y_ = *(LAS const f32x4*)(p_ + 32 + 8 * g + 4 * hi); \
        P0[4 * g] = x_[0]; P0[4 * g + 1] = x_[1]; P0[4 * g + 2] = x_[2]; P0[4 * g + 3] = x_[3]; P1[4 * g] = y_[0]; P1[4 * g + 1] = y_[1]; P1[4 * g + 2] = y_[2]; P1[4 * g + 3] = y_[3]; } } while (0)
#define DIAGFIX(C0, C1, t) do { if ((t) == tdiag) { const int kb_ = 64 * (wid >> 1) + 4 * hi; \
        if (MODE == 0) { const float ninf_ = att::neg_inf_s(); _Pragma("unroll") for (int r = 0; r < 16; ++r) { const int kv = kb_ + (r & 3) + 8 * (r >> 2); if (kv > qrel) C0[r] = ninf_; if (kv + 32 > qrel) C1[r] = ninf_; } } \
        else { const float m2_ = -2.0f * slope2; float bf_ = (float)(kb_ - qrel); asm volatile("" : "+v"(bf_)); \
            _Pragma("unroll") for (int r = 0; r < 16; ++r) { const float c_ = (float)((r & 3) + 8 * (r >> 2)); \
                C0[r] = __builtin_fmaf(__builtin_fmaxf(bf_ + c_, 0.f), m2_, C0[r]); C1[r] = __builtin_fmaf(__builtin_fmaxf(bf_ + (c_ + 32.f), 0.f), m2_, C1[r]); asm volatile("" : "+v"(C0), "+v"(C1)); } } } } while (0)
    f32x16 pA0, pA1, pB0, pB1;
    int sl_prev = 0, sl_cur = 0, sl_next = SLOTB;
#define ROT() do { sl_prev = sl_cur; sl_cur = sl_next; sl_next = (sl_next == (NSLOT - 1) * SLOTB) ? 0 : sl_next + SLOTB; } while (0)
    DMA_K(2, 2 * SLOTB);
    CBLOAD(pA0, pA1, CBPTR(0)); CBLOAD(pB0, pB1, CBPTR(1));
    XWAIT_BAR(4);
    {
#pragma unroll
        for (int d0 = 0; d0 < 4; ++d0) { const bf16x8 b0 = *(LAS const bf16x8*)(kp0 + d0 * 2048), b1 = *(LAS const bf16x8*)(kp0 + d0 * 2048 + 512); const bf16x8 q = *(LAS const bf16x8*)(qst + d0 * 1024);
            pA0 = __builtin_amdgcn_mfma_f32_32x32x16_bf16(b0, q, pA0, 0, 0, 0); pA1 = __builtin_amdgcn_mfma_f32_32x32x16_bf16(b1, q, pA1, 0, 0, 0); }
    }
    DIAGFIX(pA0, pA1, 0);
#pragma unroll
    for (int r = 0; r < 16; ++r) { pA0[r] = __builtin_amdgcn_exp2f(pA0[r]); pA1[r] = __builtin_amdgcn_exp2f(pA1[r]); }
    XWAIT_BAR(0);
    DMA_V(1, SLOTB);
    ROT();
    s16x4 vlo[8], vhi[8]; u32x4 pw0, pw1, pw2, pw3;
#define PKW(P, B) cvtpk_s(P[B], P[B + 1])
#define PAF(k) __builtin_bit_cast(bf16x8, pw##k)
#define VFR(i) (bf16x8){vlo[i][0], vlo[i][1], vlo[i][2], vlo[i][3], vhi[i][0], vhi[i][1], vhi[i][2], vhi[i][3]}
#define PIN(x) asm volatile("" : "+v"(x))
#define GAPA(MF, A0, A1, A2, A3, W0, W1, PW) do { MF; sacc += A0; sacc += A1; sacc += A2; sacc += A3; PIN(sacc); W0; W1; PIN(PW); XSBAR(); } while (0)
#define EX(v) __builtin_amdgcn_exp2f(v)
#define GAPB2(MF, X, B) do { MF; X[B] = EX(X[B]); X[B + 1] = EX(X[B + 1]); PIN(X); XSBAR(); } while (0)
#define VRD(i) do { vlo[i] = vtr(vp_ + (((i) >> 2) * 4096 + ((i) & 3) * 1024)); vhi[i] = vtr(vp_ + (((i) >> 2) * 4096 + ((i) & 3) * 1024 + 512)); } while (0)
#define VRD2(i) do { vlo[i] = vtr(vp_ + ((((i) >> 2) + 2) * 4096 + ((i) & 3) * 1024)); vhi[i] = vtr(vp_ + ((((i) >> 2) + 2) * 4096 + ((i) & 3) * 1024 + 512)); XSBAR(); } while (0)
#define KFR(i) (*(LAS const bf16x8*)(kpt_ + ((i) >> 1) * 2048 + ((i) & 1) * 512))
#define CRD(GC, P, g, off) do { if (GC) { const f32x4 x_ = *(LAS const f32x4*)(cbn_ + (off) + 8 * (g) + 4 * hi); P[4 * (g)] = x_[0]; P[4 * (g) + 1] = x_[1]; P[4 * (g) + 2] = x_[2]; P[4 * (g) + 3] = x_[3]; XSBAR(); } } while (0)
#define STEPJ(C0, C1, P0, P1, t, GK, GV, GC) do { XSBAR(); \
    const lds_cptr vp_ = vp0 + 2 * sl_prev; const lds_cptr kpt_ = kp0 + sl_cur; LAS const float* cbn_ = CBPTR((t) + 1); \
    const bf16x8 q0_ = *(LAS const bf16x8*)(qst), q1_ = *(LAS const bf16x8*)(qst + 1024), q2_ = *(LAS const bf16x8*)(qst + 2048), q3_ = *(LAS const bf16x8*)(qst + 3072); \
    bf16x8 ka_ = KFR(0), kb_ = KFR(1), kc_; \
    VRD(0); XSBAR(); float sacc = (P0[0] + P0[1]); \
    kc_ = KFR(2); GAPA(C0 = __builtin_amdgcn_mfma_f32_32x32x16_bf16(ka_, q0_, C0, 0, 0, 0), P0[2], P0[3], P0[4], P0[5],     pw0[0] = PKW(P0, 0), pw0[1] = PKW(P0, 2), pw0); \
    VRD(4); ka_ = KFR(3); XSBAR(); GAPA(C1 = __builtin_amdgcn_mfma_f32_32x32x16_bf16(kb_, q0_, C1, 0, 0, 0), P0[6], P0[7], P0[8], P0[9],     pw0[2] = PKW(P0, 4), pw0[3] = PKW(P0, 6), pw0); \
    VRD(1); kb_ = KFR(4); XSBAR(); GAPA(C0 = __builtin_amdgcn_mfma_f32_32x32x16_bf16(kc_, q1_, C0, 0, 0, 0), P0[10], P0[11], P0[12], P0[13], pw1[0] = PKW(P0, 8), pw1[1] = PKW(P0, 10), pw1); \
    VRD(5); kc_ = KFR(5); XSBAR(); GAPA(C1 = __builtin_amdgcn_mfma_f32_32x32x16_bf16(ka_, q1_, C1, 0, 0, 0), P0[14], P0[15], P1[0], P1[1],   pw1[2] = PKW(P0, 12), pw1[3] = PKW(P0, 14), pw1); \
    VRD(2); ka_ = KFR(6); XSBAR(); GAPA(C0 = __builtin_amdgcn_mfma_f32_32x32x16_bf16(kb_, q2_, C0, 0, 0, 0), P1[2], P1[3], P1[4], P1[5],     pw2[0] = PKW(P1, 0), pw2[1] = PKW(P1, 2), pw2); \
    VRD(6); kb_ = KFR(7); XSBAR(); GAPA(C1 = __builtin_amdgcn_mfma_f32_32x32x16_bf16(kc_, q2_, C1, 0, 0, 0), P1[6], P1[7], P1[8], P1[9],     pw2[2] = PKW(P1, 4), pw2[3] = PKW(P1, 6), pw2); \
    VRD(3); XSBAR(); GAPA(C0 = __builtin_amdgcn_mfma_f32_32x32x16_bf16(ka_, q3_, C0, 0, 0, 0), P1[10], P1[11], P1[12], P1[13], pw3[0] = PKW(P1, 8), pw3[1] = PKW(P1, 10), pw3); \
    VRD(7); XSBAR(); GAPA(C1 = __builtin_amdgcn_mfma_f32_32x32x16_bf16(kb_, q3_, C1, 0, 0, 0), P1[14], P1[15], 0.f, 0.f,       pw3[2] = PKW(P1, 12), pw3[3] = PKW(P1, 14), pw3); \
    l_reg += sacc; \
    asm volatile("s_waitcnt lgkmcnt(0)" ::: "memory");     \
    if (GK) { DMA_K((t) + 2, sl_prev); } if (GV) { DMA_V((t) + 1, sl_next); } \
    DFX(C0, C1, t); \
    XSBAR(); \
    GAPB2(o[0] = __builtin_amdgcn_mfma_f32_32x32x16_bf16(PAF(0), VFR(0), o[0], 0, 0, 0), C0, 0);  VRD2(0); \
    GAPB2(o[1] = __builtin_amdgcn_mfma_f32_32x32x16_bf16(PAF(0), VFR(4), o[1], 0, 0, 0), C0, 2);  VRD2(4); \
    GAPB2(o[0] = __builtin_amdgcn_mfma_f32_32x32x16_bf16(PAF(1), VFR(1), o[0], 0, 0, 0), C0, 4);  VRD2(1); \
    GAPB2(o[1] = __builtin_amdgcn_mfma_f32_32x32x16_bf16(PAF(1), VFR(5), o[1], 0, 0, 0), C0, 6);  VRD2(5); \
    GAPB2(o[0] = __builtin_amdgcn_mfma_f32_32x32x16_bf16(PAF(2), VFR(2), o[0], 0, 0, 0), C0, 8);  VRD2(2); \
    GAPB2(o[1] = __builtin_amdgcn_mfma_f32_32x32x16_bf16(PAF(2), VFR(6), o[1], 0, 0, 0), C0, 10); VRD2(6); \
    GAPB2(o[0] = __builtin_amdgcn_mfma_f32_32x32x16_bf16(PAF(3), VFR(3), o[0], 0, 0, 0), C0, 12); VRD2(3); \
    GAPB2(o[1] = __builtin_amdgcn_mfma_f32_32x32x16_bf16(PAF(3), VFR(7), o[1], 0, 0, 0), C0, 14); VRD2(7); \
    CRD(GC, P0, 0, 0);  GAPB2(o[2] = __builtin_amdgcn_mfma_f32_32x32x16_bf16(PAF(0), VFR(0), o[2], 0, 0, 0), C1, 0); \
    CRD(GC, P0, 1, 0);  GAPB2(o[3] = __builtin_amdgcn_mfma_f32_32x32x16_bf16(PAF(0), VFR(4), o[3], 0, 0, 0), C1, 2); \
    CRD(GC, P0, 2, 0);  GAPB2(o[2] = __builtin_amdgcn_mfma_f32_32x32x16_bf16(PAF(1), VFR(1), o[2], 0, 0, 0), C1, 4); \
    CRD(GC, P0, 3, 0);  GAPB2(o[3] = __builtin_amdgcn_mfma_f32_32x32x16_bf16(PAF(1), VFR(5), o[3], 0, 0, 0), C1, 6); \
    CRD(GC, P1, 0, 32); GAPB2(o[2] = __builtin_amdgcn_mfma_f32_32x32x16_bf16(PAF(2), VFR(2), o[2], 0, 0, 0), C1, 8); \
    CRD(GC, P1, 1, 32); GAPB2(o[3] = __builtin_amdgcn_mfma_f32_32x32x16_bf16(PAF(2), VFR(6), o[3], 0, 0, 0), C1, 10); \
    CRD(GC, P1, 2, 32); GAPB2(o[2] = __builtin_amdgcn_mfma_f32_32x32x16_bf16(PAF(3), VFR(3), o[2], 0, 0, 0), C1, 12); \
    CRD(GC, P1, 3, 32); GAPB2(o[3] = __builtin_amdgcn_mfma_f32_32x32x16_bf16(PAF(3), VFR(7), o[3], 0, 0, 0), C1, 14); \
    } while (0)
    int t = 1;
#define DFX(C0, C1, t) do {} while (0)
    for (; t + 5 < NT; t += 2) {
        STEPJ(pB0, pB1, pA0, pA1, t, true, true, true);     XWAIT_BAR(3); ROT();
        STEPJ(pA0, pA1, pB0, pB1, t + 1, true, true, true); XWAIT_BAR(3); ROT();
    }
#undef DFX
#define DFX(C0, C1, t) DIAGFIX(C0, C1, t)
#define ENDW(tt) do { if ((tt) + 2 < NT) { XWAIT_BAR(3); } else { XWAIT_BAR(0); } } while (0)
    for (; t + 1 < NT; t += 2) {
        STEPJ(pB0, pB1, pA0, pA1, t, (t + 2 < NT), (t + 1 < NT), (t + 1 < NT));         ENDW(t);     ROT();
        STEPJ(pA0, pA1, pB0, pB1, t + 1, (t + 3 < NT), (t + 2 < NT), (t + 2 < NT));     ENDW(t + 1); ROT();
    }
    STEPJ(pB0, pB1, pA0, pA1, NT - 1, false, false, false);
    { float sacc = pB0[0] + pB0[1];
#pragma unroll
      for (int r = 2; r < 16; ++r) sacc += pB0[r];
#pragma unroll
      for (int r = 0; r < 16; ++r) sacc += pB1[r];
      l_reg += sacc;
      pw0 = (u32x4){PKW(pB0, 0), PKW(pB0, 2), PKW(pB0, 4), PKW(pB0, 6)}; pw1 = (u32x4){PKW(pB0, 8), PKW(pB0, 10), PKW(pB0, 12), PKW(pB0, 14)};
      pw2 = (u32x4){PKW(pB1, 0), PKW(pB1, 2), PKW(pB1, 4), PKW(pB1, 6)}; pw3 = (u32x4){PKW(pB1, 8), PKW(pB1, 10), PKW(pB1, 12), PKW(pB1, 14)};
      XSBAR();
      const lds_cptr vp_ = vp0 + 2 * sl_cur;
#pragma unroll
      for (int d0 = 0; d0 < 4; ++d0) { s16x4 lo[4], hh[4];
#pragma unroll
          for (int ks = 0; ks < 4; ++ks) { lo[ks] = vtr(vp_ + d0 * 4096 + ks * 1024); hh[ks] = vtr(vp_ + d0 * 4096 + ks * 1024 + 512); }
#define PK_(k) (bf16x8){lo[k][0], lo[k][1], lo[k][2], lo[k][3], hh[k][0], hh[k][1], hh[k][2], hh[k][3]}
          o[d0] = __builtin_amdgcn_mfma_f32_32x32x16_bf16(PAF(0), PK_(0), o[d0], 0, 0, 0);
          o[d0] = __builtin_amdgcn_mfma_f32_32x32x16_bf16(PAF(1), PK_(1), o[d0], 0, 0, 0);
          o[d0] = __builtin_amdgcn_mfma_f32_32x32x16_bf16(PAF(2), PK_(2), o[d0], 0, 0, 0);
          o[d0] = __builtin_amdgcn_mfma_f32_32x32x16_bf16(PAF(3), PK_(3), o[d0], 0, 0, 0);
#undef PK_
      } }
    { auto rr = __builtin_amdgcn_permlane32_swap(__float_as_uint(l_reg), __float_as_uint(l_reg), false, false); l_reg = __uint_as_float(rr[0]) + __uint_as_float(rr[1]); }
    if (hi == 0) wsf[32 + r32] = l_reg;
    LDS_WAIT();
#pragma unroll
    for (int r = 0; r < 16; ++r) { const float a = __builtin_amdgcn_rcpf(wsf[32 + crow(r, hi)]);
#pragma unroll
        for (int d0 = 0; d0 < 4; ++d0) o[d0][r] *= a; }
    asm volatile("s_waitcnt lgkmcnt(0)\n\ts_barrier" ::: "memory");
#undef DMA_K
#undef DMA_V
#undef CBPTR
#undef CBLOAD
#undef DIAGFIX
#undef ROT
#undef PKW
#undef PAF
#undef VFR
#undef PIN
#undef GAPA
#undef EX
#undef GAPB2
#undef VRD
#undef VRD2
#undef KFR
#undef CRD
#undef STEPJ
#undef ENDW
#undef DFX
}
__device__ __forceinline__ void store_o64(const f32x16 (&o)[2], GAS bf16* Ow, int wid, int lane, LAS char* shm, bool wt) {
    const int r32 = lane & 31, hi = lane >> 5;
    LAS bf16* stg = (LAS bf16*)(shm + LDS_OST) + wid * 2048;
#pragma unroll
    for (int r = 0; r < 16; ++r) { const int orow = crow(r, hi);
#pragma unroll
        for (int d0 = 0; d0 < 2; ++d0) stg[orow * 64 + d0 * 32 + r32] = (bf16)(pk2(o[d0][r], 0.f) & 0xffffu); }
    LDS_WAIT();
#pragma unroll
    for (int i = 0; i < 4; ++i) { const int row = i * 8 + (lane >> 3), ch = lane & 7; const v4u v = *(LAS const v4u*)(stg + row * 64 + ch * 8); if (wt) st16_sc1_v(Ow + (size_t)row * 1024 + ch * 8, v); else asm volatile("global_store_dwordx4 %0, %1, off\n\ts_nop 1" :: "v"(Ow + (size_t)row * 1024 + ch * 8), "v"(v) : "memory"); }
    LDS_WAIT();
}
__device__ __forceinline__ void build_cb_fox(const GAS float* lf, int n, LAS char* shm, int tid, int lane, int w) {
    LAS float* cb = (LAS float*)(shm + LDS_CB); LAS float* tmp = (LAS float*)(shm + ATT_TMP);
    float a[4];
#pragma unroll
    for (int k = 0; k < 4; ++k) { const int s = 4 * tid + k; a[k] = s < n ? lf[(size_t)s * 8] : 0.f; }
    a[1] += a[0]; a[2] += a[1]; a[3] += a[2];
    const float tot = a[3]; float v = tot;
#pragma unroll
    for (int o = 1; o < 64; o <<= 1) { const float t = shl_from(v, lane >= o ? lane - o : lane); if (lane >= o) v += t; }
    if (lane == 63) tmp[w] = v;
    if (tid < 64) ((LAS float*)(shm + LDS_NEG))[tid] = -INFINITY;
    ABAR_L();
    float base = 0.f;
    for (int ww = 0; ww < w; ++ww) base += tmp[ww];
    const float excl = base + v - tot;
#pragma unroll
    for (int k = 0; k < 4; ++k) a[k] += excl;
    if (4 * tid + 3 == n - 1) tmp[8] = a[3];
    if (4 * tid == n - 256) tmp[9] = a[0];
    ABAR_L();
    const float R = 0.5f * (tmp[8] + tmp[9]);
    f32x4 cv; cv[0] = (R - a[0]) * LOG2E; cv[1] = (R - a[1]) * LOG2E; cv[2] = (R - a[2]) * LOG2E; cv[3] = (R - a[3]) * LOG2E;
    *(LAS f32x4*)(cb + 4 * tid) = cv;
    ABAR_L();
}
__device__ __forceinline__ void build_cb_alibi(float slope2, int n, LAS char* shm, int tid) {
    LAS float* cb = (LAS float*)(shm + LDS_CB);
    f32x4 cv;
#pragma unroll
    for (int k = 0; k < 4; ++k) cv[k] = slope2 * (float)(4 * tid + k - (n - 128));
    *(LAS f32x4*)(cb + 4 * tid) = cv;
    if (tid < 64) ((LAS float*)(shm + LDS_NEG))[tid] = -INFINITY;
    ABAR_L();
}
#undef XSBAR
#undef XWAIT_BAR
}

__device__ __forceinline__ float wave_sum(float v, int lane) {
#pragma unroll
    for (int o = 1; o < 64; o <<= 1) v += shx(v, o, lane);
    return v;
}
__device__ __forceinline__ int src_col(int map, int n) {
    if (map == 0) return n;
    if (map == 1) { const int tile = n >> 8, i = n & 255; return i < 128 ? 128 * tile + i : DFF + 128 * tile + (i - 128); }
    if (n < 1536) return n;
    if (n < 3072) return n + 8;
    if (n < 3080) return 1536 + (n - 3072);
    return -1;
}
__device__ __forceinline__ void p0_transpose_item(const GAS float* W, int K, int Nsrc, GAS bf16* WT, const GAS float* gain, int map, int nblk, LAS float* scr, int item, int lane) {
    const int kb = item / nblk, nb = item % nblk, k0 = 64 * kb, n0 = 64 * nb;
    const int nl = 4 * (lane & 15), sc = src_col(map, n0 + nl);
    f32x4 v[16];
#pragma unroll
    for (int i = 0; i < 16; ++i) { const int kk = 4 * i + (lane >> 4); v[i] = (f32x4){0.f, 0.f, 0.f, 0.f}; if (sc >= 0) v[i] = *(const GAS f32x4*)(W + (size_t)(k0 + kk) * Nsrc + sc); }
#pragma unroll
    for (int i = 0; i < 16; ++i) { const int kk = 4 * i + (lane >> 4); f32x4 w = v[i];
        if (gain) { const float g = gain[k0 + kk]; w = w * g; }
        LAS float* d = scr + kk * 65 + nl; d[0] = w.x; d[1] = w.y; d[2] = w.z; d[3] = w.w; }
    LDS_WAIT(); asm volatile("" ::: "memory");
    const int c = lane & 7;
#pragma unroll
    for (int j = 0; j < 8; ++j) { const int n = (lane >> 3) + 8 * j; const LAS float* s = scr + (8 * c) * 65 + n;
        v4u o; o.x = pk2(s[0 * 65], s[1 * 65]); o.y = pk2(s[2 * 65], s[3 * 65]); o.z = pk2(s[4 * 65], s[5 * 65]); o.w = pk2(s[6 * 65], s[7 * 65]);
        *(GAS v4u*)(WT + (size_t)(n0 + n) * K + k0 + 8 * c) = o; }
    LDS_WAIT(); asm volatile("" ::: "memory");
}

#define XB_TMO      128
#define XB_XCNT(j)  (256  + 64 * (j))
#define XB_XSUB(j)  (1280 + 64 * (j))
#define XB_XGEN(j)  (2304 + 64 * (j))
#define XB_TOP      3328
#define XB_TOPGEN   3392
#define XCD_BAR_WORDS 3456
#define XB_SPIN_CAP (1u << 18)

__device__ __forceinline__ unsigned xb_ld(unsigned* p)              { return __hip_atomic_load(p, __ATOMIC_RELAXED, __HIP_MEMORY_SCOPE_AGENT); }
__device__ __forceinline__ unsigned xb_add(unsigned* p, unsigned v) { return __hip_atomic_fetch_add(p, v, __ATOMIC_RELAXED, __HIP_MEMORY_SCOPE_AGENT); }
__device__ __forceinline__ unsigned xb_xcc_id() { return (unsigned)__builtin_amdgcn_s_getreg((3 << 11) | 20) & 0xFu; }
#define XB_SPIN(cond, bar) do { unsigned _sp = 0; while (cond) { __builtin_amdgcn_s_sleep(1); \
    if ((++_sp & 255u) == 0u) { if (xb_ld(&(bar)[XB_TMO])) break; if (_sp > XB_SPIN_CAP) { atomicAdd(&(bar)[XB_TMO], 1u); break; } } } } while (0)

struct XcdBarrier {
    unsigned* bar; unsigned x;
    volatile LAS unsigned* st;
};

__device__ __forceinline__ XcdBarrier xcd_barrier_post(unsigned* bar, volatile LAS unsigned* st) {
    XcdBarrier b; b.bar = bar; b.x = xb_xcc_id(); b.st = st;
    if (threadIdx.x == 0) (void)xb_add(&bar[XB_XCNT(b.x)], 1u);
    return b;
}
__device__ __forceinline__ void xcd_barrier_complete(unsigned* bar, unsigned x, unsigned& nloc, unsigned& nx) {
    const unsigned G = gridDim.x * gridDim.y * gridDim.z;
    unsigned sum, cnt, mine, sp = 0u;
    for (;;) {
        sum = 0u; cnt = 0u; mine = 0u;
#pragma unroll
        for (unsigned j = 0; j < 16; ++j) { const unsigned c = xb_ld(&bar[XB_XCNT(j)]); sum += c; cnt += (c > 0u) ? 1u : 0u; mine = (j == x) ? c : mine; }
        if (sum == G) break;
        __builtin_amdgcn_s_sleep(1);
        if ((++sp & 255u) == 0u) { if (xb_ld(&bar[XB_TMO])) break; if (sp > XB_SPIN_CAP) { atomicAdd(&bar[XB_TMO], 1u); break; } }
    }
    nloc = mine > 0u ? mine : 1u; nx = cnt > 0u ? cnt : 1u;
}

__device__ __forceinline__ void xcd_barrier(const XcdBarrier& b) {
    asm volatile("s_waitcnt vmcnt(0)" ::: "memory");
    __syncthreads();
    if (threadIdx.x == 0) {
        unsigned* bar = b.bar;
        __builtin_amdgcn_s_waitcnt(0);
        unsigned nloc = b.st[0], nx = b.st[1];
        if (nloc == 0u) { xcd_barrier_complete(bar, b.x, nloc, nx); b.st[0] = nloc; b.st[1] = nx; }
        const unsigned old = xb_add(&bar[XB_XSUB(b.x)], 1u);
        const unsigned gen = old / nloc;
        if (old + 1u == (gen + 1u) * nloc) {
            __builtin_amdgcn_fence(__ATOMIC_RELEASE, "agent");
            asm volatile("s_waitcnt vmcnt(0)" ::: "memory");
            const unsigned og = xb_add(&bar[XB_TOP], 1u);
            const unsigned tg = og / nx;
            if (og + 1u == (tg + 1u) * nx) xb_add(&bar[XB_TOPGEN], 1u);
            else XB_SPIN(xb_ld(&bar[XB_TOPGEN]) == tg, bar);
            __builtin_amdgcn_fence(__ATOMIC_ACQUIRE, "agent");
            xb_add(&bar[XB_XGEN(b.x)], 1u);
            asm volatile("s_waitcnt vmcnt(0)" ::: "memory");
        } else {
            XB_SPIN(xb_ld(&bar[XB_XGEN(b.x)]) == gen, bar);
            __builtin_amdgcn_fence(__ATOMIC_ACQUIRE, "agent");
            asm volatile("s_waitcnt vmcnt(0)" ::: "memory");
        }
    }
    __syncthreads();
}

constexpr int CW_FAIL = 64, CW_XMASK = 128, CW_QH = 8192, CW_QH2 = 8704, CW_DEP = 16384;
enum { DK_H1 = 0, DK_X1 = 1, DK_QKV = 2, DK_O = 3, DK_X2 = 4, DK_H2 = 5, DK_Y = 6 };
static_assert(CW_DEP + 7 * 68 * 64 <= CW_SS1, "control words");
constexpr int NSEG = 18, NSTREAM = 12;
__device__ const int SEG_PH[NSEG]   = {1, 1, 2, 1, 3, 2, 9, 3, 4, 5, 4, 6, 5, 7, 6, 8, 7, 8};
__device__ const int SEG_KIND[NSEG] = {0, 1, 0, 1, 0, 1, 0, 1, 1, 0, 1, 0, 1, 0, 1, 0, 1, 1};
__device__ const int SEG_JJ0[NSEG]  = {0, 0, 0, 88, 0, 0, 0, 0, 0, 0, 48, 0, 0, 0, 0, 0, 0, 0};
__device__ const int SEG_CNT[NSEG]  = {11, 88, 2, 88, 6, 32, NSTREAM, 104, 48, 2, 48, 11, 32, 2, 176, 2, 32, 32};
__device__ __forceinline__ int q_cnt(int n, int x) { return n / 8 + (x < n % 8 ? 1 : 0); }
__device__ __forceinline__ int q_start(int n, int x) { const int q = n / 8, r = n % 8; return x < r ? x * (q + 1) : r * (q + 1) + (x - r) * q; }
__device__ __forceinline__ int tid_now(int wave) { int x; asm volatile("v_mbcnt_lo_u32_b32 %0, -1, 0\n\tv_mbcnt_hi_u32_b32 %0, -1, %0" : "=v"(x)); return x + wave * 64; }
__device__ __forceinline__ int opq(int k) { asm volatile("" : "+s"(k)); return k; }
#define INP(k) ((const GAS float*)args.in[opq(k)])
struct Args { const float* in[23]; float* out; unsigned char* ws; int ph_lo, ph_hi; };

__device__ __forceinline__ void unit_wait(gu32* depw, int p0, int np, unsigned need, gu32* fail, int tid, LAS unsigned* dbgslot = nullptr) {
    if (tid < 64) {
#ifdef DBG_WAITACC
        const unsigned tw0_ = (unsigned)__builtin_amdgcn_s_memrealtime();
#endif
        unsigned spins = 0;
        for (;;) {
            const unsigned v = tid < np ? __hip_atomic_load(depw + 64 * (p0 + tid), RLX_AGENT) : need;
            if (__all(v >= need)) break;
            __builtin_amdgcn_s_sleep(2);
            if ((++spins & 1023u) == 0u) { if (__builtin_amdgcn_readfirstlane(__hip_atomic_load(fail, RLX_AGENT)) != 0u) break;
                if (spins > (1u << 16)) { if (tid == 0) __hip_atomic_store(fail, 1u, RLX_AGENT); break; } }
        }
        __builtin_amdgcn_fence(__ATOMIC_ACQUIRE, "agent");
        VM_WAIT();
#ifdef DBG_WAITACC
        if (tid == 0) dbgslot[0] += (unsigned)__builtin_amdgcn_s_memrealtime() - tw0_;
#endif
    }
    __syncthreads();
}
__device__ __forceinline__ void unit_publish(gu32* w, int tid) {
    VM_WAIT(); __syncthreads();
    if (tid == 0) __hip_atomic_fetch_add(w, 1u, RLX_AGENT);
}

__global__ void __launch_bounds__(NWAVES * 64, 2) mk_fwd(Args args) {
    extern __shared__ __attribute__((aligned(16))) unsigned char lds_raw[];
#ifdef DBG_EVENT
    const unsigned long long tk_ = __builtin_amdgcn_s_memrealtime();
#endif
    LAS unsigned char* lds = (LAS unsigned char*)lds_raw;
    volatile LAS unsigned* MISC = (volatile LAS unsigned*)(lds + MISC_OFF);
    const int tid = threadIdx.x, wave = __builtin_amdgcn_readfirstlane(tid >> 6);
    const int G = gridDim.x, bx = blockIdx.x, vcu = (G % 8 == 0) ? (bx % 8) * (G / 8) + bx / 8 : bx;
    gu32* ctl0 = (gu32*)((GAS unsigned char*)args.ws + WS_CTL);
    for (int u = tid; u < (LDS_BYTES - LDSCTL_OFF) / 4; u += NWAVES * 64) ((LAS unsigned*)(lds + LDSCTL_OFF))[u] = 0u;
    __syncthreads();
    XcdBarrier bar = xcd_barrier_post((unsigned*)(ctl0 + CW_BAR), MISC + 8);
    if (tid == 0) __hip_atomic_fetch_or(ctl0 + CW_XMASK + (bx & 7), 1u << xb_xcc_id(), RLX_AGENT);
    const int gw = vcu * NWAVES + wave, NGW = G * NWAVES;
#define WSPTRS \
        GAS unsigned char* ws = (GAS unsigned char*)args.ws; GAS float* out = (GAS float*)args.out; asm volatile("" : "+s"(ws), "+s"(out)); \
        gu32* ctl = (gu32*)(ws + WS_CTL); \
        GAS bf16* W1I = (GAS bf16*)(ws + WS_W1I); GAS bf16* W1O = (GAS bf16*)(ws + WS_W1O); GAS bf16* WIN = (GAS bf16*)(ws + WS_WIN); GAS bf16* WOUT = (GAS bf16*)(ws + WS_WOUT); GAS bf16* W2I = (GAS bf16*)(ws + WS_W2I); GAS bf16* W2O = (GAS bf16*)(ws + WS_W2O); \
        GAS float* BC = (GAS float*)(ws + WS_BC); GAS float* SS0 = (GAS float*)(ws + WS_SS0); GAS float* SS1 = (GAS float*)(ws + WS_CTL) + CW_SS1; GAS float* SS2 = (GAS float*)(ws + WS_CTL) + CW_SS2; \
        GAS bf16* XA = (GAS bf16*)(ws + WS_XA); GAS bf16* HB = (GAS bf16*)(ws + WS_H); GAS float* X1 = (GAS float*)(ws + WS_X1); GAS float* X2 = (GAS float*)(ws + WS_X2); \
        GAS bf16* QKV = (GAS bf16*)(ws + WS_QKV); GAS bf16* OB = (GAS bf16*)(ws + WS_OB); GAS float* OSCR = (GAS float*)(ws + WS_OSCR);
#define DEPW(kind) (ctl + CW_DEP + (kind) * 68 * 64)
    {
        WSPTRS
        (void)ctl; (void)BC; (void)SS1; (void)SS2; (void)HB; (void)X1; (void)X2; (void)QKV; (void)OB; (void)OSCR; (void)out;
        const int tidp = tid_now(wave), lanep = tidp & 63;
            LAS float* scr = (LAS float*)(lds + wave * 16640);
            constexpr int I_1I = 16 * 88, I_1O = 44 * 16, I_IN = 16 * 52, I_O = 16 * 16;
            constexpr int NITEMS = 2 * (I_1I + I_1O) + I_IN + I_O;
            for (int it = gw; it < NITEMS; it += NGW) {
                int r = it;
                if (r < I_1I) { p0_transpose_item(INP(8), 1024, NFF, W1I, INP(7), 1, 88, scr, r, lanep); continue; } r -= I_1I;
                if (r < I_1O) { p0_transpose_item(INP(9), 2816, 1024, W1O, nullptr, 0, 16, scr, r, lanep); continue; } r -= I_1O;
                if (r < I_IN) { p0_transpose_item(INP(11), 1024, 3080, WIN, INP(10), 2, 52, scr, r, lanep); continue; } r -= I_IN;
                if (r < I_O) { p0_transpose_item(INP(18), 1024, 1024, WOUT, nullptr, 0, 16, scr, r, lanep); continue; } r -= I_O;
                if (r < I_1I) { p0_transpose_item(INP(20), 1024, NFF, W2I, INP(19), 1, 88, scr, r, lanep); continue; } r -= I_1I;
                p0_transpose_item(INP(21), 2816, 1024, W2O, nullptr, 0, 16, scr, r, lanep);
            }
#ifdef DBG_EVENT
            asm volatile("s_waitcnt vmcnt(0)" ::: "memory"); const unsigned long long tp1_ = __builtin_amdgcn_s_memrealtime();
#endif
            const int xfull = (MT / (4 * NGW)) * (4 * NGW), xleft = (MT - xfull) / 4, wlight = NITEMS % NGW;
            const int gx = (gw >= wlight && wlight + xleft + 256 <= NGW) ? gw - wlight : (wlight + xleft + 256 <= NGW ? NGW : gw);
            const int gb = (wlight + xleft + 256 <= NGW) ? gw - wlight - xleft : gw;
            for (int kx = 0; kx < MT / (4 * NGW) + 1; ++kx) {
                const int m0 = kx < MT / (4 * NGW) ? 4 * gw + kx * 4 * NGW : (gx >= 0 && gx < xleft ? xfull + 4 * gx : MT);
                if (m0 >= MT) continue;
                const GAS float* xrow = m0 < MP ? INP(0) + (size_t)m0 * 1024 : INP(1) + (size_t)(m0 - MP) * 1024;
                const GAS f32x4* xr = (const GAS f32x4*)xrow + lanep; f32x4 v[4][4]; float s[4];
#pragma unroll
                for (int q = 0; q < 4; ++q)
#pragma unroll
                    for (int j = 0; j < 4; ++j) v[q][j] = xr[q * 256 + 64 * j];
#pragma unroll
                for (int q = 0; q < 4; ++q) { s[q] = 0.f;
#pragma unroll
                    for (int j = 0; j < 4; ++j) s[q] += (v[q][j].x * v[q][j].x + v[q][j].y * v[q][j].y) + (v[q][j].z * v[q][j].z + v[q][j].w * v[q][j].w); }
#pragma unroll
                for (int o = 1; o < 64; o <<= 1) {
#pragma unroll
                    for (int q = 0; q < 4; ++q) s[q] += shx(s[q], o, lanep); }
                if (lanep == 0) { f32x4 sv; sv.x = s[0]; sv.y = s[1]; sv.z = s[2]; sv.w = s[3]; *(GAS f32x4*)(SS0 + m0) = sv; }
                GAS v2u* o8 = (GAS v2u*)(XA + (size_t)m0 * 1024) + lanep;
#pragma unroll
                for (int q = 0; q < 4; ++q)
#pragma unroll
                    for (int j = 0; j < 4; ++j) { v2u p; p.x = pk2(v[q][j].x, v[q][j].y); p.y = pk2(v[q][j].z, v[q][j].w); o8[q * 256 + 64 * j] = p; }
            }
#ifdef DBG_EVENT
            asm volatile("s_waitcnt vmcnt(0)" ::: "memory"); const unsigned long long tp2_ = __builtin_amdgcn_s_memrealtime();
#endif
            for (int j = gb; j >= 0 && j < 256; j += NGW) {
                const GAS float* lf = INP(4) + (size_t)(j >> 3) * 2048 * 8 + (j & 7);
                float e[32]; float run = 0.f;
#pragma unroll
                for (int i = 31; i >= 0; --i) { const float v = lf[(size_t)(32 * lanep + i) * 8]; e[i] = run; run += v; }
                float v = run;
#pragma unroll
                for (int o = 1; o < 64; o <<= 1) { const float t = shl_from(v, lanep + o < 64 ? lanep + o : lanep); if (lanep + o < 64) v += t; }
                const float excl = v - run;
                GAS float* dst = BC + (size_t)j * 2048 + 32 * lanep;
#pragma unroll
                for (int i = 0; i < 32; i += 4) { f32x4 q; q.x = (e[i] + excl) * LOG2E; q.y = (e[i + 1] + excl) * LOG2E; q.z = (e[i + 2] + excl) * LOG2E; q.w = (e[i + 3] + excl) * LOG2E; *(GAS f32x4*)(dst + i) = q; }
            }
#ifdef DBG_EVENT
            asm volatile("s_waitcnt vmcnt(0)" ::: "memory"); const unsigned long long tp3_ = __builtin_amdgcn_s_memrealtime();
            if (tid == 0) { MISC[16] = (unsigned)(tp1_ - tk_); MISC[17] = (unsigned)(tp2_ - tk_); MISC[18] = (unsigned)(tp3_ - tk_); }
#endif
    }
    xcd_barrier(bar);

    const int xg = bx & 7, hx = xg & 1;
    const unsigned xmask = (unsigned)__builtin_amdgcn_readfirstlane(__hip_atomic_load(ctl0 + CW_XMASK + xg, RLX_AGENT));
    const bool pureg = (xmask & (xmask - 1u)) == 0u;
    LAS unsigned* slot = (LAS unsigned*)(lds + ATT_TMP + 64);
    int lidx;
    { GAS unsigned char* ws = (GAS unsigned char*)args.ws; gu32* qh = (gu32*)(ws + WS_CTL) + CW_QH + 64 * xg;
      if (tid == 0) { slot[0] = __hip_atomic_fetch_add(qh, 1u, RLX_AGENT); slot[8] = 0u; slot[9] = 0u; slot[10] = 0u; slot[11] = 0u; }
      __syncthreads(); lidx = __builtin_amdgcn_readfirstlane(slot[0]); __syncthreads(); }
#ifdef DBG_EVENT
    unsigned long long acc_ = 0ull, tacc_ = 0ull; bool inacc_ = false;
    const unsigned long long tq_ = __builtin_amdgcn_s_memrealtime(); const unsigned long long t0_ = (DBG_EVENT >= 100) ? tk_ : tq_; unsigned long long tev_ = (DBG_EVENT >= 100) ? tq_ : 0ull;
    if (DBG_EVENT == 101) tev_ = tk_; if (DBG_EVENT >= 102 && DBG_EVENT <= 104) tev_ = tk_ + MISC[16 + DBG_EVENT - 102];
#endif
    for (;;) {
        int sg = 0, sbase = 0, scnt = SEG_CNT[0] ;
        while (sg < NSEG && lidx >= sbase + scnt) { sbase += scnt; ++sg; scnt = sg < NSEG ? SEG_CNT[sg] + (sg == 4 ? hx : 0) : 0; }
        if (sg >= NSEG) break;
#ifdef DBG_EVENT
        if (tev_ == 0ull && sg >= DBG_EVENT) tev_ = __builtin_amdgcn_s_memrealtime();
#ifdef DBG_ACC
        { const unsigned long long tn_ = __builtin_amdgcn_s_memrealtime(); if (inacc_) acc_ += tn_ - tacc_; inacc_ = (sg == DBG_ACC); tacc_ = tn_; }
#endif
#endif
        const int sph = SEG_PH[sg], skind = SEG_KIND[sg], sjj0 = SEG_JJ0[sg];
        GAS unsigned char* ws = (GAS unsigned char*)args.ws; GAS float* out = (GAS float*)args.out; asm volatile("" : "+s"(ws), "+s"(out));
        gu32* ctl = (gu32*)(ws + WS_CTL); gu32* qh = ctl + CW_QH + 64 * xg; gu32* fail = ctl + CW_FAIL;
#define P_W1I ((GAS bf16*)(ws + WS_W1I))
#define P_W1O ((GAS bf16*)(ws + WS_W1O))
#define P_WIN ((GAS bf16*)(ws + WS_WIN))
#define P_WOUT ((GAS bf16*)(ws + WS_WOUT))
#define P_W2I ((GAS bf16*)(ws + WS_W2I))
#define P_W2O ((GAS bf16*)(ws + WS_W2O))
#define P_BC ((GAS float*)(ws + WS_BC))
#define P_SS0 ((GAS float*)(ws + WS_SS0))
#define P_SS1 ((GAS float*)(ws + WS_CTL) + CW_SS1)
#define P_SS2 ((GAS float*)(ws + WS_CTL) + CW_SS2)
#define P_SS3 ((GAS float*)(ws + WS_CTL) + CW_SS3)
#define P_XA ((GAS bf16*)(ws + WS_XA))
#define P_HB ((GAS bf16*)(ws + WS_H))
#define P_X1B ((GAS bf16*)(ws + WS_X1))
#define P_X2B ((GAS bf16*)(ws + WS_X2))
#define P_X3B ((GAS bf16*)(ws + WS_X3))
#define P_HB2 ((GAS bf16*)(ws + WS_H2))
#define P_QKV ((GAS bf16*)(ws + WS_QKV))
#define P_OB ((GAS bf16*)(ws + WS_OB))
#define P_OSCR ((GAS float*)(ws + WS_OSCR))
        const int tidp = tid_now(wave), lanep = tidp & 63;
        int a_att = lidx - sbase + sjj0, sph_e = sph, skind_e = skind;
        const bool inpl = pureg && skind == 1;
        GAS bf16* const bX1 = inpl ? P_XA : P_X1B; GAS bf16* const bX2 = inpl ? P_XA : P_X2B; GAS bf16* const bX3 = inpl ? P_XA : P_X3B; GAS bf16* const bH2 = inpl ? P_HB : P_HB2;
        if (sph == 9) {
            __syncthreads();
            if (tidp == 0) slot[0] = __hip_atomic_fetch_add(ctl + CW_QH2 + 64 * xg, 1u, RLX_AGENT);
            __syncthreads(); a_att = __builtin_amdgcn_readfirstlane(slot[0]); __syncthreads();
            if (a_att >= 48) {
                if (tidp == 0) slot[0] = __hip_atomic_fetch_add(qh, 1u, RLX_AGENT);
                __syncthreads(); lidx = __builtin_amdgcn_readfirstlane(slot[0]); __syncthreads();
                continue;
            }
            sph_e = 4; skind_e = 0;
#ifdef DBG_STREAMDELAY
            { const unsigned long long t0d_ = __builtin_amdgcn_s_memrealtime(); while (__builtin_amdgcn_s_memrealtime() - t0d_ < (unsigned long long)DBG_STREAMDELAY) __builtin_amdgcn_s_sleep(32); }
#endif
        }
        { unsigned m1_ = 0xffffffffu; asm volatile("" : "+v"(m1_)); if (tidp == 0) { slot[2] = m1_; slot[3] = m1_; } }
        __syncthreads();
        if (sph == 1 || sph == 6) {
            const bool f1 = sph == 1;
            pg8::Gemm g{f1 ? P_XA : bX2, f1 ? P_W1I : P_W2I, MT, NFF, 1024};
            pg8::DynSched S{22, xg, sbase, scnt, skind, sjj0, lidx, qh, f1 ? (gu32*)nullptr : DEPW(DK_X2), 32u, 32u, f1 ? DEPW(DK_H1) : DEPW(DK_H2), fail, slot, tidp};
            pg8::EpiSwiglu E{f1 ? P_HB : bH2, f1 ? P_SS0 : P_SS2, pureg};
            pg8::gemm_phase<pg8::EpiSwiglu, pg8::DynSched, true, true>(lds + RING_OFF, g, S, E, tidp);
            __syncthreads(); lidx = __builtin_amdgcn_readfirstlane(slot[0]); __syncthreads();
        } else if (sph == 2 || sph == 5 || sph == 7) {
            const int which = sph;
            pg8::Gemm g{which == 5 ? P_OB : (which == 2 ? P_HB : bH2), which == 2 ? P_W1O : (which == 5 ? P_WOUT : P_W2O), MT, 1024, which == 5 ? 1024 : 2816};
            pg8::DynSched S{4, xg, sbase, scnt, skind, sjj0, lidx, qh,
                            which == 2 ? DEPW(DK_H1) : (which == 5 ? DEPW(DK_O) : DEPW(DK_H2)), which == 5 ? 12u : 176u, which == 5 ? 96u : 176u,
                            which == 2 ? DEPW(DK_X1) : (which == 5 ? DEPW(DK_X2) : DEPW(DK_Y)), fail, slot, tidp};
            pg8::EpiResid E; E.pure = pureg;
            if (which == 2) { E.base0 = INP(0); E.base1 = INP(1); E.baseh = nullptr; E.out = nullptr; E.xa = bX1; E.ssout = P_SS1; E.alpha = 0.5f; }
            else if (which == 5) { E.base0 = nullptr; E.base1 = nullptr; E.baseh = bX1; E.out = nullptr; E.xa = bX2; E.ssout = P_SS2; E.alpha = 1.0f; }
            else { E.base0 = nullptr; E.base1 = nullptr; E.baseh = bX2; E.out = nullptr; E.xa = bX3; E.ssout = P_SS3; E.alpha = 0.5f; }
            pg8::gemm_phase<pg8::EpiResid, pg8::DynSched, true, true>(lds + RING_OFF, g, S, E, tidp);
            __syncthreads(); lidx = __builtin_amdgcn_readfirstlane(slot[0]); __syncthreads();
        } else if (sph == 3) {
            pg8::Gemm g{bX1, P_WIN, MT, NINP, 1024};
            pg8::DynSched S{13, xg, sbase, scnt, skind, sjj0, lidx, qh, DEPW(DK_X1), 32u, 32u, DEPW(DK_QKV), fail, slot, tidp};
            pg8::EpiInProj E{P_QKV, out, P_SS1, INP(12), pureg};
            pg8::gemm_phase<pg8::EpiInProj, pg8::DynSched, true, true>(lds + RING_OFF, g, S, E, tidp);
            __syncthreads(); lidx = __builtin_amdgcn_readfirstlane(slot[0]); __syncthreads();
        } else if (sph_e == 4) {
            const int a = a_att;
#define LAM_NOW() (expf(wave_sum(INP(13)[lane2] * INP(14)[lane2], lane2)) - expf(wave_sum(INP(15)[lane2] * INP(16)[lane2], lane2)) + LAMBDA_INIT)
            LAS char* al = (LAS char*)lds;
            const int tid2 = tidp, lane2 = lanep, r32 = lane2 & 31, hi = lane2 >> 5;
            int idx, pubp;
            if (skind_e == 0) {
                if (a < 16) { const int b = xg + 8 * (a >> 2), h = a & 3; idx = b * 4 + h; pubp = 64 + (b >> 3); }
                else { const int a2 = a - 16, b = xg + 8 * (a2 >> 3), h = a2 & 7; idx = 256 + b * 8 + h; pubp = 64 + (b >> 3); }
                unit_wait(DEPW(DK_QKV), pubp, 1, 104u, fail, tidp, slot + 8);
            } else {
                const int b = xg; int qb;
                if (a < 32) { const int h = a & 3; qb = 7 - (a >> 2); idx = (qb >= 4 ? 128 + (7 - qb) * 32 : 512 + (3 - qb) * 32) + b * 4 + h; }
                else { const int a2 = a - 32, h = a2 & 7; qb = 7 - (a2 >> 3); idx = 640 + (7 - qb) * 64 + b * 8 + h; }
                pubp = 8 * b + qb; unit_wait(DEPW(DK_QKV), 8 * b, qb + 1, 104u, fail, tidp, slot + 8);
            }
            {
                if (idx < 128 || (idx >= 256 && idx < 512)) {
                    const int q = tid2 >> 4, seg = tid2 & 15;
                    if (idx < 128) {
                        const int b = idx >> 2, h = idx & 3; const size_t rowq = (size_t)MP + b * 32;
                        const float slope2 = (0.25f / (float)(1 << (2 * h))) * LOG2E;
                        float r0[8], r1[8];
                        att::sample_pass<false>(P_QKV + rowq * 3072 + 1536 + h * 128, INP(5) + ((size_t)b * 2048 * 4 + h) * 128, out + O_DKS + (size_t)(b * 32) * 512 + h * 128,
                                                   INP(6) + ((size_t)b * 2048 * 4 + h) * 128, out + O_DVS + (size_t)(b * 32) * 512 + h * 128, nullptr, nullptr, slope2, wave, lane2, tid2, al, r0);
                        att::sample_pass<false>(P_QKV + rowq * 3072 + 1536 + h * 128 + 64, INP(5) + ((size_t)b * 2048 * 4 + h) * 128 + 64, out + O_DKS + (size_t)(b * 32) * 512 + h * 128 + 64,
                                                   INP(6) + ((size_t)b * 2048 * 4 + h) * 128, out + O_DVS + (size_t)(b * 32) * 512 + h * 128, nullptr, nullptr, slope2, wave, lane2, tid2, al, r1);
                        float ss = 0.f;
                        const float lam = LAM_NOW();
#pragma unroll
                        for (int k = 0; k < 8; ++k) { r0[k] -= lam * r1[k]; ss += r0[k] * r0[k]; }
                        ss += shx(ss, 1, lane2); ss += shx(ss, 2, lane2); ss += shx(ss, 4, lane2); ss += shx(ss, 8, lane2);
                        const float rn = __builtin_amdgcn_rsqf(ss * (1.0f / 128.0f) + EPS) * (1.0f - LAMBDA_INIT);
                        const GAS float* gs = INP(17) + seg * 8;
                        v4u w; w.x = pk2(r0[0] * rn * gs[0], r0[1] * rn * gs[1]); w.y = pk2(r0[2] * rn * gs[2], r0[3] * rn * gs[3]); w.z = pk2(r0[4] * rn * gs[4], r0[5] * rn * gs[5]); w.w = pk2(r0[6] * rn * gs[6], r0[7] * rn * gs[7]);
                        st16_sc1_v(P_OB + (rowq + q) * 1024 + 512 + h * 128 + seg * 8, w);
                    } else if (idx >= 256) {
                        const int j = idx - 256, b = j >> 3, h = j & 7; const size_t rowq = (size_t)MP + b * 32;
                        float r0[4];
                        att::sample_pass<true>(P_QKV + rowq * 3072 + h * 64, INP(2) + ((size_t)b * 2048 * 8 + h) * 64, out + O_FKS + (size_t)(b * 32) * 512 + h * 64,
                                                  INP(3) + ((size_t)b * 2048 * 8 + h) * 64, out + O_FVS + (size_t)(b * 32) * 512 + h * 64, P_BC + (size_t)(b * 8 + h) * 2048, out + O_FLS + (size_t)(b * 32) * 8 + h, 0.f, wave, lane2, tid2, al, r0);
                        v2u w; w.x = pk2(r0[0], r0[1]); w.y = pk2(r0[2], r0[3]);
                        st8_sc1_v(P_OB + (rowq + q) * 1024 + h * 64 + seg * 4, w);
                    }
                } else if (idx >= 640) {
                    const int j = idx - 640, qb = 7 - (j >> 6), b = (j & 63) >> 3, h = j & 7; const size_t R0 = (size_t)b * SEQ + 256 * qb;
                    GAS bf16* Ow = P_OB + (R0 + 32 * wave) * 1024 + h * 64;
                    attx::build_cb_fox(out + O_FLP + (size_t)b * SEQ * 8 + h, 256 * (qb + 1), al, tid2, lane2, wave);
                    const float cbmin = *(LAS const float*)(al + attx::LDS_CB + 4 * 256 * qb);
                    att::f32x16 o[2];
                    if (__builtin_amdgcn_readfirstlane(cbmin > -50.0f ? 1 : 0)) {
                        attx::attn_pass<0>(P_QKV + (R0 + 32 * wave) * 3072 + h * 64, P_QKV + (size_t)b * SEQ * 3072 + 512 + h * 64, P_QKV + (size_t)b * SEQ * 3072 + 1024 + h * 64, qb, wave, lane2, al, 0.f, o);
                    } else {
                        __syncthreads();
                        att::fox_bias_scan(out + O_FLP + (size_t)b * SEQ * 8 + h, 256 * (qb + 1), qb, al, tid2, lane2, wave);
                        att::prompt_pass<2, true>(P_QKV + (R0 + 32 * wave) * 3072 + h * 64, P_QKV + (size_t)b * SEQ * 3072 + 512 + h * 64, P_QKV + (size_t)b * SEQ * 3072 + 1024 + h * 64, qb, wave, lane2, al, 0.f, o);
                    }
                    attx::store_o64(o, Ow, wave, lane2, al, !pureg);
                } else {
                    const int j = idx < 256 ? idx - 128 : idx - 512, qb = (idx < 256 ? 7 : 3) - (j >> 5), b = (j & 31) >> 2, h = j & 3; const size_t R0 = (size_t)b * SEQ + 256 * qb;
                    const float slope2 = (0.25f / (float)(1 << (2 * h))) * LOG2E;
                    GAS float* scr = P_OSCR + ((size_t)bx * 512 + tid2) * 64;
                    GAS bf16* Ow = P_OB + (R0 + 32 * wave) * 1024 + 512 + h * 128;
                    attx::build_cb_alibi(slope2, 256 * (qb + 1), al, tid2);
                    att::f32x16 o[4];
                    for (int e = 0; e < 2; ++e) {
                        attx::attn_pass4<1>(P_QKV + (R0 + 32 * wave) * 3072 + 1536 + h * 128 + e * 64, P_QKV + (size_t)b * SEQ * 3072 + 2048 + h * 128 + e * 64,
                                            P_QKV + (size_t)b * SEQ * 3072 + 2560 + h * 128, qb, wave, lane2, al, slope2, o);
                        if (e == 0) {
#pragma unroll
                            for (int d0 = 0; d0 < 4; ++d0)
#pragma unroll
                                for (int g = 0; g < 4; ++g) { f32x4 t; t.x = o[d0][4 * g]; t.y = o[d0][4 * g + 1]; t.z = o[d0][4 * g + 2]; t.w = o[d0][4 * g + 3]; *(GAS f32x4*)(scr + d0 * 16 + 4 * g) = t; }
                        }
                    }
                    {
                        const float lam = LAM_NOW();
#pragma unroll
                        for (int d0 = 0; d0 < 4; ++d0)
#pragma unroll
                            for (int g = 0; g < 4; ++g) { const f32x4 t = *(const GAS f32x4*)(scr + d0 * 16 + 4 * g);
#pragma unroll
                                for (int kk = 0; kk < 4; ++kk) o[d0][4 * g + kk] = t[kk] - lam * o[d0][4 * g + kk]; }
                        float gg[4];
#pragma unroll
                        for (int d0 = 0; d0 < 4; ++d0) gg[d0] = INP(17)[32 * d0 + r32] * (1.0f - LAMBDA_INIT);
#pragma unroll
                        for (int r = 0; r < 16; ++r) { float s = (o[0][r] * o[0][r] + o[1][r] * o[1][r]) + (o[2][r] * o[2][r] + o[3][r] * o[3][r]);
                            s += shx(s, 1, lane2); s += shx(s, 2, lane2); s += shx(s, 4, lane2); s += shx(s, 8, lane2); s += shx(s, 16, lane2);
                            const float rn = __builtin_amdgcn_rsqf(s * (1.0f / 128.0f) + EPS);
#pragma unroll
                            for (int d0 = 0; d0 < 4; ++d0) o[d0][r] *= rn * gg[d0]; }
                        attx::store_o64(*(att::f32x16 (*)[2])&o[0], Ow, wave, lane2, al, !pureg);
                        attx::store_o64(*(att::f32x16 (*)[2])&o[2], Ow + 64, wave, lane2, al, !pureg);
                    }
                }
            }
            unit_publish(DEPW(DK_O) + 64 * pubp, tidp);
            if (sph != 9) {
                if (tidp == 0) slot[0] = __hip_atomic_fetch_add(qh, 1u, RLX_AGENT);
                __syncthreads(); lidx = __builtin_amdgcn_readfirstlane(slot[0]); __syncthreads();
            }
        } else {
            const int j8 = lidx - sbase; int pm, qtr;
            if (skind == 0) { pm = 64 + (xg >> 1); qtr = 2 * hx + j8; } else { pm = 8 * xg + 7 - (j8 >> 2); qtr = j8 & 3; }
            unit_wait(DEPW(DK_Y), pm, 1, 32u, fail, tidp, slot + 8);
            const GAS f32x4* gf = (const GAS f32x4*)INP(22) + 2 * lanep;
            f32x4 gv[2][2];
#pragma unroll
            for (int j = 0; j < 2; ++j) { gv[j][0] = gf[128 * j]; gv[j][1] = gf[128 * j + 1]; }
            {
                const int m0 = pm * 256 + qtr * 64 + wave * 8;
                const GAS v4u* xr = (const GAS v4u*)(bX3 + (size_t)m0 * 1024) + lanep; v4u xv[8][2]; float rs[8];
#pragma unroll
                for (int q = 0; q < 8; ++q) { xv[q][0] = xr[q * 128]; xv[q][1] = xr[q * 128 + 64]; rs[q] = __builtin_amdgcn_rsqf(P_SS3[m0 + q] * (1.0f / 1024.0f) + EPS); }
#pragma unroll
                for (int q = 0; q < 8; ++q) { GAS f32x4* yr = (GAS f32x4*)(out + O_Y + (size_t)(m0 + q) * 1024) + 2 * lanep;
#pragma unroll
                    for (int j = 0; j < 2; ++j) { const v4u h4 = xv[q][j]; f32x4 a, b2;
                        a[0] = __uint_as_float(h4.x << 16); a[1] = __uint_as_float(h4.x & 0xffff0000u); a[2] = __uint_as_float(h4.y << 16); a[3] = __uint_as_float(h4.y & 0xffff0000u);
                        b2[0] = __uint_as_float(h4.z << 16); b2[1] = __uint_as_float(h4.z & 0xffff0000u); b2[2] = __uint_as_float(h4.w << 16); b2[3] = __uint_as_float(h4.w & 0xffff0000u);
#ifdef DBG_NOYS
                        if (skind != 0)
#endif
                        { yr[128 * j] = a * rs[q] * gv[j][0]; yr[128 * j + 1] = b2 * rs[q] * gv[j][1]; } } }
            }
            if (tidp == 0) slot[0] = __hip_atomic_fetch_add(qh, 1u, RLX_AGENT);
            __syncthreads(); lidx = __builtin_amdgcn_readfirstlane(slot[0]); __syncthreads();
        }
    }
#ifdef DBG_EVENT
    if (bx == DBG_BLOCK && tid == 0) { const unsigned long long te_ = __builtin_amdgcn_s_memrealtime(); unsigned long long q_ = (tev_ ? tev_ : te_) - t0_;
#ifdef DBG_ACC
        if (inacc_) acc_ += te_ - tacc_; q_ = acc_;
#endif
#ifdef DBG_WAITACC
        q_ = slot[8];
#endif
#ifdef DBG_KACC
        q_ = (DBG_KACC == 11) ? 100ull * slot[11] : slot[DBG_KACC];
#endif
        while (__builtin_amdgcn_s_memrealtime() - te_ < q_ + 50000ull) __builtin_amdgcn_s_sleep(32); }
#endif
}

extern "C" void kernel_launch(void* const* d_in, const int* in_sizes, int n_in, void* d_out, int out_size, void* d_ws, size_t ws_size, hipStream_t stream) {
    static int grid = 0;
    if (grid == 0) {
        if (n_in != 23 || in_sizes[0] != MP * DM || (size_t)out_size != O_END || ws_size < WS_END) {
            fprintf(stderr, "kernel_launch: unexpected problem: n_in %d in0 %d out %d ws %zu; nothing launched\n", n_in, n_in > 0 ? in_sizes[0] : -1, out_size, ws_size); grid = -1; return; }
        int dev = 0, cus = 0, per_cu = 0;
        if (hipGetDevice(&dev) != hipSuccess || hipDeviceGetAttribute(&cus, hipDeviceAttributeMultiprocessorCount, dev) != hipSuccess) { fprintf(stderr, "kernel_launch: device query failed\n"); grid = -1; return; }
        if (hipFuncSetAttribute((const void*)mk_fwd, hipFuncAttributeMaxDynamicSharedMemorySize, LDS_BYTES) != hipSuccess) { fprintf(stderr, "kernel_launch: hipFuncSetAttribute failed\n"); grid = -1; return; }
        if (hipOccupancyMaxActiveBlocksPerMultiprocessor(&per_cu, (const void*)mk_fwd, NWAVES * 64, LDS_BYTES) != hipSuccess || per_cu < 1) {
            fprintf(stderr, "kernel_launch: occupancy query reports %d workgroups per CU; nothing launched\n", per_cu); (void)hipGetLastError(); grid = -1; return; }
        (void)hipGetLastError();
        grid = cus;
    }
    if (grid < 0) return;
    if (hipMemsetAsync((char*)d_ws + WS_CTL, 0, CTL_ZERO_BYTES, stream) != hipSuccess) { fprintf(stderr, "kernel_launch: memset failed\n"); return; }
    Args a{};
    for (int i = 0; i < 23; ++i) a.in[i] = (const float*)d_in[i];
    a.out = (float*)d_out; a.ws = (unsigned char*)d_ws;
    for (int li = 0; li < 1; ++li) {
        a.ph_lo = 0; a.ph_hi = 9;
        hipLaunchKernelGGL(mk_fwd, dim3(grid), dim3(NWAVES * 64), LDS_BYTES, stream, a);
        const hipError_t le = hipPeekAtLastError();
        if (le != hipSuccess) { fprintf(stderr, "kernel_launch: launch %d failed: %s\n", li, hipGetErrorName(le)); break; }
    }
}
```

```cpp
#include <hip/hip_runtime.h>
#include <hip/hip_bf16.h>
#include <cstdio>
#include <cstdint>
#include <cmath>


constexpr int DM = 1024, NBP = 8, SEQ = 2048, NBS = 32, TSM = 32, PAST = 2048;
constexpr int MP = NBP * SEQ, MS = NBS * TSM, MT = MP + MS;
constexpr int DFF = 2816, NFF = 2 * DFF, NINP = 3328, NQKV = 3072;
constexpr float EPS = 1e-6f, LOG2E = 1.4426950408889634f, C2 = 0.125f * 1.4426950408889634f;
constexpr float LAMBDA_INIT = 0.2f;
constexpr size_t O_Y = 0;
constexpr size_t O_FKP = 17825792, O_FVP = 26214400, O_FLP = 34603008, O_DKP = 34734080, O_DVP = 43122688;
constexpr size_t O_FKS = 51511296, O_FVS = 52035584, O_FLS = 52559872, O_DKS = 52568064, O_DVS = 53092352, O_END = 53616640;

constexpr size_t MiB = 1u << 20;
constexpr size_t WS_CTL = 0, CTL_ZERO_BYTES = 1 * MiB;
constexpr size_t WS_W1I = 2 * MiB, WS_W1O = 14 * MiB, WS_WIN = 20 * MiB, WS_WOUT = 27 * MiB, WS_W2I = 30 * MiB, WS_W2O = 42 * MiB;
constexpr size_t WS_BC = 48 * MiB, WS_SS0 = 50 * MiB;
constexpr size_t WS_XA = 64 * MiB, WS_H = 100 * MiB, WS_X1 = 196 * MiB, WS_X2 = 230 * MiB, WS_X3 = 264 * MiB, WS_QKV = 332 * MiB, WS_OB = 434 * MiB, WS_OSCR = 468 * MiB, WS_H2 = 500 * MiB, WS_END = 596 * MiB;
constexpr int CW_BAR = 4096;
constexpr int CW_QUEUE = 8192;
constexpr int CW_SS1 = 65536, CW_SS2 = 65536 + 32768, CW_SS3 = 65536 + 65536;
static_assert((CW_SS3 + 32768) * 4 <= (int)CTL_ZERO_BYTES, "CTL region");

constexpr int RING_OFF = 0, RING_BYTES = 131072;
constexpr int ATT_WSF = 131072, ATT_ML = 135168, ATT_TMP = 137216;
constexpr int LDSCTL_OFF = 143360, MISC_OFF = LDSCTL_OFF + 320;
constexpr int LDS_BYTES = 147456;
constexpr int NWAVES = 8;

#define GAS __attribute__((address_space(1)))
#define LAS __attribute__((address_space(3)))
typedef unsigned short bf16;
typedef unsigned v4u __attribute__((ext_vector_type(4)));
typedef unsigned v2u __attribute__((ext_vector_type(2)));
typedef float f32x4 __attribute__((ext_vector_type(4)));
typedef GAS unsigned gu32;
#define RLX_AGENT __ATOMIC_RELAXED, __HIP_MEMORY_SCOPE_AGENT
#define LDS_WAIT() asm volatile("s_waitcnt lgkmcnt(0)" ::: "memory")
#define VM_WAIT() asm volatile("s_waitcnt vmcnt(0)" ::: "memory")
typedef float f32x2_t __attribute__((ext_vector_type(2))); typedef __bf16 bf16x2_t __attribute__((ext_vector_type(2)));
__device__ __forceinline__ unsigned pk2(float lo, float hi) { f32x2_t v = {lo, hi}; bf16x2_t b = __builtin_convertvector(v, bf16x2_t); return __builtin_bit_cast(unsigned, b); }

__device__ __forceinline__ float shx(float v, int m, int lane) { return __uint_as_float(__builtin_amdgcn_ds_bpermute((lane ^ m) << 2, __float_as_uint(v))); }
__device__ __forceinline__ float shl_from(float v, int src) { return __uint_as_float(__builtin_amdgcn_ds_bpermute(src << 2, __float_as_uint(v))); }
__device__ __forceinline__ void st16_sc1_v(GAS void* p, v4u v) { asm volatile("global_store_dwordx4 %0, %1, off sc1\n\ts_nop 1" :: "v"(p), "v"(v) : "memory"); }
__device__ __forceinline__ void st8_sc1_v(GAS void* p, v2u v) { asm volatile("global_store_dwordx2 %0, %1, off sc1\n\ts_nop 1" :: "v"(p), "v"(v) : "memory"); }
namespace pg8 {
#define PG8_LAS __attribute__((address_space(3)))
typedef unsigned short bf16_t;
typedef short bf16x8 __attribute__((ext_vector_type(8)));
typedef float f32x4 __attribute__((ext_vector_type(4)));
typedef unsigned u32x4 __attribute__((ext_vector_type(4)));
constexpr int BM = 256, BK = 64, HALF = 128, HTB = HALF * BK * 2  , STAGE_BYTES = 8 * HTB, NXCD = 8, WGM = 8;

__host__ __device__ __forceinline__ int lds_byte(int r, int c) { const int st = (r >> 4) * 2 + (c >> 5), rr = r & 15, cc = c & 31, ob = rr * 64 + cc * 2; return st * 1024 + (ob ^ (((ob >> 9) & 1) << 5)); }
__host__ __device__ __forceinline__ void stage_rc(int b, int& R, int& C) { const int st = b / 1024, sb = b % 1024, swz = sb ^ (((sb >> 9) & 1) << 5); R = (st >> 1) * 16 + swz / 64; C = (st & 1) * 32 + (swz % 64) / 2; }
__host__ __device__ __forceinline__ int perm32(int rho) { const int n = rho >> 4, i = rho & 15; return 8 * (i >> 2) + 4 * n + (i & 3); }

struct Unit { int pm, pn; };
struct Gemm { const __attribute__((address_space(1))) bf16_t* A; const __attribute__((address_space(1))) bf16_t* Bt; int M, N, K; };

struct StaticOrder {
    int nM, nN, nwg, G, c;
    __host__ __device__ void init(int M, int N, int G_, int c_) { nM = M / BM; nN = N / BM; nwg = nM * nN; G = G_; c = c_; }
    __host__ __device__ bool next(int i, Unit& u) const {
        const long L = (long)i * G + c; if (L >= nwg) return false;
        int wgid = (int)L; { const int q = nwg / NXCD, r = nwg % NXCD, xcd = wgid % NXCD, off = wgid / NXCD; wgid = (xcd < r ? xcd * (q + 1) : r * (q + 1) + (xcd - r) * q) + off; }
        const int nig = WGM * nN, gid = wgid / nig, fm = gid * WGM, gsz = (nM - fm) < WGM ? (nM - fm) : WGM;
        u.pm = fm + ((wgid % nig) % gsz); u.pn = (wgid % nig) / gsz; return true;
    }
    __device__ __forceinline__ void a_ready(const Unit&) const {}
    __device__ __forceinline__ void done(const Unit&) const {}
};

__device__ __forceinline__ unsigned cvt_pk_bf16(float lo, float hi) { unsigned r; asm volatile("v_cvt_pk_bf16_f32 %0, %1, %2" : "=v"(r) : "v"(lo), "v"(hi)); return r; }
typedef float f32x2 __attribute__((ext_vector_type(2)));
__device__ __forceinline__ void st16_sc1(const GAS void* base, unsigned boff, u32x4 v) { asm volatile("global_store_dwordx4 %0, %1, %2 sc1\n\ts_nop 1" :: "v"(boff), "v"(v), "s"(base) : "memory"); }
__device__ __forceinline__ void st16_sc1(const GAS void* base, unsigned boff, f32x4 v) { asm volatile("global_store_dwordx4 %0, %1, %2 sc1\n\ts_nop 1" :: "v"(boff), "v"(v), "s"(base) : "memory"); }
__device__ __forceinline__ void st16_x(const GAS void* base, unsigned boff, u32x4 v, bool wt) { if (wt) st16_sc1(base, boff, v); else asm volatile("global_store_dwordx4 %0, %1, %2\n\ts_nop 1" :: "v"(boff), "v"(v), "s"(base) : "memory"); }
__device__ __forceinline__ void st16_x(const GAS void* base, unsigned boff, f32x4 v, bool wt) { if (wt) st16_sc1(base, boff, v); else asm volatile("global_store_dwordx4 %0, %1, %2\n\ts_nop 1" :: "v"(boff), "v"(v), "s"(base) : "memory"); }
struct EpiSwiglu {
    static constexpr bool PERM = true, AFTER_DRAIN = false;
    GAS bf16_t* H; const GAS float* ss; bool pure;
    __device__ __forceinline__ void operator()(const f32x4 (&acc)[2][2][4][2], const Unit& u, int wr, int wc, int fr, int fq) const {
        const int row0 = u.pm * BM + wr * 64 + fr, hcol = u.pn * 128 + wc * 32 + 8 * fq; const bool wt = !pure || u.pm >= 64;
        float rsv[2][4];
#pragma unroll
        for (int ai = 0; ai < 2; ++ai)
#pragma unroll
            for (int m = 0; m < 4; ++m) rsv[ai][m] = ss[row0 + ai * HALF + m * 16];
#pragma unroll
        for (int ai = 0; ai < 2; ++ai)
#pragma unroll
            for (int m = 0; m < 4; ++m) {
                const int row = row0 + ai * HALF + m * 16;
                const float rs = __builtin_amdgcn_rsqf(rsv[ai][m] * (1.0f / 1024.0f) + 1e-6f);
                float h[8];
                const float c1 = rs * -1.4426950408889634f, c2 = rs * rs;
#pragma unroll
                for (int n = 0; n < 2; ++n) {
                    const f32x4 ga = acc[ai][0][m][n], ua = acc[ai][1][m][n];
                    const f32x4 t = ga * c1, p = (ga * ua) * c2;
                    f32x4 d;
#pragma unroll
                    for (int j = 0; j < 4; ++j) d[j] = __builtin_amdgcn_exp2f(t[j]);
                    d = d + 1.0f;
#pragma unroll
                    for (int j = 0; j < 4; ++j) h[n * 4 + j] = p[j] * __builtin_amdgcn_rcpf(d[j]);
                }
                u32x4 w; w.x = cvt_pk_bf16(h[0], h[1]); w.y = cvt_pk_bf16(h[2], h[3]); w.z = cvt_pk_bf16(h[4], h[5]); w.w = cvt_pk_bf16(h[6], h[7]);
                st16_x(H, (unsigned)(row * 2816 + hcol) * 2u, w, wt);
            }
    }
};
struct EpiResid {
    static constexpr bool PERM = true, AFTER_DRAIN = false;
    const GAS float* base0; const GAS float* base1;
    const GAS bf16_t* baseh;
    GAS float* out; GAS bf16_t* xa; GAS float* ssout; float alpha; bool pure;
    __device__ __forceinline__ void operator()(const f32x4 (&acc)[2][2][4][2], const Unit& u, int wr, int wc, int fr, int fq) const {
        const GAS float* bb = (u.pm < 64) ? base0 + (size_t)(u.pm * BM) * 1024 : base1 + (size_t)(u.pm * BM - 16384) * 1024;
        const GAS bf16_t* bh = baseh + (size_t)(u.pm * BM) * 1024;
        GAS float* ob = out + (size_t)(u.pm * BM) * 1024; GAS bf16_t* xb = xa + (size_t)(u.pm * BM) * 1024; GAS float* sb = ssout + u.pm * BM;
        const unsigned off0 = (unsigned)((wr * 64 + fr) * 1024 + u.pn * BM + wc * 32 + 8 * fq); const bool wt = !pure || u.pm >= 64;
        if (baseh) {
            u32x4 hbv[2][4][2];
#pragma unroll
            for (int ai = 0; ai < 2; ++ai)
#pragma unroll
                for (int m = 0; m < 4; ++m)
#pragma unroll
                    for (int bj = 0; bj < 2; ++bj) hbv[ai][m][bj] = *(const GAS u32x4*)(bh + off0 + (unsigned)((ai * HALF + m * 16) * 1024) + bj * HALF);
#pragma unroll
            for (int ai = 0; ai < 2; ++ai)
#pragma unroll
                for (int m = 0; m < 4; ++m) {
                    const unsigned offr = off0 + (unsigned)((ai * HALF + m * 16) * 1024);
                    float sq = 0.f;
#pragma unroll
                    for (int bj = 0; bj < 2; ++bj) {
                        const unsigned off = offr + bj * HALF; const u32x4 hb = hbv[ai][m][bj]; f32x4 b0, b1;
                        b0[0] = __uint_as_float(hb.x << 16); b0[1] = __uint_as_float(hb.x & 0xffff0000u); b0[2] = __uint_as_float(hb.y << 16); b0[3] = __uint_as_float(hb.y & 0xffff0000u);
                        b1[0] = __uint_as_float(hb.z << 16); b1[1] = __uint_as_float(hb.z & 0xffff0000u); b1[2] = __uint_as_float(hb.w << 16); b1[3] = __uint_as_float(hb.w & 0xffff0000u);
                        const f32x4 v0 = b0 + acc[ai][bj][m][0] * alpha, v1 = b1 + acc[ai][bj][m][1] * alpha;
                        if (out) { st16_x(ob, off * 4u, v0, wt); st16_x(ob, off * 4u + 16u, v1, wt); }
                        if (xa) { u32x4 w; w.x = cvt_pk_bf16(v0[0], v0[1]); w.y = cvt_pk_bf16(v0[2], v0[3]); w.z = cvt_pk_bf16(v1[0], v1[1]); w.w = cvt_pk_bf16(v1[2], v1[3]);
                            st16_x(xb, off * 2u, w, wt); }
                        sq += (v0[0] * v0[0] + v0[1] * v0[1]) + (v0[2] * v0[2] + v0[3] * v0[3]) + (v1[0] * v1[0] + v1[1] * v1[1]) + (v1[2] * v1[2] + v1[3] * v1[3]);
                    }
                    if (ssout) { sq += shx(sq, 16, fr + 16 * fq); sq += shx(sq, 32, fr + 16 * fq);
                        if (fq == 0) __hip_atomic_fetch_add(sb + (unsigned)(wr * 64 + fr + ai * HALF + m * 16), sq, __ATOMIC_RELAXED, __HIP_MEMORY_SCOPE_AGENT); }
                    asm volatile("" ::: "memory");
                }
        } else {
#pragma unroll
            for (int ai = 0; ai < 2; ++ai) {
                f32x4 bv[4][2][2];
#pragma unroll
                for (int m = 0; m < 4; ++m)
#pragma unroll
                    for (int bj = 0; bj < 2; ++bj) { const GAS float* p_ = bb + off0 + (unsigned)((ai * HALF + m * 16) * 1024) + bj * HALF; bv[m][bj][0] = *(const GAS f32x4*)p_; bv[m][bj][1] = *(const GAS f32x4*)(p_ + 4); }
#pragma unroll
                for (int m = 0; m < 4; ++m) {
                    const unsigned offr = off0 + (unsigned)((ai * HALF + m * 16) * 1024);
                    float sq = 0.f;
#pragma unroll
                    for (int bj = 0; bj < 2; ++bj) {
                        const unsigned off = offr + bj * HALF;
                        const f32x4 v0 = bv[m][bj][0] + acc[ai][bj][m][0] * alpha, v1 = bv[m][bj][1] + acc[ai][bj][m][1] * alpha;
                        if (out) { st16_x(ob, off * 4u, v0, wt); st16_x(ob, off * 4u + 16u, v1, wt); }
                        if (xa) { u32x4 w; w.x = cvt_pk_bf16(v0[0], v0[1]); w.y = cvt_pk_bf16(v0[2], v0[3]); w.z = cvt_pk_bf16(v1[0], v1[1]); w.w = cvt_pk_bf16(v1[2], v1[3]);
                            st16_x(xb, off * 2u, w, wt); }
                        sq += (v0[0] * v0[0] + v0[1] * v0[1]) + (v0[2] * v0[2] + v0[3] * v0[3]) + (v1[0] * v1[0] + v1[1] * v1[1]) + (v1[2] * v1[2] + v1[3] * v1[3]);
                    }
                    if (ssout) { sq += shx(sq, 16, fr + 16 * fq); sq += shx(sq, 32, fr + 16 * fq);
                        if (fq == 0) __hip_atomic_fetch_add(sb + (unsigned)(wr * 64 + fr + ai * HALF + m * 16), sq, __ATOMIC_RELAXED, __HIP_MEMORY_SCOPE_AGENT); }
                    asm volatile("" ::: "memory");
                }
            }
        }
    }
};
struct EpiInProj {
    static constexpr bool PERM = true, AFTER_DRAIN = false;
    GAS bf16_t* qkv; GAS float* out; const GAS float* ss; const GAS float* bfg; bool pure;
    __device__ __forceinline__ void operator()(const f32x4 (&acc)[2][2][4][2], const Unit& u, int wr, int wc, int fr, int fq) const {
        const int pn = u.pn, row0 = u.pm * BM + wr * 64 + fr; const bool wt = !pure || u.pm >= 64;
        if (pn < 12) {
            const int kind = pn >> 1; const bool isq = (kind == 0 || kind == 3); const float sc = isq ? 0.125f * 1.4426950408889634f : 1.0f;
            size_t offp = 0, offs = 0;
            if (kind == 1) { offp = 17825792; offs = 51511296; } else if (kind == 2) { offp = 26214400; offs = 52035584; }
            else if (kind == 4) { offp = 34734080; offs = 52568064; } else if (kind == 5) { offp = 43122688; offs = 53092352; }
            const int cc = (pn & 1) * 256 + wc * 32 + 8 * fq, bc = pn * 256 + wc * 32 + 8 * fq;
            float rsv[2][4];
#pragma unroll
            for (int ai = 0; ai < 2; ++ai)
#pragma unroll
                for (int m = 0; m < 4; ++m) rsv[ai][m] = ss[row0 + ai * HALF + m * 16];
#pragma unroll
            for (int ai = 0; ai < 2; ++ai)
#pragma unroll
                for (int m = 0; m < 4; ++m) {
                    const int row = row0 + ai * HALF + m * 16;
                    const float rs = __builtin_amdgcn_rsqf(rsv[ai][m] * (1.0f / 1024.0f) + 1e-6f);
                    const unsigned fo = (unsigned)(row < 16384 ? row * 512 : (row - 16384) * 512) + cc; GAS float* fob = (u.pm < 64) ? out + offp : out + offs;
#pragma unroll
                    for (int bj = 0; bj < 2; ++bj) {
                        const f32x4 v0 = acc[ai][bj][m][0] * rs, v1 = acc[ai][bj][m][1] * rs;
                        u32x4 w; w.x = cvt_pk_bf16(v0[0] * sc, v0[1] * sc); w.y = cvt_pk_bf16(v0[2] * sc, v0[3] * sc); w.z = cvt_pk_bf16(v1[0] * sc, v1[1] * sc); w.w = cvt_pk_bf16(v1[2] * sc, v1[3] * sc);
                        st16_x(qkv, (unsigned)(row * 3072 + bc + bj * HALF) * 2u, w, wt);
                        if (!isq) { if (u.pm < 64) { *(GAS f32x4*)(fob + fo + bj * HALF) = v0; *(GAS f32x4*)(fob + fo + bj * HALF + 4) = v1; }
                                    else { st16_sc1(fob, (fo + bj * HALF) * 4u, v0); st16_sc1(fob, (fo + bj * HALF) * 4u + 16u, v1); } }
                    }
                }
        } else if (wc == 0 && fq == 0) {
            const f32x4 b0 = *(const GAS f32x4*)bfg, b1 = *(const GAS f32x4*)(bfg + 4);
            float rsv[2][4];
#pragma unroll
            for (int ai = 0; ai < 2; ++ai)
#pragma unroll
                for (int m = 0; m < 4; ++m) rsv[ai][m] = ss[row0 + ai * HALF + m * 16];
#pragma unroll
            for (int ai = 0; ai < 2; ++ai)
#pragma unroll
                for (int m = 0; m < 4; ++m) {
                    const int row = row0 + ai * HALF + m * 16;
                    const float rs = __builtin_amdgcn_rsqf(rsv[ai][m] * (1.0f / 1024.0f) + 1e-6f);
                    const GAS float* lfb = (u.pm < 64) ? out + 34603008 : out + 52559872; const unsigned lfo = (unsigned)(row < 16384 ? row : row - 16384) * 32u;
                    f32x4 z0 = acc[ai][0][m][0] * rs + b0, z1 = acc[ai][0][m][1] * rs + b1, l0, l1;
#pragma unroll
                    for (int j = 0; j < 4; ++j) { l0[j] = fminf(z0[j], 0.f) - log1pf(expf(-fabsf(z0[j]))); l1[j] = fminf(z1[j], 0.f) - log1pf(expf(-fabsf(z1[j]))); }
                    st16_x(lfb, lfo, l0, wt); st16_x(lfb, lfo + 16u, l1, wt);
                }
        }
    }
};

struct DynSched {
    int nN, xg;
    int seg_base, seg_cnt, kind, jj0;
    int first;
    gu32* qhead; gu32* dep; unsigned need0, need1; gu32* pub; gu32* fail; LAS unsigned* slot; int tid;
    mutable int acall = 0;
    gu32* pub2 = nullptr;
    __device__ __forceinline__ bool decode(int lidx, Unit& u) const {
        const int j = lidx - seg_base; if (j >= seg_cnt) return false;
        if (kind == 0) { const int half = xg & 1, c0 = half ? nN / 2 : 0; u.pm = 64 + (xg >> 1); u.pn = c0 + j; }
        else if (kind == 5) { const int jj = jj0 + j; u.pm = 8 * xg + 7 - (jj >> 2); u.pn = jj & 3; }
        else { const int jj = jj0 + j; u.pm = 8 * xg + 7 - (jj & 7); u.pn = jj >> 3; }
        return true;
    }
    __device__ __forceinline__ bool next(int i, Unit& u) const {
        int lidx = first;
        if (i != 0) {
            if (tid == 0) slot[0] = __hip_atomic_fetch_add(qhead, 1u, __ATOMIC_RELAXED, __HIP_MEMORY_SCOPE_AGENT);
            asm volatile("s_waitcnt lgkmcnt(0)" ::: "memory"); __builtin_amdgcn_s_barrier(); asm volatile("" ::: "memory");
            lidx = __builtin_amdgcn_readfirstlane(slot[0]);
        }
        return decode(lidx, u);
    }
    __device__ __forceinline__ void a_ready(const Unit& u) const {
        if (!dep) return;
        const int k = acall++; const bool skip = (int)slot[2 + (k & 1)] == u.pm;
        if (!skip) {
            if (tid < 64) {
#ifdef DBG_WAITACC_G
                const unsigned tw0_ = (unsigned)__builtin_amdgcn_s_memrealtime();
#endif
                const unsigned need = u.pm < 64 ? need0 : need1; unsigned spins = 0;
                while ((unsigned)__builtin_amdgcn_readfirstlane(__hip_atomic_load(dep + 64 * u.pm, __ATOMIC_RELAXED, __HIP_MEMORY_SCOPE_AGENT)) < need) {
                    __builtin_amdgcn_s_sleep(8);
                    if ((++spins & 1023u) == 0u) { if (__builtin_amdgcn_readfirstlane(__hip_atomic_load(fail, __ATOMIC_RELAXED, __HIP_MEMORY_SCOPE_AGENT)) != 0u) break;
                        if (spins > (1u << 16)) { if (tid == 0) __hip_atomic_store(fail, 1u, __ATOMIC_RELAXED, __HIP_MEMORY_SCOPE_AGENT); break; } }
                }
#ifdef DBG_CONSDELAY
                if (u.pm >= 64) { const unsigned long long t0d_ = __builtin_amdgcn_s_memrealtime(); while (__builtin_amdgcn_s_memrealtime() - t0d_ < (unsigned long long)DBG_CONSDELAY) __builtin_amdgcn_s_sleep(8); }
#endif
                __builtin_amdgcn_fence(__ATOMIC_ACQUIRE, "agent");
                asm volatile("s_waitcnt vmcnt(0)" ::: "memory");
#ifdef DBG_WAITACC_G
                if (tid == 0) slot[8] += (unsigned)__builtin_amdgcn_s_memrealtime() - tw0_;
#endif
            }
            asm volatile("" ::: "memory"); __builtin_amdgcn_s_barrier(); asm volatile("" ::: "memory");
        }
        if (tid == 0) slot[2 + ((k + 1) & 1)] = (unsigned)u.pm;
    }
    __device__ __forceinline__ void done(const Unit& u) const {
        asm volatile("s_waitcnt vmcnt(0)" ::: "memory");
        gu32* const pp = (pub2 && u.pn == 12 && u.pm < 64) ? pub2 : pub;
        if ((tid & 63) == 0) __hip_atomic_fetch_add(pp + 64 * u.pm, 1u, __ATOMIC_RELAXED, __HIP_MEMORY_SCOPE_AGENT);
    }
};

template <class Epi, class Sched, bool ALIGN_EPI = false, bool SP2 = false>
__device__ __forceinline__ void gemm_phase(PG8_LAS unsigned char* lds, const Gemm g, const Sched& S, const Epi& E, const int tid) {
    const int wid = __builtin_amdgcn_readfirstlane(tid >> 6), lane = tid & 63, wr = wid >> 2, wc = wid & 3, fr = lane & 15, fq = lane >> 4;
    const int K = g.K, nt = K / BK;
    unsigned voffA[2], voffB[2];
#pragma unroll
    for (int i = 0; i < 2; ++i) { int R, C; stage_rc(tid * 16 + i * 8192, R, C); const int Rb = Epi::PERM ? ((R & ~31) + perm32(R & 31)) : R;
        voffA[i] = (unsigned)(R * K + C) * 2u; voffB[i] = (unsigned)(Rb * K + C) * 2u; }
    const size_t kstep = (size_t)(BK * 2);
    const size_t hstep = (size_t)HALF * K * 2;
    const size_t tstep = 2 * hstep;
    const unsigned ldsw = (unsigned)wid * 1024u;
    const int aoff = lds_byte(wr * 64 + fr, fq * 8), boff = lds_byte(wc * 32 + fr, fq * 8);
#define PG8_SA(b, h) (((b) * 2 + (h)) * HTB)
#define PG8_SB(b, h) ((4 + (b) * 2 + (h)) * HTB)
#define PG8_STAGE(bufoff, gbase, voff) do { _Pragma("unroll") for (int _i = 0; _i < 2; ++_i) \
        __builtin_amdgcn_global_load_lds((const unsigned*)((const char*)(gbase) + (voff)[_i]), (PG8_LAS unsigned*)(lds + (bufoff) + ldsw + _i * 8192), 16, 0, 0); } while (0)
#define PG8_LDA(dst, b, h) do { _Pragma("unroll") for (int m = 0; m < 4; ++m) _Pragma("unroll") for (int k = 0; k < 2; ++k) dst[m][k] = *(const PG8_LAS bf16x8*)(lds + PG8_SA(b, h) + aoff + m * 2048 + k * 1024); } while (0)
#define PG8_LDB(dst, b, h) do { _Pragma("unroll") for (int n = 0; n < 2; ++n) _Pragma("unroll") for (int k = 0; k < 2; ++k) dst[n][k] = *(const PG8_LAS bf16x8*)(lds + PG8_SB(b, h) + boff + n * 2048 + k * 1024); } while (0)
#define PG8_MMA(ai, bj, At, Bt) do { __builtin_amdgcn_s_setprio(1); _Pragma("unroll") for (int m = 0; m < 4; ++m) _Pragma("unroll") for (int n = 0; n < 2; ++n) _Pragma("unroll") for (int k = 0; k < 2; ++k) \
        acc[ai][bj][m][n] = __builtin_amdgcn_mfma_f32_16x16x32_bf16(Bt[n][k], At[m][k], acc[ai][bj][m][n], 0, 0, 0); __builtin_amdgcn_s_setprio(0); } while (0)
#define PG8_WAIT_V(n) asm volatile("s_waitcnt vmcnt(" #n ")" ::: "memory")
#define PG8_WAIT_L(n) asm volatile("s_waitcnt lgkmcnt(" #n ")" ::: "memory")
#define PG8_BAR __builtin_amdgcn_s_barrier()
#define PG8_SCHED __builtin_amdgcn_sched_barrier(0)
    Unit cur, nxt; int ui = 0;
    if (!S.next(0, cur)) return;
    f32x4 acc[2][2][4][2];
#pragma unroll
    for (int a = 0; a < 2; ++a)
#pragma unroll
        for (int b = 0; b < 2; ++b)
#pragma unroll
            for (int m = 0; m < 4; ++m)
#pragma unroll
                for (int n = 0; n < 2; ++n) acc[a][b][m][n] = (f32x4){0.f, 0.f, 0.f, 0.f};
    bf16x8 At[4][2], B0[2][2], B1[2][2];
    const char* cA = (const char*)g.A + (size_t)cur.pm * tstep; const char* cB = (const char*)g.Bt + (size_t)cur.pn * tstep;
    S.a_ready(cur);
    if constexpr (SP2) {
        PG8_STAGE(PG8_SB(0, 0), cB, voffB); PG8_STAGE(PG8_SB(0, 1), cB + hstep, voffB); PG8_STAGE(PG8_SA(0, 0), cA, voffA); PG8_STAGE(PG8_SA(0, 1), cA + hstep, voffA);
        if (wr == 1) PG8_BAR;
        PG8_WAIT_V(2); PG8_BAR;
        PG8_STAGE(PG8_SB(1, 0), cB + kstep, voffB); PG8_STAGE(PG8_SA(1, 0), cA + kstep, voffA); PG8_STAGE(PG8_SB(1, 1), cB + hstep + kstep, voffB);
        PG8_WAIT_V(6); PG8_BAR;
    } else {
        PG8_STAGE(PG8_SB(0, 0), cB, voffB); PG8_STAGE(PG8_SA(0, 0), cA, voffA); PG8_STAGE(PG8_SB(0, 1), cB + hstep, voffB); PG8_STAGE(PG8_SA(0, 1), cA + hstep, voffA);
        if (wr == 1) PG8_BAR;
        PG8_WAIT_V(4); PG8_BAR;
        PG8_STAGE(PG8_SB(1, 0), cB + kstep, voffB); PG8_STAGE(PG8_SA(1, 0), cA + kstep, voffA); PG8_STAGE(PG8_SB(1, 1), cB + hstep + kstep, voffB);
        PG8_WAIT_V(6); PG8_BAR;
    }
    for (;;) {
        const bool has_next = S.next(ui + 1, nxt);
        const char* nA = has_next ? (const char*)g.A + (size_t)nxt.pm * tstep : cA; const char* nB = has_next ? (const char*)g.Bt + (size_t)nxt.pn * tstep : cB;
#ifdef DBG_KACC
        const unsigned tk0_ = (unsigned)__builtin_amdgcn_s_memrealtime();
#endif
        for (int t = 0; t < nt; t += 2) {
            const bool last = (t == nt - 2);
            const char* a1 = cA + (size_t)(t + 1) * kstep;
            const char* a2 = last ? nA : cA + (size_t)(t + 2) * kstep; const char* b2 = last ? nB : cB + (size_t)(t + 2) * kstep;
            const char* a3 = a2 + kstep; const char* b3 = b2 + kstep;
            if (last && has_next) S.a_ready(nxt);
            if constexpr (SP2) {
            PG8_LDB(B0, 0, 0); PG8_LDB(B1, 0, 1); PG8_SCHED; PG8_LDA(At, 0, 0); PG8_STAGE(PG8_SA(1, 1), a1 + hstep, voffA);
            PG8_WAIT_V(8); PG8_WAIT_L(0); PG8_BAR; PG8_MMA(0, 0, At, B0); PG8_MMA(0, 1, At, B1); PG8_BAR; PG8_SCHED;
            PG8_LDA(At, 0, 1); PG8_STAGE(PG8_SB(0, 0), b2, voffB); PG8_STAGE(PG8_SB(0, 1), b2 + hstep, voffB); PG8_STAGE(PG8_SA(0, 0), a2, voffA);
            PG8_WAIT_V(8); PG8_WAIT_L(0); PG8_BAR; PG8_MMA(1, 0, At, B0); PG8_MMA(1, 1, At, B1); PG8_BAR; PG8_SCHED;
            PG8_LDB(B0, 1, 0); PG8_LDB(B1, 1, 1); PG8_SCHED; PG8_LDA(At, 1, 0); PG8_STAGE(PG8_SA(0, 1), a2 + hstep, voffA);
            PG8_WAIT_V(8); PG8_WAIT_L(0); PG8_BAR; PG8_MMA(0, 0, At, B0); PG8_MMA(0, 1, At, B1); PG8_BAR; PG8_SCHED;
            PG8_LDA(At, 1, 1); PG8_STAGE(PG8_SB(1, 0), b3, voffB); PG8_STAGE(PG8_SB(1, 1), b3 + hstep, voffB); PG8_STAGE(PG8_SA(1, 0), a3, voffA);
            PG8_WAIT_V(8); PG8_WAIT_L(0); PG8_BAR; PG8_MMA(1, 0, At, B0); PG8_MMA(1, 1, At, B1); PG8_BAR; PG8_SCHED;
            } else {
            PG8_LDB(B0, 0, 0); PG8_SCHED; PG8_LDA(At, 0, 0); PG8_STAGE(PG8_SA(1, 1), a1 + hstep, voffA);
            PG8_WAIT_L(8); PG8_BAR; PG8_WAIT_L(0); PG8_MMA(0, 0, At, B0); PG8_BAR; PG8_SCHED;
            PG8_LDB(B1, 0, 1); PG8_STAGE(PG8_SB(0, 0), b2, voffB);
            PG8_BAR; PG8_WAIT_L(0); PG8_MMA(0, 1, At, B1); PG8_BAR;
            PG8_LDA(At, 0, 1); PG8_STAGE(PG8_SA(0, 0), a2, voffA);
            PG8_BAR; PG8_WAIT_L(0); PG8_MMA(1, 0, At, B0); PG8_BAR; PG8_SCHED;
            PG8_STAGE(PG8_SB(0, 1), b2 + hstep, voffB);
            PG8_WAIT_V(6); PG8_BAR; PG8_MMA(1, 1, At, B1); PG8_BAR;
            PG8_LDB(B0, 1, 0); PG8_SCHED; PG8_LDA(At, 1, 0); PG8_STAGE(PG8_SA(0, 1), a2 + hstep, voffA);
            PG8_WAIT_L(8); PG8_BAR; PG8_WAIT_L(0); PG8_MMA(0, 0, At, B0); PG8_BAR; PG8_SCHED;
            PG8_LDB(B1, 1, 1); PG8_STAGE(PG8_SB(1, 0), b3, voffB);
            PG8_BAR; PG8_WAIT_L(0); PG8_MMA(0, 1, At, B1); PG8_BAR;
            PG8_LDA(At, 1, 1); PG8_STAGE(PG8_SA(1, 0), a3, voffA);
            PG8_BAR; PG8_WAIT_L(0); PG8_MMA(1, 0, At, B0); PG8_BAR; PG8_SCHED;
            PG8_STAGE(PG8_SB(1, 1), b3 + hstep, voffB);
            PG8_WAIT_V(6); PG8_BAR; PG8_MMA(1, 1, At, B1); PG8_BAR;
            }
        }
#ifdef DBG_KACC
        const unsigned tk1_ = (unsigned)__builtin_amdgcn_s_memrealtime(); if (tid == 0) { S.slot[9] += tk1_ - tk0_; S.slot[11] += 1u; }
#endif
        if constexpr (ALIGN_EPI) { if (wr == 0) PG8_BAR; }
        if constexpr (!Epi::AFTER_DRAIN) { E(acc, cur, wr, wc, fr, fq); S.done(cur); }
#ifdef DBG_KACC
        if (tid == 0) S.slot[10] += (unsigned)__builtin_amdgcn_s_memrealtime() - tk1_;
#endif
        if (!has_next) break;
#pragma unroll
        for (int a = 0; a < 2; ++a)
#pragma unroll
            for (int b = 0; b < 2; ++b)
#pragma unroll
                for (int m = 0; m < 4; ++m)
#pragma unroll
                    for (int n = 0; n < 2; ++n) acc[a][b][m][n] = (f32x4){0.f, 0.f, 0.f, 0.f};
        cur = nxt; cA = nA; cB = nB; ++ui;
        if constexpr (ALIGN_EPI) { if (wr == 1) PG8_BAR; }
    }
    PG8_WAIT_V(0);
    if constexpr (!ALIGN_EPI) { if (wr == 0) PG8_BAR; }
    PG8_BAR;
    if constexpr (Epi::AFTER_DRAIN) { E.fused(acc, cur, wr, wc, fr, fq, lds, wid, lane); S.done(cur); }
#undef PG8_SA
#undef PG8_SB
#undef PG8_STAGE
#undef PG8_LDA
#undef PG8_LDB
#undef PG8_MMA
#undef PG8_WAIT_V
#undef PG8_WAIT_L
#undef PG8_BAR
#undef PG8_SCHED
}
}
namespace att {
typedef short bf16x8 __attribute__((ext_vector_type(8)));
typedef short s16x4 __attribute__((ext_vector_type(4)));
typedef float f32x16 __attribute__((ext_vector_type(16)));
typedef unsigned u32x4 __attribute__((ext_vector_type(4)));
typedef LAS const char* lds_cptr;
typedef short v4i16_t __attribute__((ext_vector_type(4)));
constexpr float THR = 8.0f;
constexpr int PITCH = 3072;

__device__ __forceinline__ int crow(int r, int hi) { return (r & 3) + 8 * (r >> 2) + 4 * hi; }
__device__ __forceinline__ float neg_inf_s() { float v; asm volatile("s_mov_b32 %0, 0xff800000" : "=s"(v)); return v; }
__device__ __forceinline__ void glds16(const GAS void* gsrc, unsigned lds_dst) { unsigned keep;
    asm volatile("s_mov_b32 %0, m0\n\ts_mov_b32 m0, %2\n\ts_nop 0\n\tglobal_load_lds_dwordx4 %1, off\n\ts_mov_b32 m0, %0" : "=&s"(keep) : "v"(gsrc), "s"(lds_dst) : "memory"); }
__device__ __forceinline__ s16x4 vtr(lds_cptr p) { return __builtin_bit_cast(s16x4, __builtin_amdgcn_ds_read_tr16_b64_v4i16((LAS v4i16_t*)p)); }
#define ABAR_L() asm volatile("s_waitcnt lgkmcnt(0)\n\ts_barrier" ::: "memory")
#define ABAR_VL() asm volatile("s_waitcnt vmcnt(0) lgkmcnt(0)\n\ts_barrier" ::: "memory")

template <int NDV>
__device__ __forceinline__ void sm_part(f32x16 s, float& m, float& l, f32x16 (&o)[NDV], LAS float* wsf, int r32, int hi, bf16x8& pa0, bf16x8& pa1) {
    float pm = s[0];
#pragma unroll
    for (int r = 1; r < 16; ++r) pm = fmaxf(pm, s[r]);
    { auto rr = __builtin_amdgcn_permlane32_swap(__float_as_uint(pm), __float_as_uint(pm), false, false); pm = fmaxf(__uint_as_float(rr[0]), __uint_as_float(rr[1])); }
    if (!__all(pm <= m + THR)) {
        const float mn = fmaxf(m, pm), alpha = __builtin_amdgcn_exp2f(m - mn); m = mn; l *= alpha;
        if (hi == 0) wsf[r32] = alpha;
        LDS_WAIT();
#pragma unroll
        for (int r = 0; r < 16; ++r) { const float a = wsf[crow(r, hi)];
#pragma unroll
            for (int d0 = 0; d0 < NDV; ++d0) o[d0][r] *= a; }
        LDS_WAIT();
    }
    float ps = 0.f;
#pragma unroll
    for (int r = 0; r < 16; ++r) { s[r] = __builtin_amdgcn_exp2f(s[r] - m); ps += s[r]; }
    l += ps;
    u32x4 w0, w1;
    w0.x = pk2(s[0], s[1]); w0.y = pk2(s[2], s[3]); w0.z = pk2(s[4], s[5]); w0.w = pk2(s[6], s[7]);
    w1.x = pk2(s[8], s[9]); w1.y = pk2(s[10], s[11]); w1.z = pk2(s[12], s[13]); w1.w = pk2(s[14], s[15]);
    pa0 = __builtin_bit_cast(bf16x8, w0); pa1 = __builtin_bit_cast(bf16x8, w1);
}
template <int NDV, int KG>
__device__ __forceinline__ void pv_part(bf16x8 pa0, bf16x8 pa1, f32x16 (&o)[NDV], lds_cptr vb) {
#pragma unroll
    for (int d0 = 0; d0 < NDV; ++d0) {
        const s16x4 a0 = vtr(vb + (d0 * KG + 0) * 1024), a1 = vtr(vb + (d0 * KG + 0) * 1024 + 512);
        const s16x4 b0 = vtr(vb + (d0 * KG + 1) * 1024), b1 = vtr(vb + (d0 * KG + 1) * 1024 + 512);
        const bf16x8 v0 = {a0[0], a0[1], a0[2], a0[3], a1[0], a1[1], a1[2], a1[3]}, v1 = {b0[0], b0[1], b0[2], b0[3], b1[0], b1[1], b1[2], b1[3]};
        o[d0] = __builtin_amdgcn_mfma_f32_32x32x16_bf16(pa0, v0, o[d0], 0, 0, 0);
        o[d0] = __builtin_amdgcn_mfma_f32_32x32x16_bf16(pa1, v1, o[d0], 0, 0, 0);
    }
}
template <int NDV, int KG>
__device__ __forceinline__ void sm_pv(f32x16 s, float& m, float& l, f32x16 (&o)[NDV], lds_cptr vb, LAS float* wsf, int r32, int hi) {
    bf16x8 pa0, pa1; sm_part<NDV>(s, m, l, o, wsf, r32, hi, pa0, pa1); pv_part<NDV, KG>(pa0, pa1, o, vb);
}
template <int NDV>
__device__ __forceinline__ void sm_pv64(f32x16 s0, f32x16 s1, float& m, float& l, f32x16 (&o)[NDV], lds_cptr vb, LAS float* wsf, int r32, int hi) {
    float pa = fmaxf(s0[0], s1[0]), pb = fmaxf(s0[1], s1[1]);
#pragma unroll
    for (int r = 2; r < 16; r += 2) { pa = fmaxf(pa, fmaxf(s0[r], s1[r])); pb = fmaxf(pb, fmaxf(s0[r + 1], s1[r + 1])); }
    float pm = fmaxf(pa, pb);
    { auto rr = __builtin_amdgcn_permlane32_swap(__float_as_uint(pm), __float_as_uint(pm), false, false); pm = fmaxf(__uint_as_float(rr[0]), __uint_as_float(rr[1])); }
    if (!__all(pm <= m + THR)) {
        const float mn = fmaxf(m, pm), alpha = __builtin_amdgcn_exp2f(m - mn); m = mn; l *= alpha;
        if (hi == 0) wsf[r32] = alpha;
        LDS_WAIT();
#pragma unroll
        for (int r = 0; r < 16; ++r) { const float a = wsf[crow(r, hi)];
#pragma unroll
            for (int d0 = 0; d0 < NDV; ++d0) o[d0][r] *= a; }
        LDS_WAIT();
    }
    float ps0 = 0.f, ps1 = 0.f;
#pragma unroll
    for (int r = 0; r < 16; ++r) { s0[r] = __builtin_amdgcn_exp2f(s0[r] - m); ps0 += s0[r]; s1[r] = __builtin_amdgcn_exp2f(s1[r] - m); ps1 += s1[r]; }
    l += ps0 + ps1;
    u32x4 w0, w1, w2, w3;
    w0.x = pk2(s0[0], s0[1]); w0.y = pk2(s0[2], s0[3]); w0.z = pk2(s0[4], s0[5]); w0.w = pk2(s0[6], s0[7]);
    w1.x = pk2(s0[8], s0[9]); w1.y = pk2(s0[10], s0[11]); w1.z = pk2(s0[12], s0[13]); w1.w = pk2(s0[14], s0[15]);
    w2.x = pk2(s1[0], s1[1]); w2.y = pk2(s1[2], s1[3]); w2.z = pk2(s1[4], s1[5]); w2.w = pk2(s1[6], s1[7]);
    w3.x = pk2(s1[8], s1[9]); w3.y = pk2(s1[10], s1[11]); w3.z = pk2(s1[12], s1[13]); w3.w = pk2(s1[14], s1[15]);
    const bf16x8 pa0 = __builtin_bit_cast(bf16x8, w0), pa1 = __builtin_bit_cast(bf16x8, w1), pa2 = __builtin_bit_cast(bf16x8, w2), pa3 = __builtin_bit_cast(bf16x8, w3);
#pragma unroll
    for (int d0 = 0; d0 < NDV; ++d0) {
        s16x4 lo[4], hh[4];
#pragma unroll
        for (int ks = 0; ks < 4; ++ks) { lo[ks] = vtr(vb + (d0 * 4 + ks) * 1024); hh[ks] = vtr(vb + (d0 * 4 + ks) * 1024 + 512); }
#define VF_(k) (bf16x8){lo[k][0], lo[k][1], lo[k][2], lo[k][3], hh[k][0], hh[k][1], hh[k][2], hh[k][3]}
        o[d0] = __builtin_amdgcn_mfma_f32_32x32x16_bf16(pa0, VF_(0), o[d0], 0, 0, 0);
        o[d0] = __builtin_amdgcn_mfma_f32_32x32x16_bf16(pa1, VF_(1), o[d0], 0, 0, 0);
        o[d0] = __builtin_amdgcn_mfma_f32_32x32x16_bf16(pa2, VF_(2), o[d0], 0, 0, 0);
        o[d0] = __builtin_amdgcn_mfma_f32_32x32x16_bf16(pa3, VF_(3), o[d0], 0, 0, 0);
#undef VF_
    }
}
template <int NDV>
__device__ __forceinline__ void normalize_o(f32x16 (&o)[NDV], float l, LAS float* wsf, int r32, int hi) {
    { auto rr = __builtin_amdgcn_permlane32_swap(__float_as_uint(l), __float_as_uint(l), false, false); l = __uint_as_float(rr[0]) + __uint_as_float(rr[1]); }
    if (hi == 0) wsf[64 + r32] = l;
    LDS_WAIT();
#pragma unroll
    for (int r = 0; r < 16; ++r) { const float a = __builtin_amdgcn_rcpf(wsf[64 + crow(r, hi)]);
#pragma unroll
        for (int d0 = 0; d0 < NDV; ++d0) o[d0][r] *= a; }
    LDS_WAIT();
}

constexpr int PSLOT = 24576, PCB = 98304;
template <int NDV, bool FOX>
__device__ __forceinline__ void prompt_pass(const GAS bf16* Qw, const GAS bf16* Kg, const GAS bf16* Vg, int qb, int w, int lane, LAS char* lds, float slope2, f32x16 (&o)[NDV]) {
    const int r32 = lane & 31, hi = lane >> 5;
    const unsigned lds0 = (unsigned)(uintptr_t)lds;
    LAS float* wsf = (LAS float*)(lds + ATT_WSF) + w * 128;
    LAS const float* cb = (LAS const float*)(lds + PCB);
    bf16x8 qr[4];
#pragma unroll
    for (int d0 = 0; d0 < 4; ++d0) qr[d0] = *(const GAS bf16x8*)(Qw + (size_t)r32 * PITCH + d0 * 16 + hi * 8);
#pragma unroll
    for (int d0 = 0; d0 < NDV; ++d0) o[d0] = f32x16{};
    float m = -1e30f, l = 0.f;
    const int NT = 4 * qb + 4;
    const int my_last_t = 4 * qb + (w >> 1);
    const GAS bf16* ksrc = Kg + (size_t)lane * PITCH + w * 8;
    const GAS bf16* vsrc0 = Vg + (size_t)(16 * (w & 3) + (lane >> 2)) * PITCH + (w >> 2) * 32 + (lane & 3) * 8;
    const GAS bf16* vsrc1 = vsrc0 + 64;
#define DMA_TILE(i_) do { const size_t go_ = (size_t)(NT - 1 - (i_)) * 64 * PITCH; const unsigned sl_ = lds0 + ((i_) & 3) * PSLOT; \
        glds16(ksrc + go_, (unsigned)__builtin_amdgcn_readfirstlane(sl_ + w * 1024)); \
        glds16(vsrc0 + go_, (unsigned)__builtin_amdgcn_readfirstlane(sl_ + 8192 + w * 1024)); \
        if (NDV == 4) glds16(vsrc1 + go_, (unsigned)__builtin_amdgcn_readfirstlane(sl_ + 8192 + (w + 8) * 1024)); } while (0)
#define WAIT_TILES(n_) do { if (NDV == 4) { if ((n_) == 2) asm volatile("s_waitcnt vmcnt(6) lgkmcnt(0)\n\ts_barrier" ::: "memory"); else if ((n_) == 1) asm volatile("s_waitcnt vmcnt(3) lgkmcnt(0)\n\ts_barrier" ::: "memory"); else ABAR_VL(); } \
        else { if ((n_) == 2) asm volatile("s_waitcnt vmcnt(4) lgkmcnt(0)\n\ts_barrier" ::: "memory"); else if ((n_) == 1) asm volatile("s_waitcnt vmcnt(2) lgkmcnt(0)\n\ts_barrier" ::: "memory"); else ABAR_VL(); } } while (0)
    asm volatile("s_waitcnt vmcnt(0)" ::: "memory");
    DMA_TILE(0); DMA_TILE(1); DMA_TILE(2);
    WAIT_TILES(2);
    for (int i = 0; i < NT; ++i) {
        const int t = NT - 1 - i;
        if (i + 3 < NT) DMA_TILE(i + 3);
        const lds_cptr kimg = (lds_cptr)lds + (i & 3) * PSLOT, vimg = kimg + 8192;
        if (t <= my_last_t) {
            f32x16 c0, c1;
            if (FOX) {
#pragma unroll
                for (int g = 0; g < 4; ++g) { const f32x4 x = *(LAS const f32x4*)(cb + 64 * t + 8 * g + 4 * hi), y = *(LAS const f32x4*)(cb + 64 * t + 32 + 8 * g + 4 * hi);
                    c0[4 * g] = x[0]; c0[4 * g + 1] = x[1]; c0[4 * g + 2] = x[2]; c0[4 * g + 3] = x[3]; c1[4 * g] = y[0]; c1[4 * g + 1] = y[1]; c1[4 * g + 2] = y[2]; c1[4 * g + 3] = y[3]; }
            } else {
                const int kb = 64 * t - 256 * qb;
                if (t == my_last_t) { const int tq2 = 2 * (32 * w + r32);
#pragma unroll
                    for (int r = 0; r < 16; ++r) { const int sa = kb + crow(r, hi), sb = sa + 32; const int va = sa < tq2 - sa ? sa : tq2 - sa, vb2 = sb < tq2 - sb ? sb : tq2 - sb; c0[r] = slope2 * (float)va; c1[r] = slope2 * (float)vb2; }
                } else {
#pragma unroll
                    for (int r = 0; r < 16; ++r) { c0[r] = slope2 * (float)(kb + crow(r, hi)); c1[r] = slope2 * (float)(kb + 32 + crow(r, hi)); }
                }
            }
#pragma unroll
            for (int d0 = 0; d0 < 4; ++d0) { const bf16x8 ka = *(LAS const bf16x8*)(kimg + (2 * d0 + hi) * 1024 + r32 * 16), kb2 = *(LAS const bf16x8*)(kimg + (2 * d0 + hi) * 1024 + (32 + r32) * 16);
                c0 = __builtin_amdgcn_mfma_f32_32x32x16_bf16(ka, qr[d0], c0, 0, 0, 0); c1 = __builtin_amdgcn_mfma_f32_32x32x16_bf16(kb2, qr[d0], c1, 0, 0, 0); }
            if (FOX && t == my_last_t) { const int qrow = 32 * (w & 1) + r32; const float ninf = neg_inf_s();
#pragma unroll
                for (int r = 0; r < 16; ++r) { if (crow(r, hi) > qrow) c0[r] = ninf; if (32 + crow(r, hi) > qrow) c1[r] = ninf; }
            }
            const lds_cptr vb = vimg + (4 * hi + ((lane & 15) >> 2)) * 64 + ((lane >> 4) & 1) * 32 + (lane & 3) * 8;
            sm_pv64<NDV>(c0, c1, m, l, o, vb, wsf, r32, hi);
        }
        if (i + 3 < NT) WAIT_TILES(2); else if (i + 2 < NT) WAIT_TILES(1); else WAIT_TILES(0);
    }
#undef DMA_TILE
#undef WAIT_TILES
    normalize_o<NDV>(o, l, wsf, r32, hi);
}

__device__ __forceinline__ void fox_bias_scan(const GAS float* lf, int n, int qb, LAS char* lds, int tid, int lane, int w) {
    LAS float* cb = (LAS float*)(lds + PCB); LAS float* tmp = (LAS float*)(lds + ATT_TMP);
    float a[4];
#pragma unroll
    for (int k = 0; k < 4; ++k) { const int s = 4 * tid + k; a[k] = s < n ? lf[(size_t)s * 8] : 0.f; }
    a[1] += a[0]; a[2] += a[1]; a[3] += a[2];
    const float tot = a[3]; float v = tot;
#pragma unroll
    for (int o = 1; o < 64; o <<= 1) { const float t = shl_from(v, lane >= o ? lane - o : lane); if (lane >= o) v += t; }
    if (lane == 63) tmp[w] = v;
    ABAR_L();
    float base = 0.f;
    for (int ww = 0; ww < w; ++ww) base += tmp[ww];
    const float excl = base + v - tot;
#pragma unroll
    for (int k = 0; k < 4; ++k) a[k] += excl;
    if (qb > 0 && tid == 64 * qb - 1) tmp[8] = a[3];
    ABAR_L();
    const float R = qb > 0 ? tmp[8] : 0.f;
    f32x4 cv; cv[0] = (R - a[0]) * LOG2E; cv[1] = (R - a[1]) * LOG2E; cv[2] = (R - a[2]) * LOG2E; cv[3] = (R - a[3]) * LOG2E;
    *(LAS f32x4*)(cb + 4 * tid) = cv;
    ABAR_L();
}

template <bool FOX>
__device__ __forceinline__ void sample_pass(const GAS bf16* Qg, const GAS float* Kc, const GAS float* Kn, const GAS float* Vc, const GAS float* Vn, const GAS float* bcs, const GAS float* lfn, float slope2,
                                            int w, int lane, int tid, LAS char* lds, float (&res)[FOX ? 4 : 8]) {
    constexpr int NSP = FOX ? 8 : 4, DPT = FOX ? 4 : 8, NDV = 2;
    const int wsub = w % NSP, grp = w / NSP;
    const int r32 = lane & 31, hi = lane >> 5;
    LAS float* wsf = (LAS float*)(lds + ATT_WSF) + w * 128;
    LAS char* myreg = lds + w * 16384;
    Vc += grp * 64; Vn += grp * 64;
    bf16x8 qr[4];
#pragma unroll
    for (int d0 = 0; d0 < 4; ++d0) qr[d0] = *(const GAS bf16x8*)(Qg + (size_t)r32 * PITCH + d0 * 16 + hi * 8);
    f32x16 o[NDV];
#pragma unroll
    for (int d0 = 0; d0 < NDV; ++d0) o[d0] = f32x16{};
    float m = -1e30f, l = 0.f;
    float nbias = 0.f;
    if (FOX && w == 0) { float v = lane < 32 ? lfn[(size_t)lane * 8] : 0.f;
#pragma unroll
        for (int o2 = 1; o2 < 32; o2 <<= 1) { const float t = shl_from(v, lane >= o2 ? lane - o2 : lane); if (lane >= o2) v += t; }
        nbias = -v * LOG2E; }
    constexpr int CNT = 64 / NSP;
    const int nsteps = (wsub == 0) ? CNT + 1 : CNT;
    const lds_cptr vbw = (lds_cptr)myreg + (4 * hi + ((lane & 15) >> 2)) * 64 + ((lane >> 4) & 1) * 32 + (lane & 3) * 8;
    f32x4 kx[2][8], vx[8];
#define STEP_OF(i_) ((wsub == 0) ? ((i_) == 0 ? 64 : NSP * (CNT - (i_))) : (wsub + NSP * (CNT - 1 - (i_))))
#define ISSUE_K(U, i_) do { const int s_ = STEP_OF(i_); const bool new_ = (s_ == 64); \
        const GAS float* Kb_ = new_ ? Kn : Kc + (size_t)(32 * s_) * 512; \
        int lv_ = lane; asm volatile("" : "+v"(lv_)); \
        const GAS float* kp_ = Kb_ + (size_t)(lv_ & 31) * 512 + 8 * (lv_ >> 5); \
        _Pragma("unroll") for (int d0 = 0; d0 < 4; ++d0) { kx[U][2 * d0] = *(const GAS f32x4*)(kp_ + 16 * d0); kx[U][2 * d0 + 1] = *(const GAS f32x4*)(kp_ + 16 * d0 + 4); } } while (0)
#define ISSUE_V(i_) do { const int s_ = STEP_OF(i_); const bool new_ = (s_ == 64); \
        const GAS float* Vb_ = new_ ? Vn : Vc + (size_t)(32 * s_) * 512; \
        int lv_ = lane; asm volatile("" : "+v"(lv_)); \
        const GAS float* vp_ = Vb_ + (size_t)(lv_ >> 4) * 512 + 4 * (lv_ & 15); \
        _Pragma("unroll") for (int i2 = 0; i2 < 8; ++i2) vx[i2] = *(const GAS f32x4*)(vp_ + (size_t)(4 * i2) * 512); } while (0)
    ISSUE_K(0, 0); ISSUE_V(0);
    constexpr bool DEEP = FOX;
    if (DEEP && 1 < nsteps) ISSUE_K(1, 1);
    for (int i0 = 0; i0 < nsteps; i0 += 2) {
#pragma unroll
      for (int u = 0; u < 2; ++u) {
        const int i = i0 + u;
        if (i >= nsteps) break;
        const int s = STEP_OF(i);
        const bool isnew = (s == 64);
        int lv = lane; asm volatile("" : "+v"(lv));
        const int r32v = lv & 31, hiv = lv >> 5;
        const int vkey = lv >> 4, vdd = 4 * (lv & 15);
        LAS char* vdst = myreg + ((vdd >> 5) * 2) * 1024 + vkey * 64 + (vdd & 31) * 2;
        __builtin_amdgcn_sched_barrier(0);
        bf16x8 kf[4];
#pragma unroll
        for (int d0 = 0; d0 < 4; ++d0) { const f32x4 a = kx[DEEP ? u : 0][2 * d0], b = kx[DEEP ? u : 0][2 * d0 + 1];
            u32x4 pk; pk.x = pk2(a[0], a[1]); pk.y = pk2(a[2], a[3]); pk.z = pk2(b[0], b[1]); pk.w = pk2(b[2], b[3]); kf[d0] = __builtin_bit_cast(bf16x8, pk); }
#pragma unroll
        for (int i2 = 0; i2 < 8; ++i2) { const int kk = 4 * i2; v2u pk; pk.x = pk2(vx[i2][0], vx[i2][1]); pk.y = pk2(vx[i2][2], vx[i2][3]); *(LAS v2u*)(vdst + (kk >> 4) * 1024 + (kk & 15) * 64) = pk; }
        __builtin_amdgcn_sched_barrier(0);
        if (i + 1 < nsteps) ISSUE_V(i + 1);
        if (DEEP) { if (i + 2 < nsteps) ISSUE_K(u, i + 2); } else { if (i + 1 < nsteps) ISSUE_K(0, i + 1); }
        __builtin_amdgcn_sched_barrier(0);
        f32x16 c;
        if (FOX) {
            if (!isnew) {
#pragma unroll
                for (int g = 0; g < 4; ++g) { const f32x4 x = *(const GAS f32x4*)(bcs + 32 * s + 8 * g + 4 * hiv); c[4 * g] = x[0]; c[4 * g + 1] = x[1]; c[4 * g + 2] = x[2]; c[4 * g + 3] = x[3]; }
            } else {
#pragma unroll
                for (int r = 0; r < 16; ++r) c[r] = shl_from(nbias, crow(r, hiv));
            }
        } else {
            if (!isnew) {
#pragma unroll
                for (int r = 0; r < 16; ++r) c[r] = slope2 * (float)(32 * s + crow(r, hiv) - 2048);
            } else {
#pragma unroll
                for (int r = 0; r < 16; ++r) { const int j = crow(r, hiv), v2 = 2 * r32v - j; c[r] = slope2 * (float)(j < v2 ? j : v2); }
            }
        }
#pragma unroll
        for (int d0 = 0; d0 < 4; ++d0) c = __builtin_amdgcn_mfma_f32_32x32x16_bf16(kf[d0], qr[d0], c, 0, 0, 0);
        if (FOX && isnew) { const float ninf = neg_inf_s();
#pragma unroll
            for (int r = 0; r < 16; ++r) if (crow(r, hiv) > r32v) c[r] = ninf;
        }
        sm_pv<NDV, 2>(c, m, l, o, vbw, wsf, r32v, hiv);
      }
    }
#undef ISSUE_K
#undef ISSUE_V
#undef STEP_OF
    { auto rr = __builtin_amdgcn_permlane32_swap(__float_as_uint(l), __float_as_uint(l), false, false); l = __uint_as_float(rr[0]) + __uint_as_float(rr[1]); }
    LAS float* Op = (LAS float*)myreg;
#pragma unroll
    for (int d0 = 0; d0 < NDV; ++d0)
#pragma unroll
        for (int r = 0; r < 16; ++r) Op[crow(r, hi) * 64 + 32 * d0 + r32] = o[d0][r];
    LAS float* ML = (LAS float*)(lds + ATT_ML);
    if (hi == 0) { ML[w * 64 + r32] = m; ML[w * 64 + 32 + r32] = l; }
    ABAR_L();
    const int q = tid >> 4, seg = tid & 15;
    const int g2 = FOX ? 0 : (seg >> 3), d = FOX ? seg * 4 : (seg & 7) * 8;
    float mw[NSP], M = -1e30f;
#pragma unroll
    for (int ww = 0; ww < NSP; ++ww) { mw[ww] = ML[(g2 * NSP + ww) * 64 + q]; M = fmaxf(M, mw[ww]); }
    float L = 0.f, acc[DPT];
#pragma unroll
    for (int k = 0; k < DPT; ++k) acc[k] = 0.f;
#pragma unroll
    for (int ww = 0; ww < NSP; ++ww) { const float sc = __builtin_amdgcn_exp2f(mw[ww] - M); L += sc * ML[(g2 * NSP + ww) * 64 + 32 + q];
        LAS const float* src = (LAS const float*)(lds + (g2 * NSP + ww) * 16384) + q * 64 + d;
#pragma unroll
        for (int k = 0; k < DPT; ++k) acc[k] += sc * src[k]; }
    const float rl = 1.0f / L;
#pragma unroll
    for (int k = 0; k < DPT; ++k) res[k] = acc[k] * rl;
    ABAR_L();
}
}

namespace attx {
using att::bf16x8; using att::s16x4; using att::f32x16; using att::u32x4; using att::lds_cptr; using att::crow; using att::glds16; using att::vtr; using att::PITCH;
constexpr int NSLOT = 3, SLOTB = 8192;
constexpr int LDS_K = 0, LDS_V = NSLOT * SLOTB, LDS_WS = LDS_V + NSLOT * 2 * SLOTB, LDS_OST = LDS_WS + 8 * 64 * 4, LDS_CB = LDS_OST + 8 * 4096, LDS_NEG = LDS_CB + 2048 * 4, LDS_END = LDS_NEG + 64 * 4;
static_assert(LDS_END <= RING_BYTES, "attention LDS map");
#define XSBAR() __builtin_amdgcn_sched_barrier(0)
#define XWAIT_BAR(N) asm volatile("s_waitcnt vmcnt(" #N ") lgkmcnt(0)\n\ts_barrier" ::: "memory")
__device__ __forceinline__ unsigned cvtpk_s(float lo, float hi) { return pk2(lo, hi); }

template <int MODE>
__device__ __forceinline__ void attn_pass(const GAS bf16* Qw, const GAS bf16* Kh, const GAS bf16* Vh, int qb, int wid, int lane, LAS char* shm, float slope2, f32x16 (&o)[2]) {
    const int r32 = lane & 31, hi = lane >> 5;
    const unsigned lds0 = (unsigned)(uintptr_t)shm;
    LAS float* wsf = (LAS float*)(shm + LDS_WS) + wid * 64;
    LAS const float* cb = (LAS const float*)(shm + LDS_CB);
    LAS const float* negblk = (LAS const float*)(shm + LDS_NEG);
    const GAS bf16* ksrc = Kh + (size_t)lane * PITCH + wid * 8;
    const GAS bf16* vsrc = Vh + (size_t)(16 * (wid & 3) + (lane >> 2)) * PITCH + (wid >> 2) * 32 + (lane & 3) * 8;
    const unsigned kdst = lds0 + LDS_K + wid * 1024, vdst = lds0 + LDS_V + wid * 1024;
#define DMA_K(t, slot) glds16(ksrc + (size_t)(t) * 64 * PITCH, (unsigned)__builtin_amdgcn_readfirstlane(kdst + (slot)))
#define DMA_V(t, slot) glds16(vsrc + (size_t)(t) * 64 * PITCH, (unsigned)__builtin_amdgcn_readfirstlane(vdst + 2 * (slot)))
    const lds_cptr shm3 = (lds_cptr)shm; const lds_cptr kp0 = shm3 + LDS_K + hi * 1024 + r32 * 16;
    const lds_cptr vp0 = shm3 + LDS_V + ((lane >> 4) & 1) * 32 + (lane & 3) * 8 + (4 * hi + ((lane & 15) >> 2)) * 64;
    bf16x8 kf[8];
    const int NT = 4 * qb + 4;
    const int tdiag = NT - 4 + (wid >> 1);
    asm volatile("s_waitcnt vmcnt(0)" ::: "memory");
    DMA_K(0, 0); DMA_V(0, 0); DMA_K(1, SLOTB);
    bf16x8 qr[4];
#pragma unroll
    for (int d0 = 0; d0 < 4; ++d0) qr[d0] = *(const GAS bf16x8*)(Qw + (size_t)r32 * PITCH + d0 * 16 + hi * 8);
    float l_reg = 0.f; o[0] = f32x16{}; o[1] = f32x16{};
    const int qrel = wid * 32 + r32;
#define CBPTR(t) (((t) > tdiag) ? negblk : cb + 64 * (t))
#define CBLOAD(P0, P1, ptr) do { LAS const float* p_ = (ptr); _Pragma("unroll") for (int g = 0; g < 4; ++g) { const f32x4 x_ = *(LAS const f32x4*)(p_ + 8 * g + 4 * hi), y_ = *(LAS const f32x4*)(p_ + 32 + 8 * g + 4 * hi); \
        P0[4 * g] = x_[0]; P0[4 * g + 1] = x_[1]; P0[4 * g + 2] = x_[2]; P0[4 * g + 3] = x_[3]; P1[4 * g] = y_[0]; P1[4 * g + 1] = y_[1]; P1[4 * g + 2] = y_[2]; P1[4 * g + 3] = y_[3]; } } while (0)
#define DIAGFIX(C0, C1, t) do { if ((t) == tdiag) { const int kb_ = 64 * (wid >> 1) + 4 * hi; \
        if (MODE == 0) { const float ninf_ = att::neg_inf_s(); _Pragma("unroll") for (int r = 0; r < 16; ++r) { const int kv = kb_ + (r & 3) + 8 * (r >> 2); if (kv > qrel) C0[r] = ninf_; if (kv + 32 > qrel) C1[r] = ninf_; } } \
        else { const float m2_ = -2.0f * slope2; float bf_ = (float)(kb_ - qrel); asm volatile("" : "+v"(bf_)); \
            _Pragma("unroll") for (int r = 0; r < 16; ++r) { const float c_ = (float)((r & 3) + 8 * (r >> 2)); \
                C0[r] = __builtin_fmaf(__builtin_fmaxf(bf_ + c_, 0.f), m2_, C0[r]); C1[r] = __builtin_fmaf(__builtin_fmaxf(bf_ + (c_ + 32.f), 0.f), m2_, C1[r]); asm volatile("" : "+v"(C0), "+v"(C1)); } } } } while (0)
    f32x16 pA0, pA1, pB0, pB1;
    int sl_prev = 0, sl_cur = 0, sl_next = SLOTB;
#define ROT() do { sl_prev = sl_cur; sl_cur = sl_next; sl_next = (sl_next == (NSLOT - 1) * SLOTB) ? 0 : sl_next + SLOTB; } while (0)
    DMA_K(2, 2 * SLOTB);
    CBLOAD(pA0, pA1, CBPTR(0)); CBLOAD(pB0, pB1, CBPTR(1));
    XWAIT_BAR(3);
    {
        const lds_cptr kb = kp0;
#pragma unroll
        for (int d0 = 0; d0 < 4; ++d0) { const bf16x8 b0 = *(LAS const bf16x8*)(kb + d0 * 2048), b1 = *(LAS const bf16x8*)(kb + d0 * 2048 + 512);
            pA0 = __builtin_amdgcn_mfma_f32_32x32x16_bf16(b0, qr[d0], pA0, 0, 0, 0); pA1 = __builtin_amdgcn_mfma_f32_32x32x16_bf16(b1, qr[d0], pA1, 0, 0, 0); }
    }
    DIAGFIX(pA0, pA1, 0);
#pragma unroll
    for (int r = 0; r < 16; ++r) { pA0[r] = __builtin_amdgcn_exp2f(pA0[r]); pA1[r] = __builtin_amdgcn_exp2f(pA1[r]); }
    XWAIT_BAR(0);
    DMA_K(3, 0); DMA_V(1, SLOTB);
    ROT();
#define KLOAD2(j, kp) do { kf[2 * (j)] = *(LAS const bf16x8*)((kp) + (j) * 2048); kf[2 * (j) + 1] = *(LAS const bf16x8*)((kp) + (j) * 2048 + 512); } while (0)
    { const lds_cptr kp = kp0 + sl_cur; KLOAD2(0, kp); KLOAD2(1, kp); KLOAD2(2, kp); KLOAD2(3, kp); }
    XWAIT_BAR(2);
    s16x4 vlo[8], vhi[8]; u32x4 pw0, pw1, pw2, pw3;
#define PKW(P, B) cvtpk_s(P[B], P[B + 1])
#define PAF(k) __builtin_bit_cast(bf16x8, pw##k)
#define VFR(i) (bf16x8){vlo[i][0], vlo[i][1], vlo[i][2], vlo[i][3], vhi[i][0], vhi[i][1], vhi[i][2], vhi[i][3]}
#define PIN(x) asm volatile("" : "+v"(x))
#define GAPA(MF, A0, A1, A2, A3, W0, W1, PW) do { MF; sacc += A0; sacc += A1; sacc += A2; sacc += A3; PIN(sacc); W0; W1; PIN(PW); XSBAR(); } while (0)
#define EX(v) __builtin_amdgcn_exp2f(v)
#define GAPB(MF, X, B) do { MF; X[B] = EX(X[B]); X[B + 1] = EX(X[B + 1]); X[B + 2] = EX(X[B + 2]); X[B + 3] = EX(X[B + 3]); PIN(X); XSBAR(); } while (0)
#define VRD(i) do { vlo[i] = vtr(vp_ + (((i) >> 2) * 4096 + ((i) & 3) * 1024)); vhi[i] = vtr(vp_ + (((i) >> 2) * 4096 + ((i) & 3) * 1024 + 512)); } while (0)
#define KRD(G, j) do { if (G) { KLOAD2(j, kp0 + sl_next); XSBAR(); } } while (0)
#define CRD(GC, P, g, off) do { if (GC) { const f32x4 x_ = *(LAS const f32x4*)(cbn_ + (off) + 8 * (g) + 4 * hi); P[4 * (g)] = x_[0]; P[4 * (g) + 1] = x_[1]; P[4 * (g) + 2] = x_[2]; P[4 * (g) + 3] = x_[3]; XSBAR(); } } while (0)
#define STEP(C0, C1, P0, P1, t, GK, GV, GL, GC) do { XSBAR(); \
    const lds_cptr vp_ = vp0 + 2 * sl_prev; LAS const float* cbn_ = CBPTR((t) + 1); \
    VRD(0); XSBAR(); float sacc = (P0[0] + P0[1]); \
    GAPA(C0 = __builtin_amdgcn_mfma_f32_32x32x16_bf16(kf[0], qr[0], C0, 0, 0, 0), P0[2], P0[3], P0[4], P0[5],     pw0[0] = PKW(P0, 0), pw0[1] = PKW(P0, 2), pw0); \
    VRD(4); XSBAR(); GAPA(C1 = __builtin_amdgcn_mfma_f32_32x32x16_bf16(kf[1], qr[0], C1, 0, 0, 0), P0[6], P0[7], P0[8], P0[9],     pw0[2] = PKW(P0, 4), pw0[3] = PKW(P0, 6), pw0); \
    VRD(1); XSBAR(); GAPA(C0 = __builtin_amdgcn_mfma_f32_32x32x16_bf16(kf[2], qr[1], C0, 0, 0, 0), P0[10], P0[11], P0[12], P0[13], pw1[0] = PKW(P0, 8), pw1[1] = PKW(P0, 10), pw1); \
    VRD(5); XSBAR(); GAPA(C1 = __builtin_amdgcn_mfma_f32_32x32x16_bf16(kf[3], qr[1], C1, 0, 0, 0), P0[14], P0[15], P1[0], P1[1],   pw1[2] = PKW(P0, 12), pw1[3] = PKW(P0, 14), pw1); \
    VRD(2); XSBAR(); GAPA(C0 = __builtin_amdgcn_mfma_f32_32x32x16_bf16(kf[4], qr[2], C0, 0, 0, 0), P1[2], P1[3], P1[4], P1[5],     pw2[0] = PKW(P1, 0), pw2[1] = PKW(P1, 2), pw2); \
    VRD(6); XSBAR(); GAPA(C1 = __builtin_amdgcn_mfma_f32_32x32x16_bf16(kf[5], qr[2], C1, 0, 0, 0), P1[6], P1[7], P1[8], P1[9],     pw2[2] = PKW(P1, 4), pw2[3] = PKW(P1, 6), pw2); \
    VRD(3); XSBAR(); GAPA(C0 = __builtin_amdgcn_mfma_f32_32x32x16_bf16(kf[6], qr[3], C0, 0, 0, 0), P1[10], P1[11], P1[12], P1[13], pw3[0] = PKW(P1, 8), pw3[1] = PKW(P1, 10), pw3); \
    VRD(7); XSBAR(); GAPA(C1 = __builtin_amdgcn_mfma_f32_32x32x16_bf16(kf[7], qr[3], C1, 0, 0, 0), P1[14], P1[15], 0.f, 0.f,       pw3[2] = PKW(P1, 12), pw3[3] = PKW(P1, 14), pw3); \
    l_reg += sacc; \
    if (GK) { DMA_K((t) + 3, sl_cur); } if (GV) { DMA_V((t) + 1, sl_next); } \
    DFX(C0, C1, t); \
    XSBAR(); \
    CRD(GC, P0, 0, 0);  GAPB(o[0] = __builtin_amdgcn_mfma_f32_32x32x16_bf16(PAF(0), VFR(0), o[0], 0, 0, 0), C0, 0); \
    CRD(GC, P0, 1, 0);  GAPB(o[1] = __builtin_amdgcn_mfma_f32_32x32x16_bf16(PAF(0), VFR(4), o[1], 0, 0, 0), C0, 4); \
    CRD(GC, P0, 2, 0);  KRD(GL, 0); GAPB(o[0] = __builtin_amdgcn_mfma_f32_32x32x16_bf16(PAF(1), VFR(1), o[0], 0, 0, 0), C0, 8); \
    CRD(GC, P0, 3, 0);  KRD(GL, 1); GAPB(o[1] = __builtin_amdgcn_mfma_f32_32x32x16_bf16(PAF(1), VFR(5), o[1], 0, 0, 0), C0, 12); \
    CRD(GC, P1, 0, 32); KRD(GL, 2); GAPB(o[0] = __builtin_amdgcn_mfma_f32_32x32x16_bf16(PAF(2), VFR(2), o[0], 0, 0, 0), C1, 0); \
    CRD(GC, P1, 1, 32); KRD(GL, 3); GAPB(o[1] = __builtin_amdgcn_mfma_f32_32x32x16_bf16(PAF(2), VFR(6), o[1], 0, 0, 0), C1, 4); \
    CRD(GC, P1, 2, 32); GAPB(o[0] = __builtin_amdgcn_mfma_f32_32x32x16_bf16(PAF(3), VFR(3), o[0], 0, 0, 0), C1, 8); \
    CRD(GC, P1, 3, 32); GAPB(o[1] = __builtin_amdgcn_mfma_f32_32x32x16_bf16(PAF(3), VFR(7), o[1], 0, 0, 0), C1, 12); \
    } while (0)
    int t = 1;
#define DFX(C0, C1, t) do {} while (0)
    for (; t + 5 < NT; t += 2) {
        STEP(pB0, pB1, pA0, pA1, t, true, true, true, true);     XWAIT_BAR(2); ROT();
        STEP(pA0, pA1, pB0, pB1, t + 1, true, true, true, true); XWAIT_BAR(2); ROT();
    }
#undef DFX
#define DFX(C0, C1, t) DIAGFIX(C0, C1, t)
#define ENDW(tt) do { if ((tt) + 3 < NT) { XWAIT_BAR(2); } else if ((tt) + 2 < NT) { XWAIT_BAR(1); } else { XWAIT_BAR(0); } } while (0)
    for (; t + 1 < NT; t += 2) {
        STEP(pB0, pB1, pA0, pA1, t, (t + 3 < NT), (t + 1 < NT), (t + 1 < NT), (t + 1 < NT));         ENDW(t);     ROT();
        STEP(pA0, pA1, pB0, pB1, t + 1, (t + 4 < NT), (t + 2 < NT), (t + 2 < NT), (t + 2 < NT));     ENDW(t + 1); ROT();
    }
    STEP(pB0, pB1, pA0, pA1, NT - 1, false, false, false, false);
    { float sacc = pB0[0] + pB0[1];
#pragma unroll
      for (int r = 2; r < 16; ++r) sacc += pB0[r];
#pragma unroll
      for (int r = 0; r < 16; ++r) sacc += pB1[r];
      l_reg += sacc;
      pw0 = (u32x4){PKW(pB0, 0), PKW(pB0, 2), PKW(pB0, 4), PKW(pB0, 6)}; pw1 = (u32x4){PKW(pB0, 8), PKW(pB0, 10), PKW(pB0, 12), PKW(pB0, 14)};
      pw2 = (u32x4){PKW(pB1, 0), PKW(pB1, 2), PKW(pB1, 4), PKW(pB1, 6)}; pw3 = (u32x4){PKW(pB1, 8), PKW(pB1, 10), PKW(pB1, 12), PKW(pB1, 14)};
      XSBAR();
      const lds_cptr vp_ = vp0 + 2 * sl_cur;
#pragma unroll
      for (int d0 = 0; d0 < 2; ++d0) { s16x4 lo[4], hh[4];
#pragma unroll
          for (int ks = 0; ks < 4; ++ks) { lo[ks] = vtr(vp_ + d0 * 4096 + ks * 1024); hh[ks] = vtr(vp_ + d0 * 4096 + ks * 1024 + 512); }
#define PK_(k) (bf16x8){lo[k][0], lo[k][1], lo[k][2], lo[k][3], hh[k][0], hh[k][1], hh[k][2], hh[k][3]}
          o[d0] = __builtin_amdgcn_mfma_f32_32x32x16_bf16(PAF(0), PK_(0), o[d0], 0, 0, 0);
          o[d0] = __builtin_amdgcn_mfma_f32_32x32x16_bf16(PAF(1), PK_(1), o[d0], 0, 0, 0);
          o[d0] = __builtin_amdgcn_mfma_f32_32x32x16_bf16(PAF(2), PK_(2), o[d0], 0, 0, 0);
          o[d0] = __builtin_amdgcn_mfma_f32_32x32x16_bf16(PAF(3), PK_(3), o[d0], 0, 0, 0);
#undef PK_
      } }
    { auto rr = __builtin_amdgcn_permlane32_swap(__float_as_uint(l_reg), __float_as_uint(l_reg), false, false); l_reg = __uint_as_float(rr[0]) + __uint_as_float(rr[1]); }
    if (hi == 0) wsf[32 + r32] = l_reg;
    LDS_WAIT();
#pragma unroll
    for (int r = 0; r < 16; ++r) { const float a = __builtin_amdgcn_rcpf(wsf[32 + crow(r, hi)]); o[0][r] *= a; o[1][r] *= a; }
    asm volatile("s_waitcnt lgkmcnt(0)\n\ts_barrier" ::: "memory");
#undef DMA_K
#undef DMA_V
#undef CBPTR
#undef CBLOAD
#undef DIAGFIX
#undef ROT
#undef KLOAD2
#undef PKW
#undef PAF
#undef VFR
#undef PIN
#undef GAPA
#undef EX
#undef GAPB
#undef VRD
#undef KRD
#undef CRD
#undef STEP
#undef ENDW
#undef DFX
}

template <int MODE>
__device__ __forceinline__ void attn_pass4(const GAS bf16* Qw, const GAS bf16* Kh, const GAS bf16* Vh, int qb, int wid, int lane, LAS char* shm, float slope2, f32x16 (&o)[4]) {
    const int r32 = lane & 31, hi = lane >> 5;
    const unsigned lds0 = (unsigned)(uintptr_t)shm;
    LAS float* wsf = (LAS float*)(shm + LDS_WS) + wid * 64;
    LAS const float* cb = (LAS const float*)(shm + LDS_CB);
    LAS const float* negblk = (LAS const float*)(shm + LDS_NEG);
    const GAS bf16* ksrc = Kh + (size_t)lane * PITCH + wid * 8;
    const GAS bf16* vsrc = Vh + (size_t)(16 * (wid & 3) + (lane >> 2)) * PITCH + (wid >> 2) * 32 + (lane & 3) * 8;
    const unsigned kdst = lds0 + LDS_K + wid * 1024, vdst = lds0 + LDS_V + wid * 1024;
#define DMA_K(t, slot) glds16(ksrc + (size_t)(t) * 64 * PITCH, (unsigned)__builtin_amdgcn_readfirstlane(kdst + (slot)))
#define DMA_V(t, slot) do { glds16(vsrc + (size_t)(t) * 64 * PITCH, (unsigned)__builtin_amdgcn_readfirstlane(vdst + 2 * (slot))); \
        glds16(vsrc + 64 + (size_t)(t) * 64 * PITCH, (unsigned)__builtin_amdgcn_readfirstlane(vdst + 2 * (slot) + 8192)); } while (0)
    const lds_cptr shm3 = (lds_cptr)shm; const lds_cptr kp0 = shm3 + LDS_K + hi * 1024 + r32 * 16;
    const lds_cptr vp0 = shm3 + LDS_V + ((lane >> 4) & 1) * 32 + (lane & 3) * 8 + (4 * hi + ((lane & 15) >> 2)) * 64;
    LAS char* qst = shm + LDS_OST + wid * 4096 + lane * 16;
    const int NT = 4 * qb + 4, tdiag = NT - 4 + (wid >> 1);
    asm volatile("s_waitcnt vmcnt(0)" ::: "memory");
    DMA_K(0, 0); DMA_V(0, 0); DMA_K(1, SLOTB);
#pragma unroll
    for (int d0 = 0; d0 < 4; ++d0) { const bf16x8 q = *(const GAS bf16x8*)(Qw + (size_t)r32 * PITCH + d0 * 16 + hi * 8); *(LAS bf16x8*)(qst + d0 * 1024) = q; }
    float l_reg = 0.f;
#pragma unroll
    for (int d0 = 0; d0 < 4; ++d0) o[d0] = f32x16{};
    const int qrel = wid * 32 + r32;
#define CBPTR(t) (((t) > tdiag) ? negblk : cb + 64 * (t))
#define CBLOAD(P0, P1, ptr) do { LAS const float* p_ = (ptr); _Pragma("unroll") for (int g = 0; g < 4; ++g) { const f32x4 x_ = *(LAS const f32x4*)(p_ + 8 * g + 4 * hi), y_ = *(LAS const f32x4*)(p_ + 32 + 8 * g + 4 * hi); \
        P0[4 * g] = x_[0]; P0[4 * g + 1] = x_[1]; P0[4 * g + 2] = x_[2]; P0[4 * g + 3] = x_[3]; P1[4 * g] = y_[0]; P1[4 * g + 1] = y_[1]; P1[4 * g + 2] = y_[2]; P1[4 * g + 3] = y_[3]; } } while (0)
#define DIAGFIX(C0, C1, t) do { if ((t) == tdiag) { const int kb_ = 64 * (wid >> 1) + 4 * hi; \
        if (MODE == 0) { const float ninf_ = att::neg_inf_s(); _Pragma("unroll") for (int r = 0; r < 16; ++r) { const int kv = kb_ + (r & 3) + 8 * (r >> 2); if (kv > qrel) C0[r] = ninf_; if (kv + 32 > qrel) C1[r] = ninf_; } } \
        else { const float m2_ = -2.0f * slope2; float bf_ = (float)(kb_ - qrel); asm volatile("" : "+v"(bf_)); \
            _Pragma("unroll") for (int r = 0; r < 16; ++r) { const float c_ = (float)((r & 3) + 8 * (r >> 2)); \
                C0[r] = __builtin_fmaf(__builtin_fmaxf(bf_ + c_, 0.f), m2_, C0[r]); C1[r] = __builtin_fmaf(__builtin_fmaxf(bf_ + (c_ + 32.f), 0.f), m2_, C1[r]); asm volatile("" : "+v"(C0), "+v"(C1)); } } } } while (0)
    f32x16 pA0, pA1, pB0, pB1;
    int sl_prev = 0, sl_cur = 0, sl_next = SLOTB;
#define ROT() do { sl_prev = sl_cur; sl_cur = sl_next; sl_next = (sl_next == (NSLOT - 1) * SLOTB) ? 0 : sl_next + SLOTB; } while (0)
    DMA_K(2, 2 * SLOTB);
    CBLOAD(pA0, pA1, CBPTR(0)); CBLOAD(pB0, pB1, CBPTR(1));
    XWAIT_BAR(4);
    {
#pragma unroll
        for (int d0 = 0; d0 < 4; ++d0) { const bf16x8 b0 = *(LAS const bf16x8*)(kp0 + d0 * 2048), b1 = *(LAS const bf16x8*)(kp0 + d0 * 2048 + 512); const bf16x8 q = *(LAS const bf16x8*)(qst + d0 * 1024);
            pA0 = __builtin_amdgcn_mfma_f32_32x32x16_bf16(b0, q, pA0, 0, 0, 0); pA1 = __builtin_amdgcn_mfma_f32_32x32x16_bf16(b1, q, pA1, 0, 0, 0); }
    }
    DIAGFIX(pA0, pA1, 0);
#pragma unroll
    for (int r = 0; r < 16; ++r) { pA0[r] = __builtin_amdgcn_exp2f(pA0[r]); pA1[r] = __builtin_amdgcn_exp2f(pA1[r]); }
    XWAIT_BAR(0);
    DMA_V(1, SLOTB);
    ROT();
    s16x4 vlo[8], vhi[8]; u32x4 pw0, pw1, pw2, pw3;
#define PKW(P, B) cvtpk_s(P[B], P[B + 1])
#define PAF(k) __builtin_bit_cast(bf16x8, pw##k)
#define VFR(i) (bf16x8){vlo[i][0], vlo[i][1], vlo[i][2], vlo[i][3], vhi[i][0], vhi[i][1], vhi[i][2], vhi[i][3]}
#define PIN(x) asm volatile("" : "+v"(x))
#define GAPA(MF, A0, A1, A2, A3, W0, W1, PW) do { MF; sacc += A0; sacc += A1; sacc += A2; sacc += A3; PIN(sacc); W0; W1; PIN(PW); XSBAR(); } while (0)
#define EX(v) __builtin_amdgcn_exp2f(v)
#define GAPB2(MF, X, B) do { MF; X[B] = EX(X[B]); X[B + 1] = EX(X[B + 1]); PIN(X); XSBAR(); } while (0)
#define VRD(i) do { vlo[i] = vtr(vp_ + (((i) >> 2) * 4096 + ((i) & 3) * 1024)); vhi[i] = vtr(vp_ + (((i) >> 2) * 4096 + ((i) & 3) * 1024 + 512)); } while (0)
#define VRD2(i) do { vlo[i] = vtr(vp_ + ((((i) >> 2) + 2) * 4096 + ((i) & 3) * 1024)); vhi[i] = vtr(vp_ + ((((i) >> 2) + 2) * 4096 + ((i) & 3) * 1024 + 512)); XSBAR(); } while (0)
#define KFR(i) (*(LAS const bf16x8*)(kpt_ + ((i) >> 1) * 2048 + ((i) & 1) * 512))
#define CRD(GC, P, g, off) do { if (GC) { const f32x4 x_ = *(LAS const f32x4*)(cbn_ + (off) + 8 * (g) + 4 * hi); P[4 * (g)] = x_[0]; P[4 * (g) + 1] = x_[1]; P[4 * (g) + 2] = x_[2]; P[4 * (g) + 3] = x_[3]; XSBAR(); } } while (0)
#define STEPJ(C0, C1, P0, P1, t, GK, GV, GC) do { XSBAR(); \
    const lds_cptr vp_ = vp0 + 2 * sl_prev; const lds_cptr kpt_ = kp0 + sl_cur; LAS const float* cbn_ = CBPTR((t) + 1); \
    const bf16x8 q0_ = *(LAS const bf16x8*)(qst), q1_ = *(LAS const bf16x8*)(qst + 1024), q2_ = *(LAS const bf16x8*)(qst + 2048), q3_ = *(LAS const bf16x8*)(qst + 3072); \
    bf16x8 ka_ = KFR(0), kb_ = KFR(1), kc_; \
    VRD(0); XSBAR(); float sacc = (P0[0] + P0[1]); \
    kc_ = KFR(2); GAPA(C0 = __builtin_amdgcn_mfma_f32_32x32x16_bf16(ka_, q0_, C0, 0, 0, 0), P0[2], P0[3], P0[4], P0[5],     pw0[0] = PKW(P0, 0), pw0[1] = PKW(P0, 2), pw0); \
    VRD(4); ka_ = KFR(3); XSBAR(); GAPA(C1 = __builtin_amdgcn_mfma_f32_32x32x16_bf16(kb_, q0_, C1, 0, 0, 0), P0[6], P0[7], P0[8], P0[9],     pw0[2] = PKW(P0, 4), pw0[3] = PKW(P0, 6), pw0); \
    VRD(1); kb_ = KFR(4); XSBAR(); GAPA(C0 = __builtin_amdgcn_mfma_f32_32x32x16_bf16(kc_, q1_, C0, 0, 0, 0), P0[10], P0[11], P0[12], P0[13], pw1[0] = PKW(P0, 8), pw1[1] = PKW(P0, 10), pw1); \
    VRD(5); kc_ = KFR(5); XSBAR(); GAPA(C1 = __builtin_amdgcn_mfma_f32_32x32x16_bf16(ka_, q1_, C1, 0, 0, 0), P0[14], P0[15], P1[0], P1[1],   pw1[2] = PKW(P0, 12), pw1[3] = PKW(P0, 14), pw1); \
    VRD(2); ka_ = KFR(6); XSBAR(); GAPA(C0 = __builtin_amdgcn_mfma_f32_32x32x16_bf16(kb_, q2_, C0, 0, 0, 0), P1[2], P1[3], P1[4], P1[5],     pw2[0] = PKW(P1, 0), pw2[1] = PKW(P1, 2), pw2); \
    VRD(6); kb_ = KFR(7); XSBAR(); GAPA(C1 = __builtin_amdgcn_mfma_f32_32x32x16_bf16(kc_, q2_, C1, 0, 0, 0), P1[6], P1[7], P1[8], P1[9],     pw2[2] = PKW(P1, 4), pw2[3] = PKW(P1, 6), pw2); \
    VRD(3); XSBAR(); GAPA(C0 = __builtin_amdgcn_mfma_f32_32x32x16_bf16(ka_, q3_, C0, 0, 0, 0), P1[10], P1[11], P1[12], P1[13], pw3[0] = PKW(P1, 8), pw3[1] = PKW(P1, 10), pw3); \
    VRD(7); XSBAR(); GAPA(C1 = __builtin_amdgcn_mfma_f32_32x32x16_bf16(kb_, q3_, C1, 0, 0, 0), P1[14], P1[15], 0.f, 0.f,       pw3[2] = PKW(P1, 12), pw3[3] = PKW(P1, 14), pw3); \
    l_reg += sacc; \
    asm volatile("s_waitcnt lgkmcnt(0)" ::: "memory");     \
    if (GK) { DMA_K((t) + 2, sl_prev); } if (GV) { DMA_V((t) + 1, sl_next); } \
    DFX(C0, C1, t); \
    XSBAR(); \
    GAPB2(o[0] = __builtin_amdgcn_mfma_f32_32x32x16_bf16(PAF(0), VFR(0), o[0], 0, 0, 0), C0, 0);  VRD2(0); \
    GAPB2(o[1] = __builtin_amdgcn_mfma_f32_32x32x16_bf16(PAF(0), VFR(4), o[1], 0, 0, 0), C0, 2);  VRD2(4); \
    GAPB2(o[0] = __builtin_amdgcn_mfma_f32_32x32x16_bf16(PAF(1), VFR(1), o[0], 0, 0, 0), C0, 4);  VRD2(1); \
    GAPB2(o[1] = __builtin_amdgcn_mfma_f32_32x32x16_bf16(PAF(1), VFR(5), o[1], 0, 0, 0), C0, 6);  VRD2(5); \
    GAPB2(o[0] = __builtin_amdgcn_mfma_f32_32x32x16_bf16(PAF(2), VFR(2), o[0], 0, 0, 0), C0, 8);  VRD2(2); \
    GAPB2(o[1] = __builtin_amdgcn_mfma_f32_32x32x16_bf16(PAF(2), VFR(6), o[1], 0, 0, 0), C0, 10); VRD2(6); \
    GAPB2(o[0] = __builtin_amdgcn_mfma_f32_32x32x16_bf16(PAF(3), VFR(3), o[0], 0, 0, 0), C0, 12); VRD2(3); \
    GAPB2(o[1] = __builtin_amdgcn_mfma_f32_32x32x16_bf16(PAF(3), VFR(7), o[1], 0, 0, 0), C0, 14); VRD2(7); \
    CRD(GC, P0, 0, 0);  GAPB2(o[2] = __builtin_amdgcn_mfma_f32_32x32x16_bf16(PAF(0), VFR(0), o[2], 0, 0, 0), C1, 0); \
    CRD(GC, P0, 1, 0);  GAPB2(o[3] = __builtin_amdgcn_mfma_f32_32x32x16_bf16(PAF(0), VFR(4), o[3], 0, 0, 0), C1, 2); \
    CRD(GC, P0, 2, 0);  GAPB2(o[2] = __builtin_amdgcn_mfma_f32_32x32x16_bf16(PAF(1), VFR(1), o[2], 0, 0, 0), C1, 4); \
    CRD(GC, P0, 3, 0);  GAPB2(o[3] = __builtin_amdgcn_mfma_f32_32x32x16_bf16(PAF(1), VFR(5), o[3], 0, 0, 0), C1, 6); \
    CRD(GC, P1, 0, 32); GAPB2(o[2] = __builtin_amdgcn_mfma_f32_32x32x16_bf16(PAF(2), VFR(2), o[2], 0, 0, 0), C1, 8); \
    CRD(GC, P1, 1, 32); GAPB2(o[3] = __builtin_amdgcn_mfma_f32_32x32x16_bf16(PAF(2), VFR(6), o[3], 0, 0, 0), C1, 10); \
    CRD(GC, P1, 2, 32); GAPB2(o[2] = __builtin_amdgcn_mfma_f32_32x32x16_bf16(PAF(3), VFR(3), o[2], 0, 0, 0), C1, 12); \
    CRD(GC, P1, 3, 32); GAPB2(o[3] = __builtin_amdgcn_mfma_f32_32x32x16_bf16(PAF(3), VFR(7), o[3], 0, 0, 0), C1, 14); \
    } while (0)
    int t = 1;
#define DFX(C0, C1, t) do {} while (0)
    for (; t + 5 < NT; t += 2) {
        STEPJ(pB0, pB1, pA0, pA1, t, true, true, true);     XWAIT_BAR(3); ROT();
        STEPJ(pA0, pA1, pB0, pB1, t + 1, true, true, true); XWAIT_BAR(3); ROT();
    }
#undef DFX
#define DFX(C0, C1, t) DIAGFIX(C0, C1, t)
#define ENDW(tt) do { if ((tt) + 2 < NT) { XWAIT_BAR(3); } else { XWAIT_BAR(0); } } while (0)
    for (; t + 1 < NT; t += 2) {
        STEPJ(pB0, pB1, pA0, pA1, t, (t + 2 < NT), (t + 1 < NT), (t + 1 < NT));         ENDW(t);     ROT();
        STEPJ(pA0, pA1, pB0, pB1, t + 1, (t + 3 < NT), (t + 2 < NT), (t + 2 < NT));     ENDW(t + 1); ROT();
    }
    STEPJ(pB0, pB1, pA0, pA1, NT - 1, false, false, false);
    { float sacc = pB0[0] + pB0[1];
#pragma unroll
      for (int r = 2; r < 16; ++r) sacc += pB0[r];
#pragma unroll
      for (int r = 0; r < 16; ++r) sacc += pB1[r];
      l_reg += sacc;
      pw0 = (u32x4){PKW(pB0, 0), PKW(pB0, 2), PKW(pB0, 4), PKW(pB0, 6)}; pw1 = (u32x4){PKW(pB0, 8), PKW(pB0, 10), PKW(pB0, 12), PKW(pB0, 14)};
      pw2 = (u32x4){PKW(pB1, 0), PKW(pB1, 2), PKW(pB1, 4), PKW(pB1, 6)}; pw3 = (u32x4){PKW(pB1, 8), PKW(pB1, 10), PKW(pB1, 12), PKW(pB1, 14)};
      XSBAR();
      const lds_cptr vp_ = vp0 + 2 * sl_cur;
#pragma unroll
      for (int d0 = 0; d0 < 4; ++d0) { s16x4 lo[4], hh[4];
#pragma unroll
          for (int ks = 0; ks < 4; ++ks) { lo[ks] = vtr(vp_ + d0 * 4096 + ks * 1024); hh[ks] = vtr(vp_ + d0 * 4096 + ks * 1024 + 512); }
#define PK_(k) (bf16x8){lo[k][0], lo[k][1], lo[k][2], lo[k][3], hh[k][0], hh[k][1], hh[k][2], hh[k][3]}
          o[d0] = __builtin_amdgcn_mfma_f32_32x32x16_bf16(PAF(0), PK_(0), o[d0], 0, 0, 0);
          o[d0] = __builtin_amdgcn_mfma_f32_32x32x16_bf16(PAF(1), PK_(1), o[d0], 0, 0, 0);
          o[d0] = __builtin_amdgcn_mfma_f32_32x32x16_bf16(PAF(2), PK_(2), o[d0], 0, 0, 0);
          o[d0] = __builtin_amdgcn_mfma_f32_32x32x16_bf16(PAF(3), PK_(3), o[d0], 0, 0, 0);
#undef PK_
      } }
    { auto rr = __builtin_amdgcn_permlane32_swap(__float_as_uint(l_reg), __float_as_uint(l_reg), false, false); l_reg = __uint_as_float(rr[0]) + __uint_as_float(rr[1]); }
    if (hi == 0) wsf[32 + r32] = l_reg;
    LDS_WAIT();
#pragma unroll
    for (int r = 0; r < 16; ++r) { const float a = __builtin_amdgcn_rcpf(wsf[32 + crow(r, hi)]);
#pragma unroll
        for (int d0 = 0; d0 < 4; ++d0) o[d0][r] *= a; }
    asm volatile("s_waitcnt lgkmcnt(0)\n\ts_barrier" ::: "memory");
#undef DMA_K
#undef DMA_V
#undef CBPTR
#undef CBLOAD
#undef DIAGFIX
#undef ROT
#undef PKW
#undef PAF
#undef VFR
#undef PIN
#undef GAPA
#undef EX
#undef GAPB2
#undef VRD
#undef VRD2
#undef KFR
#undef CRD
#undef STEPJ
#undef ENDW
#undef DFX
}
__device__ __forceinline__ void store_o64(const f32x16 (&o)[2], GAS bf16* Ow, int wid, int lane, LAS char* shm, bool wt) {
    const int r32 = lane & 31, hi = lane >> 5;
    LAS bf16* stg = (LAS bf16*)(shm + LDS_OST) + wid * 2048;
#pragma unroll
    for (int r = 0; r < 16; ++r) { const int orow = crow(r, hi);
#pragma unroll
        for (int d0 = 0; d0 < 2; ++d0) stg[orow * 64 + d0 * 32 + r32] = (bf16)(pk2(o[d0][r], 0.f) & 0xffffu); }
    LDS_WAIT();
#pragma unroll
    for (int i = 0; i < 4; ++i) { const int row = i * 8 + (lane >> 3), ch = lane & 7; const v4u v = *(LAS const v4u*)(stg + row * 64 + ch * 8); if (wt) st16_sc1_v(Ow + (size_t)row * 1024 + ch * 8, v); else asm volatile("global_store_dwordx4 %0, %1, off\n\ts_nop 1" :: "v"(Ow + (size_t)row * 1024 + ch * 8), "v"(v) : "memory"); }
    LDS_WAIT();
}
__device__ __forceinline__ void build_cb_fox(const GAS float* lf, int n, LAS char* shm, int tid, int lane, int w) {
    LAS float* cb = (LAS float*)(shm + LDS_CB); LAS float* tmp = (LAS float*)(shm + ATT_TMP);
    float a[4];
#pragma unroll
    for (int k = 0; k < 4; ++k) { const int s = 4 * tid + k; a[k] = s < n ? lf[(size_t)s * 8] : 0.f; }
    a[1] += a[0]; a[2] += a[1]; a[3] += a[2];
    const float tot = a[3]; float v = tot;
#pragma unroll
    for (int o = 1; o < 64; o <<= 1) { const float t = shl_from(v, lane >= o ? lane - o : lane); if (lane >= o) v += t; }
    if (lane == 63) tmp[w] = v;
    if (tid < 64) ((LAS float*)(shm + LDS_NEG))[tid] = -INFINITY;
    ABAR_L();
    float base = 0.f;
    for (int ww = 0; ww < w; ++ww) base += tmp[ww];
    const float excl = base + v - tot;
#pragma unroll
    for (int k = 0; k < 4; ++k) a[k] += excl;
    if (4 * tid + 3 == n - 1) tmp[8] = a[3];
    if (4 * tid == n - 256) tmp[9] = a[0];
    ABAR_L();
    const float R = 0.5f * (tmp[8] + tmp[9]);
    f32x4 cv; cv[0] = (R - a[0]) * LOG2E; cv[1] = (R - a[1]) * LOG2E; cv[2] = (R - a[2]) * LOG2E; cv[3] = (R - a[3]) * LOG2E;
    *(LAS f32x4*)(cb + 4 * tid) = cv;
    ABAR_L();
}
__device__ __forceinline__ void build_cb_alibi(float slope2, int n, LAS char* shm, int tid) {
    LAS float* cb = (LAS float*)(shm + LDS_CB);
    f32x4 cv;
#pragma unroll
    for (int k = 0; k < 4; ++k) cv[k] = slope2 * (float)(4 * tid + k - (n - 128));
    *(LAS f32x4*)(cb + 4 * tid) = cv;
    if (tid < 64) ((LAS float*)(shm + LDS_NEG))[tid] = -INFINITY;
    ABAR_L();
}
#undef XSBAR
#undef XWAIT_BAR
}

__device__ __forceinline__ float wave_sum(float v, int lane) {
#pragma unroll
    for (int o = 1; o < 64; o <<= 1) v += shx(v, o, lane);
    return v;
}
__device__ __forceinline__ int src_col(int map, int n) {
    if (map == 0) return n;
    if (map == 1) { const int tile = n >> 8, i = n & 255; return i < 128 ? 128 * tile + i : DFF + 128 * tile + (i - 128); }
    if (n < 1536) return n;
    if (n < 3072) return n + 8;
    if (n < 3080) return 1536 + (n - 3072);
    return -1;
}
__device__ __forceinline__ void p0_transpose_item(const GAS float* W, int K, int Nsrc, GAS bf16* WT, const GAS float* gain, int map, int nblk, LAS float* scr, int item, int lane, bool wt = false) {
    const int kb = item / nblk, nb = item % nblk, k0 = 64 * kb, n0 = 64 * nb;
    const int nl = 4 * (lane & 15), sc = src_col(map, n0 + nl);
    f32x4 v[16];
#pragma unroll
    for (int i = 0; i < 16; ++i) { const int kk = 4 * i + (lane >> 4); v[i] = (f32x4){0.f, 0.f, 0.f, 0.f}; if (sc >= 0) v[i] = *(const GAS f32x4*)(W + (size_t)(k0 + kk) * Nsrc + sc); }
#pragma unroll
    for (int i = 0; i < 16; ++i) { const int kk = 4 * i + (lane >> 4); f32x4 w = v[i];
        if (gain) { const float g = gain[k0 + kk]; w = w * g; }
        LAS float* d = scr + kk * 65 + nl; d[0] = w.x; d[1] = w.y; d[2] = w.z; d[3] = w.w; }
    LDS_WAIT(); asm volatile("" ::: "memory");
    const int c = lane & 7;
#pragma unroll
    for (int j = 0; j < 8; ++j) { const int n = (lane >> 3) + 8 * j; const LAS float* s = scr + (8 * c) * 65 + n;
        v4u o; o.x = pk2(s[0 * 65], s[1 * 65]); o.y = pk2(s[2 * 65], s[3 * 65]); o.z = pk2(s[4 * 65], s[5 * 65]); o.w = pk2(s[6 * 65], s[7 * 65]);
        if (wt) st16_sc1_v(WT + (size_t)(n0 + n) * K + k0 + 8 * c, o); else *(GAS v4u*)(WT + (size_t)(n0 + n) * K + k0 + 8 * c) = o; }
    LDS_WAIT(); asm volatile("" ::: "memory");
}

#define XB_TMO      128
#define XB_XCNT(j)  (256  + 64 * (j))
#define XB_XSUB(j)  (1280 + 64 * (j))
#define XB_XGEN(j)  (2304 + 64 * (j))
#define XB_TOP      3328
#define XB_TOPGEN   3392
#define XCD_BAR_WORDS 3456
#define XB_SPIN_CAP (1u << 18)

__device__ __forceinline__ unsigned xb_ld(unsigned* p)              { return __hip_atomic_load(p, __ATOMIC_RELAXED, __HIP_MEMORY_SCOPE_AGENT); }
__device__ __forceinline__ unsigned xb_add(unsigned* p, unsigned v) { return __hip_atomic_fetch_add(p, v, __ATOMIC_RELAXED, __HIP_MEMORY_SCOPE_AGENT); }
__device__ __forceinline__ unsigned xb_xcc_id() { return (unsigned)__builtin_amdgcn_s_getreg((3 << 11) | 20) & 0xFu; }
#define XB_SPIN(cond, bar) do { unsigned _sp = 0; while (cond) { __builtin_amdgcn_s_sleep(1); \
    if ((++_sp & 255u) == 0u) { if (xb_ld(&(bar)[XB_TMO])) break; if (_sp > XB_SPIN_CAP) { atomicAdd(&(bar)[XB_TMO], 1u); break; } } } } while (0)

struct XcdBarrier {
    unsigned* bar; unsigned x;
    volatile LAS unsigned* st;
};

__device__ __forceinline__ XcdBarrier xcd_barrier_post(unsigned* bar, volatile LAS unsigned* st) {
    XcdBarrier b; b.bar = bar; b.x = xb_xcc_id(); b.st = st;
    if (threadIdx.x == 0) (void)xb_add(&bar[XB_XCNT(b.x)], 1u);
    return b;
}
__device__ __forceinline__ void xcd_barrier_complete(unsigned* bar, unsigned x, unsigned& nloc, unsigned& nx) {
    const unsigned G = gridDim.x * gridDim.y * gridDim.z;
    unsigned sum, cnt, mine, sp = 0u;
    for (;;) {
        sum = 0u; cnt = 0u; mine = 0u;
#pragma unroll
        for (unsigned j = 0; j < 16; ++j) { const unsigned c = xb_ld(&bar[XB_XCNT(j)]); sum += c; cnt += (c > 0u) ? 1u : 0u; mine = (j == x) ? c : mine; }
        if (sum == G) break;
        __builtin_amdgcn_s_sleep(1);
        if ((++sp & 255u) == 0u) { if (xb_ld(&bar[XB_TMO])) break; if (sp > XB_SPIN_CAP) { atomicAdd(&bar[XB_TMO], 1u); break; } }
    }
    nloc = mine > 0u ? mine : 1u; nx = cnt > 0u ? cnt : 1u;
}

__device__ __forceinline__ void xcd_barrier(const XcdBarrier& b) {
    asm volatile("s_waitcnt vmcnt(0)" ::: "memory");
    __syncthreads();
    if (threadIdx.x == 0) {
        unsigned* bar = b.bar;
        __builtin_amdgcn_s_waitcnt(0);
        unsigned nloc = b.st[0], nx = b.st[1];
        if (nloc == 0u) { xcd_barrier_complete(bar, b.x, nloc, nx); b.st[0] = nloc; b.st[1] = nx; }
        const unsigned old = xb_add(&bar[XB_XSUB(b.x)], 1u);
        const unsigned gen = old / nloc;
        if (old + 1u == (gen + 1u) * nloc) {
            __builtin_amdgcn_fence(__ATOMIC_RELEASE, "agent");
            asm volatile("s_waitcnt vmcnt(0)" ::: "memory");
            const unsigned og = xb_add(&bar[XB_TOP], 1u);
            const unsigned tg = og / nx;
            if (og + 1u == (tg + 1u) * nx) xb_add(&bar[XB_TOPGEN], 1u);
            else XB_SPIN(xb_ld(&bar[XB_TOPGEN]) == tg, bar);
            __builtin_amdgcn_fence(__ATOMIC_ACQUIRE, "agent");
            xb_add(&bar[XB_XGEN(b.x)], 1u);
            asm volatile("s_waitcnt vmcnt(0)" ::: "memory");
        } else {
            XB_SPIN(xb_ld(&bar[XB_XGEN(b.x)]) == gen, bar);
            __builtin_amdgcn_fence(__ATOMIC_ACQUIRE, "agent");
            asm volatile("s_waitcnt vmcnt(0)" ::: "memory");
        }
    }
    __syncthreads();
}

constexpr int CW_FAIL = 64, CW_XMASK = 128, CW_CQ = 192, CW_WRDY = 256, CW_QH = 8192, CW_QH2 = 8704, CW_DEP = 16384;
enum { DK_H1 = 0, DK_X1 = 1, DK_QKV = 2, DK_O = 3, DK_X2 = 4, DK_H2 = 5, DK_Y = 6, DK_LF = 7 };
static_assert(CW_DEP + 8 * 68 * 64 <= CW_SS1, "control words");
constexpr int NSEG = 19, NSTREAM = 12, NCONV = 6;
__device__ const int SEG_PH[NSEG]   = {10, 1, 1, 2, 1, 3, 2, 9, 3, 4, 5, 4, 6, 5, 7, 6, 8, 7, 8};
__device__ const int SEG_KIND[NSEG] = {0, 0, 1, 0, 1, 0, 5, 0, 1, 1, 0, 1, 0, 5, 0, 1, 0, 5, 1};
__device__ const int SEG_JJ0[NSEG]  = {0, 0, 0, 0, 88, 0, 0, 0, 0, 0, 0, 48, 0, 0, 0, 0, 0, 0, 0};
__device__ const int SEG_CNT[NSEG]  = {NCONV, 11, 88, 2, 88, 6, 32, NSTREAM, 104, 48, 2, 48, 11, 32, 2, 176, 2, 32, 32};
__device__ __forceinline__ int q_cnt(int n, int x) { return n / 8 + (x < n % 8 ? 1 : 0); }
__device__ __forceinline__ int q_start(int n, int x) { const int q = n / 8, r = n % 8; return x < r ? x * (q + 1) : r * (q + 1) + (x - r) * q; }
__device__ __forceinline__ int tid_now(int wave) { int x; asm volatile("v_mbcnt_lo_u32_b32 %0, -1, 0\n\tv_mbcnt_hi_u32_b32 %0, -1, %0" : "=v"(x)); return x + wave * 64; }
__device__ __forceinline__ int opq(int k) { asm volatile("" : "+s"(k)); return k; }
#define INP(k) ((const GAS float*)args.in[opq(k)])
struct Args { const float* in[23]; float* out; unsigned char* ws; int ph_lo, ph_hi; };

__device__ __forceinline__ void unit_wait(gu32* depw, int p0, int np, unsigned need, gu32* fail, int tid, LAS unsigned* dbgslot = nullptr, gu32* depw2 = nullptr, unsigned need2 = 0u) {
    if (tid < 64) {
#ifdef DBG_WAITACC
        const unsigned tw0_ = (unsigned)__builtin_amdgcn_s_memrealtime();
#endif
        unsigned spins = 0;
        for (;;) {
            unsigned v = need, v2 = need2;
            if (tid < np) v = __hip_atomic_load(depw + 64 * (p0 + tid), RLX_AGENT);
            else if (depw2 && tid >= 8 && tid < 8 + np) v2 = __hip_atomic_load(depw2 + 64 * (p0 + tid - 8), RLX_AGENT);
            if (__all(v >= need && v2 >= need2)) break;
            __builtin_amdgcn_s_sleep(2);
            if ((++spins & 1023u) == 0u) { if (__builtin_amdgcn_readfirstlane(__hip_atomic_load(fail, RLX_AGENT)) != 0u) break;
                if (spins > (1u << 16)) { if (tid == 0) __hip_atomic_store(fail, 1u, RLX_AGENT); break; } }
        }
        __builtin_amdgcn_fence(__ATOMIC_ACQUIRE, "agent");
        VM_WAIT();
#ifdef DBG_WAITACC
        if (tid == 0) dbgslot[0] += (unsigned)__builtin_amdgcn_s_memrealtime() - tw0_;
#endif
    }
    __syncthreads();
}
__device__ __forceinline__ void unit_publish(gu32* w, int tid) {
    VM_WAIT(); __syncthreads();
    if (tid == 0) __hip_atomic_fetch_add(w, 1u, RLX_AGENT);
}

__global__ void __launch_bounds__(NWAVES * 64, 2) mk_fwd(Args args) {
    extern __shared__ __attribute__((aligned(16))) unsigned char lds_raw[];
#ifdef DBG_EVENT
    const unsigned long long tk_ = __builtin_amdgcn_s_memrealtime();
#endif
    LAS unsigned char* lds = (LAS unsigned char*)lds_raw;
    volatile LAS unsigned* MISC = (volatile LAS unsigned*)(lds + MISC_OFF);
    const int tid = threadIdx.x, wave = __builtin_amdgcn_readfirstlane(tid >> 6);
    const int G = gridDim.x, bx = blockIdx.x, vcu = (G % 8 == 0) ? (bx % 8) * (G / 8) + bx / 8 : bx;
    gu32* ctl0 = (gu32*)((GAS unsigned char*)args.ws + WS_CTL);
    for (int u = tid; u < (LDS_BYTES - LDSCTL_OFF) / 4; u += NWAVES * 64) ((LAS unsigned*)(lds + LDSCTL_OFF))[u] = 0u;
    __syncthreads();
    XcdBarrier bar = xcd_barrier_post((unsigned*)(ctl0 + CW_BAR), MISC + 8);
    if (tid == 0) __hip_atomic_fetch_or(ctl0 + CW_XMASK + (bx & 7), 1u << xb_xcc_id(), RLX_AGENT);
    const int gw = vcu * NWAVES + wave, NGW = G * NWAVES;
#define WSPTRS \
        GAS unsigned char* ws = (GAS unsigned char*)args.ws; GAS float* out = (GAS float*)args.out; asm volatile("" : "+s"(ws), "+s"(out)); \
        gu32* ctl = (gu32*)(ws + WS_CTL); \
        GAS bf16* W1I = (GAS bf16*)(ws + WS_W1I); GAS bf16* W1O = (GAS bf16*)(ws + WS_W1O); GAS bf16* WIN = (GAS bf16*)(ws + WS_WIN); GAS bf16* WOUT = (GAS bf16*)(ws + WS_WOUT); GAS bf16* W2I = (GAS bf16*)(ws + WS_W2I); GAS bf16* W2O = (GAS bf16*)(ws + WS_W2O); \
        GAS float* BC = (GAS float*)(ws + WS_BC); GAS float* SS0 = (GAS float*)(ws + WS_SS0); GAS float* SS1 = (GAS float*)(ws + WS_CTL) + CW_SS1; GAS float* SS2 = (GAS float*)(ws + WS_CTL) + CW_SS2; \
        GAS bf16* XA = (GAS bf16*)(ws + WS_XA); GAS bf16* HB = (GAS bf16*)(ws + WS_H); GAS float* X1 = (GAS float*)(ws + WS_X1); GAS float* X2 = (GAS float*)(ws + WS_X2); \
        GAS bf16* QKV = (GAS bf16*)(ws + WS_QKV); GAS bf16* OB = (GAS bf16*)(ws + WS_OB); GAS float* OSCR = (GAS float*)(ws + WS_OSCR);
#define DEPW(kind) (ctl + CW_DEP + (kind) * 68 * 64)
    {
        WSPTRS
        (void)ctl; (void)BC; (void)SS1; (void)SS2; (void)HB; (void)X1; (void)X2; (void)QKV; (void)OB; (void)OSCR; (void)out;
        const int tidp = tid_now(wave), lanep = tidp & 63;
            LAS float* scr = (LAS float*)(lds + wave * 16640);
            constexpr int I_1I = 16 * 88, I_1O = 44 * 16, I_IN = 16 * 52, I_O = 16 * 16;
            constexpr int NITEMS = I_1I;
            for (int it = gw; it < NITEMS; it += NGW) p0_transpose_item(INP(8), 1024, NFF, W1I, INP(7), 1, 88, scr, it, lanep);
#ifdef DBG_EVENT
            asm volatile("s_waitcnt vmcnt(0)" ::: "memory"); const unsigned long long tp1_ = __builtin_amdgcn_s_memrealtime();
#endif
            const int xfull = (MT / (4 * NGW)) * (4 * NGW), xleft = (MT - xfull) / 4, wlight = NITEMS % NGW;
            const int gx = (gw >= wlight && wlight + xleft + 256 <= NGW) ? gw - wlight : (wlight + xleft + 256 <= NGW ? NGW : gw);
            const int gb = (wlight + xleft + 256 <= NGW) ? gw - wlight - xleft : gw;
            for (int kx = 0; kx < MT / (4 * NGW) + 1; ++kx) {
                const int m0 = kx < MT / (4 * NGW) ? 4 * gw + kx * 4 * NGW : (gx >= 0 && gx < xleft ? xfull + 4 * gx : MT);
                if (m0 >= MT) continue;
                const GAS float* xrow = m0 < MP ? INP(0) + (size_t)m0 * 1024 : INP(1) + (size_t)(m0 - MP) * 1024;
                const GAS f32x4* xr = (const GAS f32x4*)xrow + lanep; f32x4 v[4][4]; float s[4];
#pragma unroll
                for (int q = 0; q < 4; ++q)
#pragma unroll
                    for (int j = 0; j < 4; ++j) v[q][j] = xr[q * 256 + 64 * j];
#pragma unroll
                for (int q = 0; q < 4; ++q) { s[q] = 0.f;
#pragma unroll
                    for (int j = 0; j < 4; ++j) s[q] += (v[q][j].x * v[q][j].x + v[q][j].y * v[q][j].y) + (v[q][j].z * v[q][j].z + v[q][j].w * v[q][j].w); }
#pragma unroll
                for (int o = 1; o < 64; o <<= 1) {
#pragma unroll
                    for (int q = 0; q < 4; ++q) s[q] += shx(s[q], o, lanep); }
                if (lanep == 0) { f32x4 sv; sv.x = s[0]; sv.y = s[1]; sv.z = s[2]; sv.w = s[3]; *(GAS f32x4*)(SS0 + m0) = sv; }
                GAS v2u* o8 = (GAS v2u*)(XA + (size_t)m0 * 1024) + lanep;
#pragma unroll
                for (int q = 0; q < 4; ++q)
#pragma unroll
                    for (int j = 0; j < 4; ++j) { v2u p; p.x = pk2(v[q][j].x, v[q][j].y); p.y = pk2(v[q][j].z, v[q][j].w); o8[q * 256 + 64 * j] = p; }
            }
#ifdef DBG_EVENT
            asm volatile("s_waitcnt vmcnt(0)" ::: "memory"); const unsigned long long tp2_ = __builtin_amdgcn_s_memrealtime();
#endif
            for (int j = gb; j >= 0 && j < 256; j += NGW) {
                const GAS float* lf = INP(4) + (size_t)(j >> 3) * 2048 * 8 + (j & 7);
                float e[32]; float run = 0.f;
#pragma unroll
                for (int i = 31; i >= 0; --i) { const float v = lf[(size_t)(32 * lanep + i) * 8]; e[i] = run; run += v; }
                float v = run;
#pragma unroll
                for (int o = 1; o < 64; o <<= 1) { const float t = shl_from(v, lanep + o < 64 ? lanep + o : lanep); if (lanep + o < 64) v += t; }
                const float excl = v - run;
                GAS float* dst = BC + (size_t)j * 2048 + 32 * lanep;
#pragma unroll
                for (int i = 0; i < 32; i += 4) { f32x4 q; q.x = (e[i] + excl) * LOG2E; q.y = (e[i + 1] + excl) * LOG2E; q.z = (e[i + 2] + excl) * LOG2E; q.w = (e[i + 3] + excl) * LOG2E; *(GAS f32x4*)(dst + i) = q; }
            }
#ifdef DBG_EVENT
            asm volatile("s_waitcnt vmcnt(0)" ::: "memory"); const unsigned long long tp3_ = __builtin_amdgcn_s_memrealtime();
            if (tid == 0) { MISC[16] = (unsigned)(tp1_ - tk_); MISC[17] = (unsigned)(tp2_ - tk_); MISC[18] = (unsigned)(tp3_ - tk_); }
#endif
    }
    xcd_barrier(bar);

    const int xg = bx & 7, hx = xg & 1;
    const unsigned xmask = (unsigned)__builtin_amdgcn_readfirstlane(__hip_atomic_load(ctl0 + CW_XMASK + xg, RLX_AGENT));
    const bool pureg = (xmask & (xmask - 1u)) == 0u;
    LAS unsigned* slot = (LAS unsigned*)(lds + ATT_TMP + 64);
    int lidx;
    { GAS unsigned char* ws = (GAS unsigned char*)args.ws; gu32* qh = (gu32*)(ws + WS_CTL) + CW_QH + 64 * xg;
      if (tid == 0) { slot[0] = __hip_atomic_fetch_add(qh, 1u, RLX_AGENT); slot[8] = 0u; slot[9] = 0u; slot[10] = 0u; slot[11] = 0u; slot[12] = 0u; }
      __syncthreads(); lidx = __builtin_amdgcn_readfirstlane(slot[0]); __syncthreads(); }
#ifdef DBG_EVENT
    unsigned long long acc_ = 0ull, tacc_ = 0ull; bool inacc_ = false;
    const unsigned long long tq_ = __builtin_amdgcn_s_memrealtime(); const unsigned long long t0_ = (DBG_EVENT >= 100) ? tk_ : tq_; unsigned long long tev_ = (DBG_EVENT >= 100) ? tq_ : 0ull;
    if (DBG_EVENT == 101) tev_ = tk_; if (DBG_EVENT >= 102 && DBG_EVENT <= 104) tev_ = tk_ + MISC[16 + DBG_EVENT - 102];
#endif
    for (;;) {
        int sg = 0, sbase = 0, scnt = SEG_CNT[0] ;
        while (sg < NSEG && lidx >= sbase + scnt) { sbase += scnt; ++sg; scnt = sg < NSEG ? SEG_CNT[sg] + (sg == 5 ? hx : 0) : 0; }
        if (sg >= NSEG) break;
#ifdef DBG_EVENT
        if (tev_ == 0ull && sg >= DBG_EVENT) tev_ = __builtin_amdgcn_s_memrealtime();
#ifdef DBG_ACC
        { const unsigned long long tn_ = __builtin_amdgcn_s_memrealtime(); if (inacc_) acc_ += tn_ - tacc_; inacc_ = (sg == DBG_ACC); tacc_ = tn_; }
#endif
#endif
        const int sph = SEG_PH[sg], skind = SEG_KIND[sg], sjj0 = SEG_JJ0[sg];
        GAS unsigned char* ws = (GAS unsigned char*)args.ws; GAS float* out = (GAS float*)args.out; asm volatile("" : "+s"(ws), "+s"(out));
        gu32* ctl = (gu32*)(ws + WS_CTL); gu32* qh = ctl + CW_QH + 64 * xg; gu32* fail = ctl + CW_FAIL;
#define P_W1I ((GAS bf16*)(ws + WS_W1I))
#define P_W1O ((GAS bf16*)(ws + WS_W1O))
#define P_WIN ((GAS bf16*)(ws + WS_WIN))
#define P_WOUT ((GAS bf16*)(ws + WS_WOUT))
#define P_W2I ((GAS bf16*)(ws + WS_W2I))
#define P_W2O ((GAS bf16*)(ws + WS_W2O))
#define P_BC ((GAS float*)(ws + WS_BC))
#define P_SS0 ((GAS float*)(ws + WS_SS0))
#define P_SS1 ((GAS float*)(ws + WS_CTL) + CW_SS1)
#define P_SS2 ((GAS float*)(ws + WS_CTL) + CW_SS2)
#define P_SS3 ((GAS float*)(ws + WS_CTL) + CW_SS3)
#define P_XA ((GAS bf16*)(ws + WS_XA))
#define P_HB ((GAS bf16*)(ws + WS_H))
#define P_X1B ((GAS bf16*)(ws + WS_X1))
#define P_X2B ((GAS bf16*)(ws + WS_X2))
#define P_X3B ((GAS bf16*)(ws + WS_X3))
#define P_HB2 ((GAS bf16*)(ws + WS_H2))
#define P_QKV ((GAS bf16*)(ws + WS_QKV))
#define P_OB ((GAS bf16*)(ws + WS_OB))
#define P_OSCR ((GAS float*)(ws + WS_OSCR))
        const int tidp = tid_now(wave), lanep = tidp & 63;
        int a_att = lidx - sbase + sjj0, sph_e = sph, skind_e = skind;
        const bool inpl = pureg && skind != 0;
        GAS bf16* const bX1 = inpl ? P_XA : P_X1B; GAS bf16* const bX2 = inpl ? P_XA : P_X2B; GAS bf16* const bX3 = inpl ? P_XA : P_X3B; GAS bf16* const bH2 = inpl ? P_HB : P_HB2;
        if (sph == 9) {
            __syncthreads();
            if (tidp == 0) slot[0] = __hip_atomic_fetch_add(ctl + CW_QH2 + 64 * xg, 1u, RLX_AGENT);
            __syncthreads(); a_att = __builtin_amdgcn_readfirstlane(slot[0]); __syncthreads();
            if (a_att >= 48) {
                if (tidp == 0) slot[0] = __hip_atomic_fetch_add(qh, 1u, RLX_AGENT);
                __syncthreads(); lidx = __builtin_amdgcn_readfirstlane(slot[0]); __syncthreads();
                continue;
            }
            sph_e = 4; skind_e = 0;
#ifdef DBG_STREAMDELAY
            { const unsigned long long t0d_ = __builtin_amdgcn_s_memrealtime(); while (__builtin_amdgcn_s_memrealtime() - t0d_ < (unsigned long long)DBG_STREAMDELAY) __builtin_amdgcn_s_sleep(32); }
#endif
        }
        if (sph == 10) {
            constexpr int C_1O = 88, C_IN = C_1O + 104, C_O = C_IN + 32, C_2I = C_O + 176, C_2O = C_2I + 88;
            LAS float* cscr = (LAS float*)(lds + wave * 16640);
            for (;;) {
                __syncthreads();
                if (tidp == 0) slot[0] = __hip_atomic_fetch_add(ctl + CW_CQ, 1u, RLX_AGENT);
                __syncthreads(); const int c = __builtin_amdgcn_readfirstlane(slot[0]); __syncthreads();
                if (c >= C_2O) break;
                int m, r = 8 * c + wave;
                if (c < C_1O) { m = 0; p0_transpose_item(INP(9), 2816, 1024, P_W1O, nullptr, 0, 16, cscr, r, lanep, true); }
                else if (c < C_IN) { m = 1; p0_transpose_item(INP(11), 1024, 3080, P_WIN, INP(10), 2, 52, cscr, r - 8 * C_1O, lanep, true); }
                else if (c < C_O) { m = 2; p0_transpose_item(INP(18), 1024, 1024, P_WOUT, nullptr, 0, 16, cscr, r - 8 * C_IN, lanep, true); }
                else if (c < C_2I) { m = 3; p0_transpose_item(INP(20), 1024, NFF, P_W2I, INP(19), 1, 88, cscr, r - 8 * C_O, lanep, true); }
                else { m = 4; p0_transpose_item(INP(21), 2816, 1024, P_W2O, nullptr, 0, 16, cscr, r - 8 * C_2I, lanep, true); }
                VM_WAIT(); __syncthreads();
                if (tidp == 0) __hip_atomic_fetch_add(ctl + CW_WRDY + 64 * m, 1u, RLX_AGENT);
            }
            if (tidp == 0) slot[0] = __hip_atomic_fetch_add(qh, 1u, RLX_AGENT);
            __syncthreads(); lidx = __builtin_amdgcn_readfirstlane(slot[0]); __syncthreads();
            continue;
        }
        const unsigned wflags = slot[12];
        { unsigned m1_ = 0xffffffffu; asm volatile("" : "+v"(m1_)); if (tidp == 0) { slot[2] = m1_; slot[3] = m1_; } }
        __syncthreads();
        if (sph_e != 4 && sph >= 2 && sph <= 7) {
            const int wm = sph == 2 ? 0 : (sph == 3 ? 1 : (sph == 5 ? 2 : (sph == 6 ? 3 : 4)));
            const unsigned wneed = sph == 2 ? 88u : (sph == 3 ? 104u : (sph == 5 ? 32u : (sph == 6 ? 176u : 88u)));
            if (!((wflags >> wm) & 1u)) {
                if (tidp < 64) { unsigned spins = 0;
                    while ((unsigned)__builtin_amdgcn_readfirstlane(__hip_atomic_load(ctl + CW_WRDY + 64 * wm, RLX_AGENT)) < wneed) {
                        __builtin_amdgcn_s_sleep(8);
                        if ((++spins & 1023u) == 0u) { if (__builtin_amdgcn_readfirstlane(__hip_atomic_load(fail, RLX_AGENT)) != 0u) break;
                            if (spins > (1u << 16)) { if (tidp == 0) __hip_atomic_store(fail, 1u, RLX_AGENT); break; } } }
                    __builtin_amdgcn_fence(__ATOMIC_ACQUIRE, "agent"); VM_WAIT(); }
                __syncthreads();
                if (tidp == 0) slot[12] = wflags | (1u << wm);
            }
        }
        if (sph == 1 || sph == 6) {
            const bool f1 = sph == 1;
            pg8::Gemm g{f1 ? P_XA : bX2, f1 ? P_W1I : P_W2I, MT, NFF, 1024};
            pg8::DynSched S{22, xg, sbase, scnt, skind, sjj0, lidx, qh, f1 ? (gu32*)nullptr : DEPW(DK_X2), 32u, 32u, f1 ? DEPW(DK_H1) : DEPW(DK_H2), fail, slot, tidp};
            pg8::EpiSwiglu E{f1 ? P_HB : bH2, f1 ? P_SS0 : P_SS2, pureg};
            pg8::gemm_phase<pg8::EpiSwiglu, pg8::DynSched, true, true>(lds + RING_OFF, g, S, E, tidp);
            __syncthreads(); lidx = __builtin_amdgcn_readfirstlane(slot[0]); __syncthreads();
        } else if (sph == 2 || sph == 5 || sph == 7) {
            const int which = sph;
            pg8::Gemm g{which == 5 ? P_OB : (which == 2 ? P_HB : bH2), which == 2 ? P_W1O : (which == 5 ? P_WOUT : P_W2O), MT, 1024, which == 5 ? 1024 : 2816};
            pg8::DynSched S{4, xg, sbase, scnt, skind, sjj0, lidx, qh,
                            which == 2 ? DEPW(DK_H1) : (which == 5 ? DEPW(DK_O) : DEPW(DK_H2)), which == 5 ? 12u : 176u, which == 5 ? 96u : 176u,
                            which == 2 ? DEPW(DK_X1) : (which == 5 ? DEPW(DK_X2) : DEPW(DK_Y)), fail, slot, tidp};
            pg8::EpiResid E; E.pure = pureg;
            if (which == 2) { E.base0 = INP(0); E.base1 = INP(1); E.baseh = nullptr; E.out = nullptr; E.xa = bX1; E.ssout = P_SS1; E.alpha = 0.5f; }
            else if (which == 5) { E.base0 = nullptr; E.base1 = nullptr; E.baseh = bX1; E.out = nullptr; E.xa = bX2; E.ssout = P_SS2; E.alpha = 1.0f; }
            else { E.base0 = nullptr; E.base1 = nullptr; E.baseh = bX2; E.out = nullptr; E.xa = bX3; E.ssout = P_SS3; E.alpha = 0.5f; }
            pg8::gemm_phase<pg8::EpiResid, pg8::DynSched, true, true>(lds + RING_OFF, g, S, E, tidp);
            __syncthreads(); lidx = __builtin_amdgcn_readfirstlane(slot[0]); __syncthreads();
        } else if (sph == 3) {
            pg8::Gemm g{bX1, P_WIN, MT, NINP, 1024};
            pg8::DynSched S{13, xg, sbase, scnt, skind, sjj0, lidx, qh, DEPW(DK_X1), 32u, 32u, DEPW(DK_QKV), fail, slot, tidp};
            S.pub2 = DEPW(DK_LF);
            pg8::EpiInProj E{P_QKV, out, P_SS1, INP(12), pureg};
            pg8::gemm_phase<pg8::EpiInProj, pg8::DynSched, true, true>(lds + RING_OFF, g, S, E, tidp);
            __syncthreads(); lidx = __builtin_amdgcn_readfirstlane(slot[0]); __syncthreads();
        } else if (sph_e == 4) {
            const int a = a_att;
#define LAM_NOW() (expf(wave_sum(INP(13)[lane2] * INP(14)[lane2], lane2)) - expf(wave_sum(INP(15)[lane2] * INP(16)[lane2], lane2)) + LAMBDA_INIT)
            LAS char* al = (LAS char*)lds;
            const int tid2 = tidp, lane2 = lanep, r32 = lane2 & 31, hi = lane2 >> 5;
            int idx, pubp;
            if (skind_e == 0) {
                if (a < 16) { const int b = xg + 8 * (a >> 2), h = a & 3; idx = b * 4 + h; pubp = 64 + (b >> 3); }
                else { const int a2 = a - 16, b = xg + 8 * (a2 >> 3), h = a2 & 7; idx = 256 + b * 8 + h; pubp = 64 + (b >> 3); }
                unit_wait(DEPW(DK_QKV), pubp, 1, 104u, fail, tidp, slot + 8);
            } else {
                const int b = xg; int qb;
                if (a < 32) { const int h = a & 3; qb = 7 - (a >> 2); idx = (qb >= 4 ? 128 + (7 - qb) * 32 : 512 + (3 - qb) * 32) + b * 4 + h; }
                else { const int a2 = a - 32, h = a2 & 7; qb = 7 - (a2 >> 3); idx = 640 + (7 - qb) * 64 + b * 8 + h; }
                pubp = 8 * b + qb;
                if (a < 32) unit_wait(DEPW(DK_QKV), 8 * b, qb + 1, 96u, fail, tidp, slot + 8); else unit_wait(DEPW(DK_QKV), 8 * b, qb + 1, 96u, fail, tidp, slot + 8, DEPW(DK_LF), 8u);
            }
            {
                if (idx < 128 || (idx >= 256 && idx < 512)) {
                    const int q = tid2 >> 4, seg = tid2 & 15;
                    if (idx < 128) {
                        const int b = idx >> 2, h = idx & 3; const size_t rowq = (size_t)MP + b * 32;
                        const float slope2 = (0.25f / (float)(1 << (2 * h))) * LOG2E;
                        float r0[8], r1[8];
                        att::sample_pass<false>(P_QKV + rowq * 3072 + 1536 + h * 128, INP(5) + ((size_t)b * 2048 * 4 + h) * 128, out + O_DKS + (size_t)(b * 32) * 512 + h * 128,
                                                   INP(6) + ((size_t)b * 2048 * 4 + h) * 128, out + O_DVS + (size_t)(b * 32) * 512 + h * 128, nullptr, nullptr, slope2, wave, lane2, tid2, al, r0);
                        att::sample_pass<false>(P_QKV + rowq * 3072 + 1536 + h * 128 + 64, INP(5) + ((size_t)b * 2048 * 4 + h) * 128 + 64, out + O_DKS + (size_t)(b * 32) * 512 + h * 128 + 64,
                                                   INP(6) + ((size_t)b * 2048 * 4 + h) * 128, out + O_DVS + (size_t)(b * 32) * 512 + h * 128, nullptr, nullptr, slope2, wave, lane2, tid2, al, r1);
                        float ss = 0.f;
                        const float lam = LAM_NOW();
#pragma unroll
                        for (int k = 0; k < 8; ++k) { r0[k] -= lam * r1[k]; ss += r0[k] * r0[k]; }
                        ss += shx(ss, 1, lane2); ss += shx(ss, 2, lane2); ss += shx(ss, 4, lane2); ss += shx(ss, 8, lane2);
                        const float rn = __builtin_amdgcn_rsqf(ss * (1.0f / 128.0f) + EPS) * (1.0f - LAMBDA_INIT);
                        const GAS float* gs = INP(17) + seg * 8;
                        v4u w; w.x = pk2(r0[0] * rn * gs[0], r0[1] * rn * gs[1]); w.y = pk2(r0[2] * rn * gs[2], r0[3] * rn * gs[3]); w.z = pk2(r0[4] * rn * gs[4], r0[5] * rn * gs[5]); w.w = pk2(r0[6] * rn * gs[6], r0[7] * rn * gs[7]);
                        st16_sc1_v(P_OB + (rowq + q) * 1024 + 512 + h * 128 + seg * 8, w);
                    } else if (idx >= 256) {
                        const int j = idx - 256, b = j >> 3, h = j & 7; const size_t rowq = (size_t)MP + b * 32;
                        float r0[4];
                        att::sample_pass<true>(P_QKV + rowq * 3072 + h * 64, INP(2) + ((size_t)b * 2048 * 8 + h) * 64, out + O_FKS + (size_t)(b * 32) * 512 + h * 64,
                                                  INP(3) + ((size_t)b * 2048 * 8 + h) * 64, out + O_FVS + (size_t)(b * 32) * 512 + h * 64, P_BC + (size_t)(b * 8 + h) * 2048, out + O_FLS + (size_t)(b * 32) * 8 + h, 0.f, wave, lane2, tid2, al, r0);
                        v2u w; w.x = pk2(r0[0], r0[1]); w.y = pk2(r0[2], r0[3]);
                        st8_sc1_v(P_OB + (rowq + q) * 1024 + h * 64 + seg * 4, w);
                    }
                } else if (idx >= 640) {
                    const int j = idx - 640, qb = 7 - (j >> 6), b = (j & 63) >> 3, h = j & 7; const size_t R0 = (size_t)b * SEQ + 256 * qb;
                    GAS bf16* Ow = P_OB + (R0 + 32 * wave) * 1024 + h * 64;
                    attx::build_cb_fox(out + O_FLP + (size_t)b * SEQ * 8 + h, 256 * (qb + 1), al, tid2, lane2, wave);
                    const float cbmin = *(LAS const float*)(al + attx::LDS_CB + 4 * 256 * qb);
                    att::f32x16 o[2];
                    if (__builtin_amdgcn_readfirstlane(cbmin > -50.0f ? 1 : 0)) {
                        attx::attn_pass<0>(P_QKV + (R0 + 32 * wave) * 3072 + h * 64, P_QKV + (size_t)b * SEQ * 3072 + 512 + h * 64, P_QKV + (size_t)b * SEQ * 3072 + 1024 + h * 64, qb, wave, lane2, al, 0.f, o);
                    } else {
                        __syncthreads();
                        att::fox_bias_scan(out + O_FLP + (size_t)b * SEQ * 8 + h, 256 * (qb + 1), qb, al, tid2, lane2, wave);
                        att::prompt_pass<2, true>(P_QKV + (R0 + 32 * wave) * 3072 + h * 64, P_QKV + (size_t)b * SEQ * 3072 + 512 + h * 64, P_QKV + (size_t)b * SEQ * 3072 + 1024 + h * 64, qb, wave, lane2, al, 0.f, o);
                    }
                    attx::store_o64(o, Ow, wave, lane2, al, !pureg);
                } else {
                    const int j = idx < 256 ? idx - 128 : idx - 512, qb = (idx < 256 ? 7 : 3) - (j >> 5), b = (j & 31) >> 2, h = j & 3; const size_t R0 = (size_t)b * SEQ + 256 * qb;
                    const float slope2 = (0.25f / (float)(1 << (2 * h))) * LOG2E;
                    GAS float* scr = P_OSCR + ((size_t)bx * 512 + tid2) * 64;
                    GAS bf16* Ow = P_OB + (R0 + 32 * wave) * 1024 + 512 + h * 128;
                    attx::build_cb_alibi(slope2, 256 * (qb + 1), al, tid2);
                    att::f32x16 o[4];
                    for (int e = 0; e < 2; ++e) {
                        attx::attn_pass4<1>(P_QKV + (R0 + 32 * wave) * 3072 + 1536 + h * 128 + e * 64, P_QKV + (size_t)b * SEQ * 3072 + 2048 + h * 128 + e * 64,
                                            P_QKV + (size_t)b * SEQ * 3072 + 2560 + h * 128, qb, wave, lane2, al, slope2, o);
                        if (e == 0) {
#pragma unroll
                            for (int d0 = 0; d0 < 4; ++d0)
#pragma unroll
                                for (int g = 0; g < 4; ++g) { f32x4 t; t.x = o[d0][4 * g]; t.y = o[d0][4 * g + 1]; t.z = o[d0][4 * g + 2]; t.w = o[d0][4 * g + 3]; *(GAS f32x4*)(scr + d0 * 16 + 4 * g) = t; }
                        }
                    }
                    {
                        const float lam = LAM_NOW();
#pragma unroll
                        for (int d0 = 0; d0 < 4; ++d0)
#pragma unroll
                            for (int g = 0; g < 4; ++g) { const f32x4 t = *(const GAS f32x4*)(scr + d0 * 16 + 4 * g);
#pragma unroll
                                for (int kk = 0; kk < 4; ++kk) o[d0][4 * g + kk] = t[kk] - lam * o[d0][4 * g + kk]; }
                        float gg[4];
#pragma unroll
                        for (int d0 = 0; d0 < 4; ++d0) gg[d0] = INP(17)[32 * d0 + r32] * (1.0f - LAMBDA_INIT);
#pragma unroll
                        for (int r = 0; r < 16; ++r) { float s = (o[0][r] * o[0][r] + o[1][r] * o[1][r]) + (o[2][r] * o[2][r] + o[3][r] * o[3][r]);
                            s += shx(s, 1, lane2); s += shx(s, 2, lane2); s += shx(s, 4, lane2); s += shx(s, 8, lane2); s += shx(s, 16, lane2);
                            const float rn = __builtin_amdgcn_rsqf(s * (1.0f / 128.0f) + EPS);
#pragma unroll
                            for (int d0 = 0; d0 < 4; ++d0) o[d0][r] *= rn * gg[d0]; }
                        attx::store_o64(*(att::f32x16 (*)[2])&o[0], Ow, wave, lane2, al, !pureg);
                        attx::store_o64(*(att::f32x16 (*)[2])&o[2], Ow + 64, wave, lane2, al, !pureg);
                    }
                }
            }
            unit_publish(DEPW(DK_O) + 64 * pubp, tidp);
            if (sph != 9) {
                if (tidp == 0) slot[0] = __hip_atomic_fetch_add(qh, 1u, RLX_AGENT);
                __syncthreads(); lidx = __builtin_amdgcn_readfirstlane(slot[0]); __syncthreads();
            }
        } else {
            const int j8 = lidx - sbase; int pm, qtr;
            if (skind == 0) { pm = 64 + (xg >> 1); qtr = 2 * hx + j8; } else { pm = 8 * xg + 7 - (j8 >> 2); qtr = j8 & 3; }
            unit_wait(DEPW(DK_Y), pm, 1, 32u, fail, tidp, slot + 8);
            const GAS f32x4* gf = (const GAS f32x4*)INP(22) + 2 * lanep;
            f32x4 gv[2][2];
#pragma unroll
            for (int j = 0; j < 2; ++j) { gv[j][0] = gf[128 * j]; gv[j][1] = gf[128 * j + 1]; }
            {
                const int m0 = pm * 256 + qtr * 64 + wave * 8;
                const GAS v4u* xr = (const GAS v4u*)(bX3 + (size_t)m0 * 1024) + lanep; v4u xv[8][2]; float rs[8];
#pragma unroll
                for (int q = 0; q < 8; ++q) { xv[q][0] = xr[q * 128]; xv[q][1] = xr[q * 128 + 64]; rs[q] = __builtin_amdgcn_rsqf(P_SS3[m0 + q] * (1.0f / 1024.0f) + EPS); }
#pragma unroll
                for (int q = 0; q < 8; ++q) { GAS f32x4* yr = (GAS f32x4*)(out + O_Y + (size_t)(m0 + q) * 1024) + 2 * lanep;
#pragma unroll
                    for (int j = 0; j < 2; ++j) { const v4u h4 = xv[q][j]; f32x4 a, b2;
                        a[0] = __uint_as_float(h4.x << 16); a[1] = __uint_as_float(h4.x & 0xffff0000u); a[2] = __uint_as_float(h4.y << 16); a[3] = __uint_as_float(h4.y & 0xffff0000u);
                        b2[0] = __uint_as_float(h4.z << 16); b2[1] = __uint_as_float(h4.z & 0xffff0000u); b2[2] = __uint_as_float(h4.w << 16); b2[3] = __uint_as_float(h4.w & 0xffff0000u);
#ifdef DBG_NOYS
                        if (skind != 0)
#endif
                        { yr[128 * j] = a * rs[q] * gv[j][0]; yr[128 * j + 1] = b2 * rs[q] * gv[j][1]; } } }
            }
            if (tidp == 0) slot[0] = __hip_atomic_fetch_add(qh, 1u, RLX_AGENT);
            __syncthreads(); lidx = __builtin_amdgcn_readfirstlane(slot[0]); __syncthreads();
        }
    }
#ifdef DBG_EVENT
    if (bx == DBG_BLOCK && tid == 0) { const unsigned long long te_ = __builtin_amdgcn_s_memrealtime(); unsigned long long q_ = (tev_ ? tev_ : te_) - t0_;
#ifdef DBG_ACC
        if (inacc_) acc_ += te_ - tacc_; q_ = acc_;
#endif
#ifdef DBG_WAITACC
        q_ = slot[8];
#endif
#ifdef DBG_KACC
        q_ = (DBG_KACC == 11) ? 100ull * slot[11] : slot[DBG_KACC];
#endif
        while (__builtin_amdgcn_s_memrealtime() - te_ < q_ + 50000ull) __builtin_amdgcn_s_sleep(32); }
#endif
}

extern "C" void kernel_launch(void* const* d_in, const int* in_sizes, int n_in, void* d_out, int out_size, void* d_ws, size_t ws_size, hipStream_t stream) {
    static int grid = 0;
    if (grid == 0) {
        if (n_in != 23 || in_sizes[0] != MP * DM || (size_t)out_size != O_END || ws_size < WS_END) {
            fprintf(stderr, "kernel_launch: unexpected problem: n_in %d in0 %d out %d ws %zu; nothing launched\n", n_in, n_in > 0 ? in_sizes[0] : -1, out_size, ws_size); grid = -1; return; }
        int dev = 0, cus = 0, per_cu = 0;
        if (hipGetDevice(&dev) != hipSuccess || hipDeviceGetAttribute(&cus, hipDeviceAttributeMultiprocessorCount, dev) != hipSuccess) { fprintf(stderr, "kernel_launch: device query failed\n"); grid = -1; return; }
        if (hipFuncSetAttribute((const void*)mk_fwd, hipFuncAttributeMaxDynamicSharedMemorySize, LDS_BYTES) != hipSuccess) { fprintf(stderr, "kernel_launch: hipFuncSetAttribute failed\n"); grid = -1; return; }
        if (hipOccupancyMaxActiveBlocksPerMultiprocessor(&per_cu, (const void*)mk_fwd, NWAVES * 64, LDS_BYTES) != hipSuccess || per_cu < 1) {
            fprintf(stderr, "kernel_launch: occupancy query reports %d workgroups per CU; nothing launched\n", per_cu); (void)hipGetLastError(); grid = -1; return; }
        (void)hipGetLastError();
        grid = cus;
    }
    if (grid < 0) return;
    if (hipMemsetAsync((char*)d_ws + WS_CTL, 0, CTL_ZERO_BYTES, stream) != hipSuccess) { fprintf(stderr, "kernel_launch: memset failed\n"); return; }
    Args a{};
    for (int i = 0; i < 23; ++i) a.in[i] = (const float*)d_in[i];
    a.out = (float*)d_out; a.ws = (unsigned char*)d_ws;
    for (int li = 0; li < 1; ++li) {
        a.ph_lo = 0; a.ph_hi = 9;
        hipLaunchKernelGGL(mk_fwd, dim3(grid), dim3(NWAVES * 64), LDS_BYTES, stream, a);
        const hipError_t le = hipPeekAtLastError();
        if (le != hipSuccess) { fprintf(stderr, "kernel_launch: launch %d failed: %s\n", li, hipGetErrorName(le)); break; }
    }
}
```
